# Optimizing an MI355X kernel written in HIP

```python
import jax, jax.numpy as jnp
from jax import lax
import numpy as np

D_MODEL = 1024
BATCH = 2
SEQ = 8192
DEPTH = 1

D_MIX = D_MODEL
GLA_HEADS = 4
GLA_DV = (D_MIX // 2) // GLA_HEADS
GLA_DK = GLA_DV // 2
GLA_RANK = 16
GLA_GATE_NORMALIZER = 16.0
GLA_CHUNK = 64
ATT_Q_HEADS = 8
ATT_KV_HEADS = 2
ATT_HEAD_DIM = (D_MIX // 2) // ATT_Q_HEADS
ATT_WINDOW = 128
ATT_BLOCK = 128
ROT_DIM = ATT_HEAD_DIM // 4
ROPE_THETA = 500000.0
N_EXPERTS = 32
TOP_K = 4
D_FF = D_MODEL
SWIGLU_LIMIT = 7.0
SWIGLU_ALPHA = 1.702
MOE_BLOCK = 128
NORM_EPS = 1e-6
NEG_INF = -1e30
IN_SPLITS = (GLA_HEADS * GLA_DK, GLA_HEADS * GLA_DK, GLA_HEADS * GLA_DV, GLA_HEADS * GLA_DV, 2 * GLA_RANK, ATT_Q_HEADS * ATT_HEAD_DIM, ATT_KV_HEADS * ATT_HEAD_DIM, ATT_KV_HEADS * ATT_HEAD_DIM)
D_IN = sum(IN_SPLITS)
D_MIX_OUT = GLA_HEADS * GLA_DV + ATT_Q_HEADS * ATT_HEAD_DIM

kernel_name = 'hybrid_gla_swa_moe_block'


def rms_norm(x, g):
    xf = x.astype(jnp.float32)
    y = xf * lax.rsqrt(jnp.mean(xf * xf, axis=-1, keepdims=True) + NORM_EPS)
    return (y * g.astype(jnp.float32)).astype(x.dtype)


def partial_rotary(x, positions):
    half = ROT_DIM // 2
    inv_freq = ROPE_THETA ** (-2.0 * jnp.arange(half, dtype=jnp.float32) / ROT_DIM)
    ang = positions.astype(jnp.float32)[:, None] * inv_freq[None, :]
    cos = jnp.cos(ang)[None, :, None, :]
    sin = jnp.sin(ang)[None, :, None, :]
    x1 = x[..., :half].astype(jnp.float32)
    x2 = x[..., half:ROT_DIM].astype(jnp.float32)
    rot = jnp.concatenate([x1 * cos - x2 * sin, x2 * cos + x1 * sin], axis=-1).astype(x.dtype)
    return jnp.concatenate([rot, x[..., ROT_DIM:]], axis=-1)


def gla_one_direction(q, k, v, log_a):
    B, S, H, DK = q.shape
    DV = v.shape[-1]
    C = GLA_CHUNK
    N = S // C

    def chunks(t):
        return t.astype(jnp.float32).reshape(B, N, C, H, t.shape[-1]).transpose(1, 0, 3, 2, 4)

    qc, kc, vc, ac = chunks(q), chunks(k), chunks(v), chunks(log_a)
    b = jnp.cumsum(ac, axis=3)
    b_last = b[:, :, :, -1:, :]
    b_ref = b[:, :, :, C // 2 - 1:C // 2, :]
    scores = jnp.einsum('nbhid,nbhjd->nbhij', qc * jnp.exp(b - b_ref), kc * jnp.exp(b_ref - b))
    causal_in_chunk = jnp.tril(jnp.ones((C, C), dtype=bool))
    scores = jnp.where(causal_in_chunk, scores, 0.0)
    o_intra = jnp.einsum('nbhij,nbhjv->nbhiv', scores, vc)
    q_inter = qc * jnp.exp(b)
    k_state = kc * jnp.exp(b_last - b)
    chunk_decay = jnp.exp(b_last[:, :, :, 0, :])

    def step(state, inp):
        q_n, k_n, v_n, d_n = inp
        o_n = jnp.einsum('bhid,bhdv->bhiv', q_n, state)
        state = state * d_n[..., None] + jnp.einsum('bhjd,bhjv->bhdv', k_n, v_n)
        return state, o_n

    state0 = jnp.zeros((B, H, DK, DV), jnp.float32)
    _, o_inter = lax.scan(step, state0, (q_inter, k_state, vc, chunk_decay))
    o = o_intra + o_inter
    return o.transpose(1, 0, 3, 2, 4).reshape(B, S, H, DV)


def window_attention(q, k, v, sink):
    B, S, HQ, HD = q.shape
    HKV = k.shape[2]
    G = HQ // HKV
    QB = ATT_BLOCK
    NB = S // QB
    pad = ((0, 0), (QB, QB), (0, 0), (0, 0))

    def band(t):
        tp = jnp.pad(t, pad).reshape(B, NB + 2, QB, HKV, HD)
        return jnp.concatenate([tp[:, :-2], tp[:, 1:-1], tp[:, 2:]], axis=2)

    kb, vb = band(k), band(v)
    qb = q.reshape(B, NB, QB, HKV, G, HD)
    s = jnp.einsum('bnikgd,bnjkd->bnkgij', qb, kb).astype(jnp.float32) * (HD ** -0.5)
    blk = jnp.arange(NB)[:, None, None] * QB
    qpos = blk + jnp.arange(QB)[None, :, None]
    kpos = blk - QB + jnp.arange(3 * QB)[None, None, :]
    valid = (jnp.abs(kpos - qpos) <= ATT_WINDOW) & (kpos >= 0) & (kpos < S)
    s = jnp.where(valid[None, :, None, None], s, NEG_INF)
    sink_logit = jnp.broadcast_to(sink.astype(jnp.float32).reshape(HKV, G)[None, None, :, :, None, None], s.shape[:-1] + (1,))
    p = jax.nn.softmax(jnp.concatenate([s, sink_logit], axis=-1), axis=-1)[..., :-1]
    o = jnp.einsum('bnkgij,bnjkd->bnikgd', p.astype(v.dtype), vb)
    return o.reshape(B, S, HQ, HD)


def hybrid_mixer(h, w_in, w_gk_fwd, b_gk_fwd, w_gk_bwd, b_gk_bwd, g_gla_out, attn_sink, w_out):
    B, S, _ = h.shape
    proj = h @ w_in
    split_at = np.cumsum(IN_SPLITS)[:-1].tolist()
    gq, gk, gv, gg, glr, aq, ak, av = jnp.split(proj, split_at, axis=-1)
    q = (gq * (GLA_DK ** -0.5)).reshape(B, S, GLA_HEADS, GLA_DK)
    k = gk.reshape(B, S, GLA_HEADS, GLA_DK)
    v = gv.reshape(B, S, GLA_HEADS, GLA_DV)
    lr_f, lr_b = jnp.split(glr, 2, axis=-1)
    la_f = (jax.nn.log_sigmoid((lr_f @ w_gk_fwd + b_gk_fwd).astype(jnp.float32)) / GLA_GATE_NORMALIZER).reshape(B, S, GLA_HEADS, GLA_DK)
    la_b = (jax.nn.log_sigmoid((lr_b @ w_gk_bwd + b_gk_bwd).astype(jnp.float32)) / GLA_GATE_NORMALIZER).reshape(B, S, GLA_HEADS, GLA_DK)
    o_f = gla_one_direction(q, k, v, la_f)
    o_b = jnp.flip(gla_one_direction(jnp.flip(q, 1), jnp.flip(k, 1), jnp.flip(v, 1), jnp.flip(la_b, 1)), 1)
    o_gla = (o_f + o_b).astype(h.dtype)
    o_gla = rms_norm(o_gla, g_gla_out) * jax.nn.silu(gg.reshape(B, S, GLA_HEADS, GLA_DV))
    positions = jnp.arange(S)
    qa = partial_rotary(aq.reshape(B, S, ATT_Q_HEADS, ATT_HEAD_DIM), positions)
    ka = partial_rotary(ak.reshape(B, S, ATT_KV_HEADS, ATT_HEAD_DIM), positions)
    va = av.reshape(B, S, ATT_KV_HEADS, ATT_HEAD_DIM)
    o_att = window_attention(qa, ka, va, attn_sink)
    o = jnp.concatenate([o_gla.reshape(B, S, GLA_HEADS * GLA_DV), o_att.reshape(B, S, ATT_Q_HEADS * ATT_HEAD_DIM)], axis=-1)
    return o @ w_out


def moe_ffn(h, w_router, b_router, w_gate_up, b_gate_up, w_down, b_down):
    B, S, D = h.shape
    T = B * S
    A = T * TOP_K
    xf = h.reshape(T, D)
    logits = (xf @ w_router + b_router).astype(jnp.float32)
    top_v, top_i = lax.top_k(logits, TOP_K)
    gates = jax.nn.softmax(top_v, axis=-1)
    e_flat = top_i.reshape(A)
    tok_flat = jnp.arange(A, dtype=jnp.int32) // TOP_K
    order = jnp.argsort(e_flat)
    e_sorted = e_flat[order]
    counts = jnp.bincount(e_flat, length=N_EXPERTS)
    padded = (counts + MOE_BLOCK - 1) // MOE_BLOCK * MOE_BLOCK
    pad_end = jnp.cumsum(padded)
    pad_start = pad_end - padded
    start = jnp.cumsum(counts) - counts
    dest = pad_start[e_sorted] + jnp.arange(A, dtype=jnp.int32) - start[e_sorted]
    R = A + N_EXPERTS * MOE_BLOCK
    n_blocks = R // MOE_BLOCK
    row_tok = jnp.zeros((R,), jnp.int32).at[dest].set(tok_flat[order])
    row_gate = jnp.zeros((R,), jnp.float32).at[dest].set(gates.reshape(A)[order])
    block_expert = jnp.minimum(jnp.searchsorted(pad_end, jnp.arange(n_blocks) * MOE_BLOCK, side='right'), N_EXPERTS - 1)
    xs = xf[row_tok].reshape(n_blocks, MOE_BLOCK, D)

    def expert_block(args):
        xb, e = args
        gu = xb @ w_gate_up[e] + b_gate_up[e]
        gate, up = jnp.split(gu, 2, axis=-1)
        gate = jnp.minimum(gate, SWIGLU_LIMIT)
        up = jnp.clip(up, -SWIGLU_LIMIT, SWIGLU_LIMIT)
        act = (up + 1.0) * gate * jax.nn.sigmoid(SWIGLU_ALPHA * gate)
        return act @ w_down[e] + b_down[e]

    ys = lax.map(expert_block, (xs, block_expert)).reshape(R, D)
    out = jnp.zeros((T, D), h.dtype).at[row_tok].add(ys * row_gate[:, None].astype(ys.dtype))
    return out.reshape(B, S, D)


def setup_inputs(seed: int = 0) -> dict:
    key = jax.random.key(seed)
    ks = jax.random.split(key, 24)
    f32 = jnp.float32
    L, D = DEPTH, D_MODEL
    gk_w = GLA_HEADS * GLA_DK

    def nrm(k, shape, scale):
        return jax.random.normal(k, shape, f32) * scale

    return {
        'x': nrm(ks[0], (BATCH, SEQ, D), 1.0),
        'c': nrm(ks[1], (BATCH, D), 1.0),
        'w_ada': nrm(ks[2], (L, D, 6 * D), D ** -0.5),
        'b_ada': nrm(ks[3], (L, 6 * D), 0.02),
        'g_pre_mix': 1.0 + nrm(ks[4], (L, D), 0.02),
        'g_post_mix': 1.0 + nrm(ks[5], (L, D), 0.02),
        'w_in': nrm(ks[6], (L, D, D_IN), D ** -0.5),
        'w_gk_fwd': nrm(ks[7], (L, GLA_RANK, gk_w), GLA_RANK ** -0.5),
        'b_gk_fwd': nrm(ks[8], (L, gk_w), 0.1),
        'w_gk_bwd': nrm(ks[9], (L, GLA_RANK, gk_w), GLA_RANK ** -0.5),
        'b_gk_bwd': nrm(ks[10], (L, gk_w), 0.1),
        'g_gla_out': 1.0 + nrm(ks[11], (L, GLA_DV), 0.02),
        'attn_sink': nrm(ks[12], (L, ATT_Q_HEADS), 1.0),
        'w_out': nrm(ks[13], (L, D_MIX_OUT, D), D_MIX_OUT ** -0.5),
        'g_pre_ffn': 1.0 + nrm(ks[14], (L, D), 0.02),
        'g_post_ffn': 1.0 + nrm(ks[15], (L, D), 0.02),
        'w_router': nrm(ks[16], (L, D, N_EXPERTS), D ** -0.5),
        'b_router': nrm(ks[17], (L, N_EXPERTS), 0.01),
        'w_gate_up': nrm(ks[18], (L, N_EXPERTS, D, 2 * D_FF), D ** -0.5),
        'b_gate_up': nrm(ks[19], (L, N_EXPERTS, 2 * D_FF), 0.01),
        'w_down': nrm(ks[20], (L, N_EXPERTS, D_FF, D), D_FF ** -0.5),
        'b_down': nrm(ks[21], (L, N_EXPERTS, D), 0.01),
    }


def reference(x, c, w_ada, b_ada, g_pre_mix, g_post_mix, w_in, w_gk_fwd, b_gk_fwd, w_gk_bwd, b_gk_bwd, g_gla_out, attn_sink, w_out, g_pre_ffn, g_post_ffn, w_router, b_router, w_gate_up, b_gate_up, w_down, b_down):
    B = x.shape[0]
    D = x.shape[-1]
    c_act = jax.nn.silu(c)
    for l in range(DEPTH):
        mod = (c_act @ w_ada[l] + b_ada[l]).reshape(B, 6, D)[:, :, None, :]
        shift1, scale1, gate1, shift2, scale2, gate2 = (mod[:, i] for i in range(6))
        h = rms_norm(x, g_pre_mix[l]) * (1.0 + scale1) + shift1
        y = hybrid_mixer(h, w_in[l], w_gk_fwd[l], b_gk_fwd[l], w_gk_bwd[l], b_gk_bwd[l], g_gla_out[l], attn_sink[l], w_out[l])
        x = x + gate1 * rms_norm(y, g_post_mix[l])
        h = rms_norm(x, g_pre_ffn[l]) * (1.0 + scale2) + shift2
        y = moe_ffn(h, w_router[l], b_router[l], w_gate_up[l], b_gate_up[l], w_down[l], b_down[l])
        x = x + gate2 * rms_norm(y, g_post_ffn[l])
    return x
```

```cpp
#include <hip/hip_runtime.h>
#include <cstdio>
#include <cstdint>

#define GAS __attribute__((address_space(1)))
#define LAS __attribute__((address_space(3)))
typedef unsigned short bf16;
typedef unsigned v4u __attribute__((ext_vector_type(4)));
typedef unsigned v2u __attribute__((ext_vector_type(2)));
typedef float f32x4 __attribute__((ext_vector_type(4)));
typedef float f32x2 __attribute__((ext_vector_type(2)));
typedef short bf16x8 __attribute__((ext_vector_type(8)));
typedef short bf16x4 __attribute__((ext_vector_type(4)));

#ifndef MK_N_LAUNCHES
#define MK_N_LAUNCHES 1
#endif
constexpr int N_PHASES = 11;

constexpr int NB = 2, SEQ = 8192, T = NB * SEQ, D = 1024, DIN = 2336, DINP = 2560, NE = 32, DFF = 1024;
constexpr int C_GQ = 0, C_GK = 256, C_GV = 512, C_GG = 1024, C_GLR = 1536, C_AQ = 1568, C_AK = 2080, C_AV = 2208;
constexpr int NCH = 128;
constexpr float EPS = 1e-6f;
constexpr int LCAP = 16384;
constexpr int ACT_ROWS = 65536 + NE * 256;

constexpr size_t MiB = 1u << 20;
constexpr size_t WS_CTL = 0, CTL_ZERO_BYTES = 1 * MiB;
constexpr size_t WS_MOD = 1 * MiB;
constexpr size_t WS_ROPE = 1 * MiB + 512 * 1024;
constexpr size_t WS_WR_T = 2 * MiB;
constexpr size_t WS_LIST = 3 * MiB;
constexpr size_t WS_GATE = 5 * MiB;
constexpr size_t WS_DEC = 6 * MiB;
constexpr size_t WS_WIN_T = 8 * MiB;
constexpr size_t WS_WOUT_T = 14 * MiB;
constexpr size_t WS_WGU_T = 16 * MiB;
constexpr size_t WS_WD_T = 144 * MiB;
constexpr size_t WS_H = 208 * MiB;
constexpr size_t WS_PROJ = 240 * MiB;
constexpr size_t WS_UT = 320 * MiB;
constexpr size_t WS_ST = 384 * MiB;
constexpr size_t WS_O = 416 * MiB;
constexpr size_t WS_Y = 448 * MiB;
constexpr size_t WS_H2 = 512 * MiB;
constexpr size_t WS_ACT = 544 * MiB;
constexpr size_t WS_Y2 = 688 * MiB;
constexpr size_t WS_END = 816 * MiB;
constexpr int CW_CNT = 64;
constexpr int CW_BAR = 4096;

constexpr int RING_BYTES = 131072;
constexpr int LDSCTL_OFF = RING_BYTES, MISC_OFF = LDSCTL_OFF + 320;
constexpr int LDS_BYTES = 147456;
constexpr int NWAVES = 8;

#define RLX_AGENT __ATOMIC_RELAXED, __HIP_MEMORY_SCOPE_AGENT
#define LDS_WAIT() asm volatile("s_waitcnt lgkmcnt(0)" ::: "memory")
#define VM_WAIT() asm volatile("s_waitcnt vmcnt(0)" ::: "memory")
__device__ __forceinline__ unsigned f2bf(float f) { unsigned u = __builtin_bit_cast(unsigned, f); return (u + 0x7fffu + ((u >> 16) & 1u)) >> 16; }
__device__ __forceinline__ unsigned pk2(float lo, float hi) { return f2bf(lo) | (f2bf(hi) << 16); }
__device__ __forceinline__ float bf2f(unsigned v) { return __builtin_bit_cast(float, v << 16); }
__device__ __forceinline__ float bflo(unsigned w) { return __builtin_bit_cast(float, w << 16); }
__device__ __forceinline__ float bfhi(unsigned w) { return __builtin_bit_cast(float, w & 0xffff0000u); }
__device__ __forceinline__ float wave_sum(float v) {
#pragma unroll
    for (int o = 1; o < 64; o <<= 1) v += __shfl_xor(v, o);
    return v;
}

#define XB_TMO      128
#define XB_XCNT(j)  (256  + 64 * (j))
#define XB_XSUB(j)  (1280 + 64 * (j))
#define XB_XGEN(j)  (2304 + 64 * (j))
#define XB_TOP      3328
#define XB_TOPGEN   3392
#define XCD_BAR_WORDS 3456
#define XB_SPIN_CAP (1u << 18)
__device__ __forceinline__ unsigned xb_ld(unsigned* p)              { return __hip_atomic_load(p, __ATOMIC_RELAXED, __HIP_MEMORY_SCOPE_AGENT); }
__device__ __forceinline__ unsigned xb_add(unsigned* p, unsigned v) { return __hip_atomic_fetch_add(p, v, __ATOMIC_RELAXED, __HIP_MEMORY_SCOPE_AGENT); }
__device__ __forceinline__ unsigned xb_xcc_id() { return (unsigned)__builtin_amdgcn_s_getreg((3 << 11) | 20) & 0xFu; }
#define XB_SPIN(cond, bar) do { unsigned _sp = 0; while (cond) { __builtin_amdgcn_s_sleep(1); \
    if ((++_sp & 255u) == 0u) { if (xb_ld(&(bar)[XB_TMO])) break; if (_sp > XB_SPIN_CAP) { atomicAdd(&(bar)[XB_TMO], 1u); break; } } } } while (0)
struct XcdBarrier { unsigned* bar; unsigned x; volatile LAS unsigned* st; };
__device__ __forceinline__ XcdBarrier xcd_barrier_post(unsigned* bar, volatile LAS unsigned* st) {
    XcdBarrier b; b.bar = bar; b.x = xb_xcc_id(); b.st = st;
    if (threadIdx.x == 0) (void)xb_add(&bar[XB_XCNT(b.x)], 1u);
    return b;
}
__device__ __forceinline__ void xcd_barrier_complete(unsigned* bar, unsigned x, unsigned& nloc, unsigned& nx) {
    const unsigned G = gridDim.x * gridDim.y * gridDim.z;
    unsigned sum, cnt, mine, sp = 0u;
    for (;;) {
        sum = 0u; cnt = 0u; mine = 0u;
#pragma unroll
        for (unsigned j = 0; j < 16; ++j) { const unsigned c = xb_ld(&bar[XB_XCNT(j)]); sum += c; cnt += (c > 0u) ? 1u : 0u; mine = (j == x) ? c : mine; }
        if (sum == G) break;
        __builtin_amdgcn_s_sleep(1);
        if ((++sp & 255u) == 0u) { if (xb_ld(&bar[XB_TMO])) break; if (sp > XB_SPIN_CAP) { atomicAdd(&bar[XB_TMO], 1u); break; } }
    }
    nloc = mine > 0u ? mine : 1u; nx = cnt > 0u ? cnt : 1u;
}
__device__ __forceinline__ void xcd_barrier(const XcdBarrier& b) {
    asm volatile("s_waitcnt vmcnt(0)" ::: "memory");
    __syncthreads();
    if (threadIdx.x == 0) {
        unsigned* bar = b.bar;
        __builtin_amdgcn_s_waitcnt(0);
        unsigned nloc = b.st[0], nx = b.st[1];
        if (nloc == 0u) { xcd_barrier_complete(bar, b.x, nloc, nx); b.st[0] = nloc; b.st[1] = nx; }
        const unsigned old = xb_add(&bar[XB_XSUB(b.x)], 1u);
        const unsigned gen = old / nloc;
        if (old + 1u == (gen + 1u) * nloc) {
            __builtin_amdgcn_fence(__ATOMIC_RELEASE, "agent");
            asm volatile("s_waitcnt vmcnt(0)" ::: "memory");
            const unsigned og = xb_add(&bar[XB_TOP], 1u);
            const unsigned tg = og / nx;
            if (og + 1u == (tg + 1u) * nx) xb_add(&bar[XB_TOPGEN], 1u);
            else XB_SPIN(xb_ld(&bar[XB_TOPGEN]) == tg, bar);
            __builtin_amdgcn_fence(__ATOMIC_ACQUIRE, "agent");
            xb_add(&bar[XB_XGEN(b.x)], 1u);
            asm volatile("s_waitcnt vmcnt(0)" ::: "memory");
        } else {
            XB_SPIN(xb_ld(&bar[XB_XGEN(b.x)]) == gen, bar);
            __builtin_amdgcn_fence(__ATOMIC_ACQUIRE, "agent");
            asm volatile("s_waitcnt vmcnt(0)" ::: "memory");
        }
    }
    __syncthreads();
}

namespace pg8 {
constexpr int BM = 256, BK = 64, HALF = 128, HTB = HALF * BK * 2, NXCD = 8, WGM = 8;
__device__ __forceinline__ int lds_byte(int r, int c) { const int st = (r >> 4) * 2 + (c >> 5), rr = r & 15, cc = c & 31, ob = rr * 64 + cc * 2; return st * 1024 + (ob ^ (((ob >> 9) & 1) << 5)); }
__device__ __forceinline__ void stage_rc(int b, int& R, int& C) { const int st = b / 1024, sb = b % 1024, swz = sb ^ (((sb >> 9) & 1) << 5); R = (st >> 1) * 16 + swz / 64; C = (st & 1) * 32 + (swz % 64) / 2; }
__device__ __forceinline__ int perm32(int rho) { const int n = rho >> 4, i = rho & 15; return 8 * (i >> 2) + 4 * n + (i & 3); }
struct Unit { int pm, pn, e, nrows; };
__device__ __forceinline__ unsigned cvt_pk_bf16(float lo, float hi) { unsigned r; asm volatile("v_cvt_pk_bf16_f32 %0, %1, %2" : "=v"(r) : "v"(lo), "v"(hi)); return r; }

struct StaticOrder {
    int nM, nN, nwg, G, c;
    __device__ void init(int M, int N, int G_, int c_) { nM = M / BM; nN = N / BM; nwg = nM * nN; G = G_; c = c_; }
    __device__ bool next(int i, int& pm, int& pn) const {
        const long L = (long)i * G + c; if (L >= nwg) return false;
        int wgid = (int)L; { const int q = nwg / NXCD, r = nwg % NXCD, xcd = wgid % NXCD, off = wgid / NXCD; wgid = (xcd < r ? xcd * (q + 1) : r * (q + 1) + (xcd - r) * q) + off; }
        const int nig = WGM * nN, gid = wgid / nig, fm = gid * WGM, gsz = (nM - fm) < WGM ? (nM - fm) : WGM;
        pm = fm + ((wgid % nig) % gsz); pn = (wgid % nig) / gsz; return true;
    }
};

template <class P>
__device__ __forceinline__ void gemm_phase(LAS unsigned char* lds, const P& S) {
    const int tid = threadIdx.x, wid = __builtin_amdgcn_readfirstlane(tid >> 6), lane = tid & 63, wr = wid >> 2, wc = wid & 3, fr = lane & 15, fq = lane >> 4;
    const int K = S.K, nt = K / BK;
    int RA[2], CA[2]; unsigned voffB[2];
#pragma unroll
    for (int i = 0; i < 2; ++i) { int R, C; stage_rc(tid * 16 + i * 8192, R, C); RA[i] = R; CA[i] = C; const int Rb = P::PERM ? ((R & ~31) + perm32(R & 31)) : R; voffB[i] = (unsigned)(Rb * K + C) * 2u; }
    const unsigned kstep = (unsigned)(BK * 2);
    const size_t hstepB = (size_t)HALF * K * 2;
    const unsigned ldsw = (unsigned)wid * 1024u;
    const int aoff = lds_byte(wr * 64 + fr, fq * 8), boff = lds_byte(wc * 32 + fr, fq * 8);
    const char* Abase = (const char*)S.A;
#define PG8_SA(b, h) (((b) * 2 + (h)) * HTB)
#define PG8_SB(b, h) ((4 + (b) * 2 + (h)) * HTB)
#define PG8_STGB(bufoff, gbase) do { _Pragma("unroll") for (int _i = 0; _i < 2; ++_i) \
        __builtin_amdgcn_global_load_lds((const unsigned*)((const char*)(gbase) + voffB[_i]), (LAS unsigned*)(lds + (bufoff) + ldsw + _i * 8192), 16, 0, 0); } while (0)
#define PG8_STGA(bufoff, kb, o0, o1) do { \
        __builtin_amdgcn_global_load_lds((const unsigned*)(Abase + (size_t)(kb) + (o0)), (LAS unsigned*)(lds + (bufoff) + ldsw), 16, 0, 0); \
        __builtin_amdgcn_global_load_lds((const unsigned*)(Abase + (size_t)(kb) + (o1)), (LAS unsigned*)(lds + (bufoff) + ldsw + 8192), 16, 0, 0); } while (0)
#define PG8_LDA(dst, b, h) do { _Pragma("unroll") for (int m = 0; m < 4; ++m) _Pragma("unroll") for (int k = 0; k < 2; ++k) dst[m][k] = *(const LAS bf16x8*)(lds + PG8_SA(b, h) + aoff + m * 2048 + k * 1024); } while (0)
#define PG8_LDB(dst, b, h) do { _Pragma("unroll") for (int n = 0; n < 2; ++n) _Pragma("unroll") for (int k = 0; k < 2; ++k) dst[n][k] = *(const LAS bf16x8*)(lds + PG8_SB(b, h) + boff + n * 2048 + k * 1024); } while (0)
#define PG8_MMA(ai, bj, At, Bt) do { __builtin_amdgcn_s_setprio(1); _Pragma("unroll") for (int m = 0; m < 4; ++m) _Pragma("unroll") for (int n = 0; n < 2; ++n) _Pragma("unroll") for (int k = 0; k < 2; ++k) \
        acc[ai][bj][m][n] = __builtin_amdgcn_mfma_f32_16x16x32_bf16(Bt[n][k], At[m][k], acc[ai][bj][m][n], 0, 0, 0); __builtin_amdgcn_s_setprio(0); } while (0)
#define PG8_WAIT_V(n) asm volatile("s_waitcnt vmcnt(" #n ")" ::: "memory")
#define PG8_WAIT_L(n) asm volatile("s_waitcnt lgkmcnt(" #n ")" ::: "memory")
#define PG8_BAR __builtin_amdgcn_s_barrier()
#define PG8_SCHED __builtin_amdgcn_sched_barrier(0)
    Unit cur, nxt; int ui = 0;
    if (!S.next(0, cur)) return;
    f32x4 acc[2][2][4][2];
#pragma unroll
    for (int a = 0; a < 2; ++a)
#pragma unroll
        for (int b = 0; b < 2; ++b)
#pragma unroll
            for (int m = 0; m < 4; ++m)
#pragma unroll
                for (int n = 0; n < 2; ++n) acc[a][b][m][n] = (f32x4){0.f, 0.f, 0.f, 0.f};
    bf16x8 At[4][2], B0[2][2], B1[2][2];
    unsigned c00, c01, c10, c11, n00, n01, n10, n11;
    S.aoff(cur, RA[0], RA[1], CA[0], CA[1], c00, c01, c10, c11);
    const char* cB = S.bptr(cur);
    PG8_STGB(PG8_SB(0, 0), cB); PG8_STGB(PG8_SB(0, 1), cB + hstepB); PG8_STGA(PG8_SA(0, 0), 0, c00, c01); PG8_STGA(PG8_SA(0, 1), 0, c10, c11);
    if (wr == 1) PG8_BAR;
    PG8_WAIT_V(2); PG8_BAR;
    PG8_STGB(PG8_SB(1, 0), cB + kstep); PG8_STGA(PG8_SA(1, 0), kstep, c00, c01); PG8_STGB(PG8_SB(1, 1), cB + hstepB + kstep);
    PG8_WAIT_V(6); PG8_BAR;
    for (;;) {
        const bool has_next = S.next(ui + 1, nxt);
        const char* nB = cB;
        n00 = c00; n01 = c01; n10 = c10; n11 = c11;
        if (has_next) { S.aoff(nxt, RA[0], RA[1], CA[0], CA[1], n00, n01, n10, n11); nB = S.bptr(nxt); }
        for (int t = 0; t < nt; t += 2) {
            const bool last = (t == nt - 2);
            const unsigned k1 = (unsigned)(t + 1) * kstep;
            const unsigned k2 = last ? 0u : (unsigned)(t + 2) * kstep, k3 = k2 + kstep;
            const char* b2 = last ? nB : cB + (size_t)(t + 2) * kstep; const char* b3 = b2 + kstep;
            const unsigned x00 = last ? n00 : c00, x01 = last ? n01 : c01, x10 = last ? n10 : c10, x11 = last ? n11 : c11;
            PG8_LDB(B0, 0, 0); PG8_LDB(B1, 0, 1); PG8_SCHED; PG8_LDA(At, 0, 0); PG8_STGA(PG8_SA(1, 1), k1, c10, c11);
            PG8_WAIT_V(8); PG8_WAIT_L(0); PG8_BAR; PG8_MMA(0, 0, At, B0); PG8_MMA(0, 1, At, B1); PG8_BAR; PG8_SCHED;
            PG8_LDA(At, 0, 1); PG8_STGB(PG8_SB(0, 0), b2); PG8_STGB(PG8_SB(0, 1), b2 + hstepB); PG8_STGA(PG8_SA(0, 0), k2, x00, x01);
            PG8_WAIT_V(8); PG8_WAIT_L(0); PG8_BAR; PG8_MMA(1, 0, At, B0); PG8_MMA(1, 1, At, B1); PG8_BAR; PG8_SCHED;
            PG8_LDB(B0, 1, 0); PG8_LDB(B1, 1, 1); PG8_SCHED; PG8_LDA(At, 1, 0); PG8_STGA(PG8_SA(0, 1), k2, x10, x11);
            PG8_WAIT_V(8); PG8_WAIT_L(0); PG8_BAR; PG8_MMA(0, 0, At, B0); PG8_MMA(0, 1, At, B1); PG8_BAR; PG8_SCHED;
            PG8_LDA(At, 1, 1); PG8_STGB(PG8_SB(1, 0), b3); PG8_STGB(PG8_SB(1, 1), b3 + hstepB); PG8_STGA(PG8_SA(1, 0), k3, x00, x01);
            PG8_WAIT_V(8); PG8_WAIT_L(0); PG8_BAR; PG8_MMA(1, 0, At, B0); PG8_MMA(1, 1, At, B1); PG8_BAR; PG8_SCHED;
        }
        if (wr == 0) PG8_BAR;
        S.epi(acc, cur, wr, wc, fr, fq);
        if (!has_next) break;
#pragma unroll
        for (int a = 0; a < 2; ++a)
#pragma unroll
            for (int b = 0; b < 2; ++b)
#pragma unroll
                for (int m = 0; m < 4; ++m)
#pragma unroll
                    for (int n = 0; n < 2; ++n) acc[a][b][m][n] = (f32x4){0.f, 0.f, 0.f, 0.f};
        cur = nxt; cB = nB; c00 = n00; c01 = n01; c10 = n10; c11 = n11; ++ui;
        if (wr == 1) PG8_BAR;
    }
    PG8_WAIT_V(0);
    PG8_BAR;
#undef PG8_SA
#undef PG8_SB
#undef PG8_STGA
#undef PG8_STGB
#undef PG8_LDA
#undef PG8_LDB
#undef PG8_MMA
#undef PG8_WAIT_V
#undef PG8_WAIT_L
#undef PG8_BAR
#undef PG8_SCHED
}
}

struct Frame {
    LAS unsigned char* lds;
    volatile LAS unsigned* MISC;
    GAS unsigned* ctl;
    int tid, lane, wave, vcu, G;
    const float *x, *c, *w_ada, *b_ada, *g_pre_mix, *g_post_mix, *w_in, *w_gk_fwd, *b_gk_fwd, *w_gk_bwd, *b_gk_bwd, *g_gla_out, *attn_sink, *w_out,
                *g_pre_ffn, *g_post_ffn, *w_router, *b_router, *w_gate_up, *b_gate_up, *w_down, *b_down;
    float* out;
    float *MOD, *ROPE, *GATE, *DEC, *UT, *Y;
    bf16 *WR_T, *WIN_T, *WOUT_T, *WGU_T, *WD_T, *H, *PROJ, *ST, *O, *H2, *ACT, *Y2;
    int* LIST;
};

struct ProjPolicy {
    static constexpr bool PERM = true;
    const bf16* A; const bf16* Bt; int K; pg8::StaticOrder so; bf16* O; const float* rope;
    __device__ __forceinline__ bool next(int i, pg8::Unit& u) const { u.e = 0; u.nrows = 256; return so.next(i, u.pm, u.pn); }
    __device__ __forceinline__ void aoff(const pg8::Unit& u, int R0, int R1, int C0, int C1, unsigned& o00, unsigned& o01, unsigned& o10, unsigned& o11) const {
        const unsigned b = (unsigned)u.pm * 256u;
        o00 = ((b + R0) * K + C0) * 2u; o01 = ((b + R1) * K + C1) * 2u; o10 = ((b + 128 + R0) * K + C0) * 2u; o11 = ((b + 128 + R1) * K + C1) * 2u;
    }
    __device__ __forceinline__ const char* bptr(const pg8::Unit& u) const { return (const char*)Bt + (size_t)u.pn * 256 * K * 2; }
    __device__ __forceinline__ void epi(const f32x4 (&acc)[2][2][4][2], const pg8::Unit& u, int wr, int wc, int fr, int fq) const {
        const int row0 = u.pm * 256 + wr * 64 + fr;
#pragma unroll
        for (int bj = 0; bj < 2; ++bj) {
            const int cb = u.pn * 256 + bj * 128 + wc * 32;
            const float sc = (cb < C_GK || (cb >= C_AQ && cb < C_AK)) ? 0.125f : 1.f;
            const bool rot = (cb >= C_AQ) && (cb < C_AV) && (((cb - C_AQ) & 63) == 0);
            const float sg = (fq == 0) ? -1.f : 1.f;
#pragma unroll
            for (int ai = 0; ai < 2; ++ai)
#pragma unroll
                for (int m = 0; m < 4; ++m) {
                    const int row = row0 + ai * 128 + m * 16;
                    f32x4 v0 = acc[ai][bj][m][0], v1 = acc[ai][bj][m][1];
                    if (rot) {
                        const float* rp = rope + (size_t)(row & (SEQ - 1)) * 16;
                        const f32x4 c0 = *(const f32x4*)(rp), c1 = *(const f32x4*)(rp + 4), s0 = *(const f32x4*)(rp + 8), s1 = *(const f32x4*)(rp + 12);
                        f32x4 p0, p1;
#pragma unroll
                        for (int j = 0; j < 4; ++j) { p0[j] = __shfl_xor(v0[j], 16); p1[j] = __shfl_xor(v1[j], 16); }
                        if (fq < 2) { v0 = v0 * c0 + (p0 * s0) * sg; v1 = v1 * c1 + (p1 * s1) * sg; }
                    }
                    v0 = v0 * sc; v1 = v1 * sc;
                    v4u w; w.x = pg8::cvt_pk_bf16(v0[0], v0[1]); w.y = pg8::cvt_pk_bf16(v0[2], v0[3]); w.z = pg8::cvt_pk_bf16(v1[0], v1[1]); w.w = pg8::cvt_pk_bf16(v1[2], v1[3]);
                    *(v4u*)(O + (size_t)row * DINP + cb + 8 * fq) = w;
                }
        }
    }
};
struct OutPolicy {
    static constexpr bool PERM = false;
    const bf16* A; const bf16* Bt; int K; pg8::StaticOrder so; float* C;
    __device__ __forceinline__ bool next(int i, pg8::Unit& u) const { u.e = 0; u.nrows = 256; return so.next(i, u.pm, u.pn); }
    __device__ __forceinline__ void aoff(const pg8::Unit& u, int R0, int R1, int C0, int C1, unsigned& o00, unsigned& o01, unsigned& o10, unsigned& o11) const {
        const unsigned b = (unsigned)u.pm * 256u;
        o00 = ((b + R0) * K + C0) * 2u; o01 = ((b + R1) * K + C1) * 2u; o10 = ((b + 128 + R0) * K + C0) * 2u; o11 = ((b + 128 + R1) * K + C1) * 2u;
    }
    __device__ __forceinline__ const char* bptr(const pg8::Unit& u) const { return (const char*)Bt + (size_t)u.pn * 256 * K * 2; }
    __device__ __forceinline__ void epi(const f32x4 (&acc)[2][2][4][2], const pg8::Unit& u, int wr, int wc, int fr, int fq) const {
        const int row0 = u.pm * 256 + wr * 64 + fr, col0 = u.pn * 256 + wc * 32 + 4 * fq;
#pragma unroll
        for (int ai = 0; ai < 2; ++ai)
#pragma unroll
            for (int m = 0; m < 4; ++m) { float* rowp = C + (size_t)(row0 + ai * 128 + m * 16) * D + col0;
#pragma unroll
                for (int bj = 0; bj < 2; ++bj)
#pragma unroll
                    for (int n = 0; n < 2; ++n) *(f32x4*)(rowp + bj * 128 + n * 16) = acc[ai][bj][m][n]; }
    }
};
struct MoePolicyBase {
    const volatile LAS int* tb; const int* cnt; const int* list; int G, c, ncol;
    __device__ __forceinline__ bool next_rt(int i, pg8::Unit& u) const {
        const int L = i * G + c; const int nunits = tb[32] * ncol; if (L >= nunits) return false;
        const int rt = L / ncol; u.pn = L - rt * ncol; u.pm = rt;
        int e = 0;
#pragma unroll 1
        for (int j = 1; j < 32; ++j) e = (rt >= tb[j]) ? j : e;
        u.e = e; const int rem = cnt[e] - (rt - tb[e]) * 256; u.nrows = rem < 256 ? rem : 256; return true;
    }
};
struct Moe1Policy : MoePolicyBase {
    static constexpr bool PERM = true;
    const bf16* A; const bf16* Bt; int K; bf16* ACTp; const float* bias;
    __device__ __forceinline__ bool next(int i, pg8::Unit& u) const { return next_rt(i, u); }
    __device__ __forceinline__ void aoff(const pg8::Unit& u, int R0, int R1, int C0, int C1, unsigned& o00, unsigned& o01, unsigned& o10, unsigned& o11) const {
        const int* lp = list + (size_t)u.e * LCAP + (u.pm - tb[u.e]) * 256;
        const int t00 = (R0 < u.nrows) ? (lp[R0] >> 2) : 0, t01 = (R1 < u.nrows) ? (lp[R1] >> 2) : 0;
        const int t10 = (R0 + 128 < u.nrows) ? (lp[R0 + 128] >> 2) : 0, t11 = (R1 + 128 < u.nrows) ? (lp[R1 + 128] >> 2) : 0;
        o00 = ((unsigned)t00 * K + C0) * 2u; o01 = ((unsigned)t01 * K + C1) * 2u; o10 = ((unsigned)t10 * K + C0) * 2u; o11 = ((unsigned)t11 * K + C1) * 2u;
    }
    __device__ __forceinline__ const char* bptr(const pg8::Unit& u) const { return (const char*)Bt + ((size_t)u.e * 2048 + (size_t)u.pn * 256) * K * 2; }
    __device__ __forceinline__ void epi(const f32x4 (&acc)[2][2][4][2], const pg8::Unit& u, int wr, int wc, int fr, int fq) const {
        const int row0 = u.pm * 256 + wr * 64 + fr, col0 = u.pn * 128 + wc * 32 + 8 * fq;
        const float* bg = bias + (size_t)u.e * 2048 + col0;
        const f32x4 g0 = *(const f32x4*)(bg), g1 = *(const f32x4*)(bg + 4), u0 = *(const f32x4*)(bg + 1024), u1 = *(const f32x4*)(bg + 1028);
#pragma unroll
        for (int ai = 0; ai < 2; ++ai)
#pragma unroll
            for (int m = 0; m < 4; ++m) {
                f32x4 gt[2] = {acc[ai][0][m][0] + g0, acc[ai][0][m][1] + g1}, up[2] = {acc[ai][1][m][0] + u0, acc[ai][1][m][1] + u1};
                float a[8];
#pragma unroll
                for (int n = 0; n < 2; ++n)
#pragma unroll
                    for (int j = 0; j < 4; ++j) {
                        const float g = fminf(gt[n][j], 7.0f), uu = fminf(fmaxf(up[n][j], -7.0f), 7.0f);
                        const float sg = __builtin_amdgcn_rcpf(1.0f + __builtin_amdgcn_exp2f(-1.702f * 1.44269504f * g));
                        a[n * 4 + j] = (uu + 1.0f) * g * sg;
                    }
                v4u w; w.x = pg8::cvt_pk_bf16(a[0], a[1]); w.y = pg8::cvt_pk_bf16(a[2], a[3]); w.z = pg8::cvt_pk_bf16(a[4], a[5]); w.w = pg8::cvt_pk_bf16(a[6], a[7]);
                *(v4u*)(ACTp + (size_t)(row0 + ai * 128 + m * 16) * DFF + col0) = w;
            }
    }
};
struct Moe2Policy : MoePolicyBase {
    static constexpr bool PERM = true;
    const bf16* A; const bf16* Bt; int K; bf16* Y2p; const float* bias; const float* gate;
    __device__ __forceinline__ bool next(int i, pg8::Unit& u) const { return next_rt(i, u); }
    __device__ __forceinline__ void aoff(const pg8::Unit& u, int R0, int R1, int C0, int C1, unsigned& o00, unsigned& o01, unsigned& o10, unsigned& o11) const {
        const unsigned b = (unsigned)u.pm * 256u;
        o00 = ((b + R0) * K + C0) * 2u; o01 = ((b + R1) * K + C1) * 2u; o10 = ((b + 128 + R0) * K + C0) * 2u; o11 = ((b + 128 + R1) * K + C1) * 2u;
    }
    __device__ __forceinline__ const char* bptr(const pg8::Unit& u) const { return (const char*)Bt + ((size_t)u.e * 1024 + (size_t)u.pn * 256) * K * 2; }
    __device__ __forceinline__ void epi(const f32x4 (&acc)[2][2][4][2], const pg8::Unit& u, int wr, int wc, int fr, int fq) const {
        const int* lp = list + (size_t)u.e * LCAP + (u.pm - tb[u.e]) * 256;
        const int colb = u.pn * 256 + wc * 32 + 8 * fq;
        const float* bp = bias + (size_t)u.e * 1024 + colb;
        f32x4 bv[2][2];
#pragma unroll
        for (int bj = 0; bj < 2; ++bj)
#pragma unroll
            for (int n = 0; n < 2; ++n) bv[bj][n] = *(const f32x4*)(bp + bj * 128 + 4 * n);
#pragma unroll
        for (int ai = 0; ai < 2; ++ai)
#pragma unroll
            for (int m = 0; m < 4; ++m) {
                const int r = ai * 128 + wr * 64 + m * 16 + fr;
                if (r < u.nrows) {
                    const int asg = lp[r]; const float gt = gate[asg];
                    bf16* rowp = Y2p + (size_t)asg * D + colb;
#pragma unroll
                    for (int bj = 0; bj < 2; ++bj) {
                        const f32x4 v0 = (acc[ai][bj][m][0] + bv[bj][0]) * gt, v1 = (acc[ai][bj][m][1] + bv[bj][1]) * gt;
                        v4u w; w.x = pg8::cvt_pk_bf16(v0[0], v0[1]); w.y = pg8::cvt_pk_bf16(v0[2], v0[3]); w.z = pg8::cvt_pk_bf16(v1[0], v1[1]); w.w = pg8::cvt_pk_bf16(v1[2], v1[3]);
                        *(v4u*)(rowp + bj * 128) = w;
                    }
                }
            }
    }
};

__device__ __forceinline__ void p0_transpose_item(const float* W, int K, int N, bf16* WT, int kb, int n0, int drow0, LAS float* scr, int lane) {
    const int k0 = 64 * kb;
#pragma unroll 8
    for (int i = 0; i < 32; ++i) { const int kk = 2 * i + (lane >> 5); scr[kk * 33 + (lane & 31)] = W[(size_t)(k0 + kk) * N + n0 + (lane & 31)]; }
    LDS_WAIT(); asm volatile("" ::: "memory");
    const int c = lane & 7;
#pragma unroll
    for (int j = 0; j < 4; ++j) { const int n = (lane >> 3) + 8 * j; const LAS float* s = scr + (8 * c) * 33 + n;
        v4u o; o.x = pk2(s[0 * 33], s[1 * 33]); o.y = pk2(s[2 * 33], s[3 * 33]); o.z = pk2(s[4 * 33], s[5 * 33]); o.w = pk2(s[6 * 33], s[7 * 33]);
        *(GAS v4u*)(WT + (size_t)(drow0 + n) * K + k0 + 8 * c) = o; }
    LDS_WAIT(); asm volatile("" ::: "memory");
}
__device__ __forceinline__ void p0_prologue(Frame& F) {
    const int gw = F.vcu * NWAVES + F.wave, NGW = F.G * NWAVES;
    {
        LAS float* cact = (LAS float*)(F.lds);
        LAS float* red = (LAS float*)(F.lds + 8192);
        bool any = false;
        for (int it = F.vcu; it < 96; it += F.G) {
            if (!any) { for (int i = F.tid; i < 2048; i += 512) { const float v = F.c[i]; cact[i] = v / (1.0f + __expf(-v)); } __syncthreads(); any = true; }
            const int j = it * 64 + F.lane, k0 = F.wave * 128;
            float a0 = 0.f, a1 = 0.f;
#pragma unroll 16
            for (int k = 0; k < 128; ++k) { const float w = F.w_ada[(size_t)(k0 + k) * 6144 + j]; a0 += cact[k0 + k] * w; a1 += cact[1024 + k0 + k] * w; }
            red[(F.wave * 2 + 0) * 64 + F.lane] = a0; red[(F.wave * 2 + 1) * 64 + F.lane] = a1;
            __syncthreads();
            if (F.wave < 2) { float s = F.b_ada[j];
#pragma unroll
                for (int w = 0; w < 8; ++w) s += red[(w * 2 + F.wave) * 64 + F.lane];
                F.MOD[F.wave * 6144 + j] = s; }
            __syncthreads();
        }
        __syncthreads();
    }
    for (int idx = (F.vcu * 512 + F.tid); idx < SEQ * 8; idx += F.G * 512) {
        const int t = idx >> 3, i = idx & 7;
        const float inv = powf(500000.0f, -(float)i / 8.0f);
        const float ang = (float)t * inv;
        const double rev = (double)ang * 0.15915494309189535;
        const float fr = (float)(rev - rint(rev));
        F.ROPE[t * 16 + i] = __builtin_amdgcn_cosf(fr); F.ROPE[t * 16 + 8 + i] = __builtin_amdgcn_sinf(fr);
    }
    { v4u z = {0u, 0u, 0u, 0u}; GAS v4u* p = (GAS v4u*)(F.WIN_T + (size_t)DIN * D); const int n = (DINP - DIN) * D * 2 / 16;
      for (int i = F.vcu * 512 + F.tid; i < n; i += F.G * 512) p[i] = z; }
    LAS float* scr = (LAS float*)(F.lds + 16384 + F.wave * 12288);
    constexpr int I_IN = 16 * (DIN / 32), I_OUT = 16 * 32, I_R = 16, I_GU = 16 * 64, I_D = 16 * 32;
    constexpr int NITEMS = I_IN + I_OUT + I_R + NE * (I_GU + I_D);
    for (int it = gw; it < NITEMS; it += NGW) {
        int r = it;
        if (r < I_IN) { const int nb = r % (DIN / 32), kb = r / (DIN / 32); p0_transpose_item(F.w_in, D, DIN, F.WIN_T, kb, nb * 32, nb * 32, scr, F.lane); continue; } r -= I_IN;
        if (r < I_OUT) { const int nb = r % 32, kb = r / 32; p0_transpose_item(F.w_out, D, D, F.WOUT_T, kb, nb * 32, nb * 32, scr, F.lane); continue; } r -= I_OUT;
        if (r < I_R) { p0_transpose_item(F.w_router, D, NE, F.WR_T, r, 0, 0, scr, F.lane); continue; } r -= I_R;
        const int e = r / (I_GU + I_D); r -= e * (I_GU + I_D);
        if (r < I_GU) { const int nb = r % 64, kb = r / 64, n0 = nb * 32;
            const int drow = (n0 < 1024) ? ((n0 >> 7) * 256 + (n0 & 127)) : ((((n0 - 1024) >> 7) * 256) + 128 + ((n0 - 1024) & 127));
            p0_transpose_item(F.w_gate_up + (size_t)e * D * 2048, D, 2048, F.WGU_T + (size_t)e * 2048 * D, kb, n0, drow, scr, F.lane); continue; } r -= I_GU;
        { const int nb = r % 32, kb = r / 32; p0_transpose_item(F.w_down + (size_t)e * DFF * D, DFF, D, F.WD_T + (size_t)e * D * DFF, kb, nb * 32, nb * 32, scr, F.lane); }
    }
}

__device__ __forceinline__ void p1_norm(Frame& F) {
    LAS float* sc = (LAS float*)(F.lds);
    LAS float* sh = (LAS float*)(F.lds + 4096);
    for (int rg = F.vcu; rg < T / 64; rg += F.G) {
        const int b = (rg * 64) / SEQ;
        __syncthreads();
        for (int i = F.tid; i < D; i += 512) { sc[i] = F.g_pre_mix[i] * (1.0f + F.MOD[b * 6144 + 1024 + i]); sh[i] = F.MOD[b * 6144 + i]; }
        __syncthreads();
        for (int rr = 0; rr < 8; ++rr) {
            const int row = rg * 64 + F.wave * 8 + rr;
            const GAS f32x4* xr = (const GAS f32x4*)(F.x + (size_t)row * D) + F.lane;
            f32x4 v[4]; float s = 0.f;
#pragma unroll
            for (int j = 0; j < 4; ++j) { v[j] = xr[64 * j]; s += (v[j].x * v[j].x + v[j].y * v[j].y) + (v[j].z * v[j].z + v[j].w * v[j].w); }
            const float rinv = 1.0f / sqrtf(wave_sum(s) * (1.0f / D) + EPS);
            GAS v2u* o8 = (GAS v2u*)(F.H + (size_t)row * D) + F.lane;
#pragma unroll
            for (int j = 0; j < 4; ++j) { const f32x4 a = *(const LAS f32x4*)(sc + 4 * F.lane + 256 * j), c = *(const LAS f32x4*)(sh + 4 * F.lane + 256 * j);
                const f32x4 h = (v[j] * rinv) * a + c; v2u w; w.x = pk2(h.x, h.y); w.y = pk2(h.z, h.w); o8[64 * j] = w; }
        }
    }
}

__device__ __forceinline__ f32x4 mfma16(bf16x8 a, bf16x8 b, f32x4 c) { return __builtin_amdgcn_mfma_f32_16x16x32_bf16(a, b, c, 0, 0, 0); }
__device__ __forceinline__ void attn_unit(Frame& F, int unit) {
    const int qb = unit & 63, g = (unit >> 6) & 1, b = unit >> 7;
    LAS bf16* KL = (LAS bf16*)F.lds;
    LAS bf16* VT = (LAS bf16*)(F.lds + 384 * 72 * 2);
    const int kbase = qb * 128 - 128;
    __syncthreads();
    for (int idx = F.tid; idx < 384 * 8; idx += 512) {
        const int r = idx >> 3, ch = idx & 7, kp = kbase + r;
        v4u kv = {0u, 0u, 0u, 0u}, vv = {0u, 0u, 0u, 0u};
        if (kp >= 0 && kp < SEQ) { const bf16* rowp = F.PROJ + (size_t)(b * SEQ + kp) * DINP; kv = *(const v4u*)(rowp + C_AK + g * 64 + ch * 8); vv = *(const v4u*)(rowp + C_AV + g * 64 + ch * 8); }
        *(LAS v4u*)(KL + r * 72 + ch * 8) = kv;
        LAS bf16* vp = VT + (ch * 8) * 392 + r;
        vp[0 * 392] = (bf16)(vv.x & 0xffffu); vp[1 * 392] = (bf16)(vv.x >> 16); vp[2 * 392] = (bf16)(vv.y & 0xffffu); vp[3 * 392] = (bf16)(vv.y >> 16);
        vp[4 * 392] = (bf16)(vv.z & 0xffffu); vp[5 * 392] = (bf16)(vv.z >> 16); vp[6 * 392] = (bf16)(vv.w & 0xffffu); vp[7 * 392] = (bf16)(vv.w >> 16);
    }
    __syncthreads();
    const int fr = F.lane & 15, fq = F.lane >> 4;
    const int hq = 4 * g + (F.wave >> 1);
    const float sink = F.attn_sink[hq];
    constexpr float L2E = 1.44269504f;
#pragma unroll 1
    for (int rt = 0; rt < 4; ++rt) {
        const int tq0 = 64 * (F.wave & 1) + 16 * rt;
        const int qrow = b * SEQ + qb * 128 + tq0 + fr;
        const bf16* qp = F.PROJ + (size_t)qrow * DINP + C_AQ + hq * 64 + 8 * fq;
        const bf16x8 qf0 = *(const bf16x8*)(qp), qf1 = *(const bf16x8*)(qp + 32);
        int kt0 = tq0 >> 4; kt0 = kt0 > 6 ? 6 : kt0;
        f32x4 sc[18];
#pragma unroll
        for (int jj = 0; jj < 18; ++jj) {
            const LAS bf16* kp = KL + ((kt0 + jj) * 16 + fr) * 72 + 8 * fq;
            const bf16x8 k0 = *(const LAS bf16x8*)(kp), k1 = *(const LAS bf16x8*)(kp + 32);
            f32x4 a = {0.f, 0.f, 0.f, 0.f};
            a = mfma16(k0, qf0, a); a = mfma16(k1, qf1, a);
            sc[jj] = a;
        }
        const int tq = tq0 + fr;
        float m = sink;
#pragma unroll
        for (int jj = 0; jj < 18; ++jj)
#pragma unroll
            for (int r = 0; r < 4; ++r) {
                const int ki = (kt0 + jj) * 16 + 4 * fq + r, kp = kbase + ki;
                const bool valid = (ki >= tq) && (ki <= tq + 256) && (kp >= 0) && (kp < SEQ);
                sc[jj][r] = valid ? sc[jj][r] : -1e30f;
                m = fmaxf(m, sc[jj][r]);
            }
        m = fmaxf(m, __shfl_xor(m, 16)); m = fmaxf(m, __shfl_xor(m, 32));
        float sum = 0.f;
#pragma unroll
        for (int jj = 0; jj < 18; ++jj)
#pragma unroll
            for (int r = 0; r < 4; ++r) { const float p = __builtin_amdgcn_exp2f((sc[jj][r] - m) * L2E); sc[jj][r] = p; sum += p; }
        sum += __shfl_xor(sum, 16); sum += __shfl_xor(sum, 32);
        sum += __builtin_amdgcn_exp2f((sink - m) * L2E);
        const float rden = 1.0f / sum;
        f32x4 o[4];
#pragma unroll
        for (int dt = 0; dt < 4; ++dt) o[dt] = (f32x4){0.f, 0.f, 0.f, 0.f};
#pragma unroll
        for (int kk = 0; kk < 9; ++kk) {
            v4u pw; pw.x = pg8::cvt_pk_bf16(sc[2 * kk][0], sc[2 * kk][1]); pw.y = pg8::cvt_pk_bf16(sc[2 * kk][2], sc[2 * kk][3]);
            pw.z = pg8::cvt_pk_bf16(sc[2 * kk + 1][0], sc[2 * kk + 1][1]); pw.w = pg8::cvt_pk_bf16(sc[2 * kk + 1][2], sc[2 * kk + 1][3]);
            const bf16x8 pf = __builtin_bit_cast(bf16x8, pw);
#pragma unroll
            for (int dt = 0; dt < 4; ++dt) {
                const LAS bf16* vp = VT + (16 * dt + fr) * 392 + (kt0 + 2 * kk) * 16 + 4 * fq;
                const v2u va = *(const LAS v2u*)(vp), vb = *(const LAS v2u*)(vp + 16);
                v4u vw; vw.x = va.x; vw.y = va.y; vw.z = vb.x; vw.w = vb.y;
                o[dt] = mfma16(__builtin_bit_cast(bf16x8, vw), pf, o[dt]);
            }
        }
        bf16* op = F.O + (size_t)qrow * D + 512 + hq * 64 + 4 * fq;
#pragma unroll
        for (int dt = 0; dt < 4; ++dt) { v2u w; w.x = pg8::cvt_pk_bf16(o[dt][0] * rden, o[dt][1] * rden); w.y = pg8::cvt_pk_bf16(o[dt][2] * rden, o[dt][3] * rden); *(v2u*)(op + 16 * dt) = w; }
    }
}

struct GlaGates { float b0[8], b1[8]; float all0, ref0, all1, ref1; };
__device__ __forceinline__ float log_sigmoid(float z) { return fminf(z, 0.f) - __logf(1.0f + __expf(-fabsf(z))); }
__device__ __forceinline__ void gla_gates(Frame& F, int b, int h, int c, LAS float* GLR, LAS float* TOT, GlaGates& G) {
    const int ig = F.wave, d = F.lane;
    const size_t row0 = (size_t)b * SEQ + (size_t)c * 64;
    if (F.tid < 256) { const int r = F.tid >> 2, ch = F.tid & 3;
        const v4u w = *(const v4u*)(F.PROJ + (row0 + r) * DINP + C_GLR + ch * 8);
        LAS float* gp = GLR + r * 32 + ch * 8;
        gp[0] = bflo(w.x); gp[1] = bfhi(w.x); gp[2] = bflo(w.y); gp[3] = bfhi(w.y); gp[4] = bflo(w.z); gp[5] = bfhi(w.z); gp[6] = bflo(w.w); gp[7] = bfhi(w.w); }
    float wf[16], wb[16];
#pragma unroll
    for (int r = 0; r < 16; ++r) { wf[r] = F.w_gk_fwd[r * 256 + h * 64 + d]; wb[r] = F.w_gk_bwd[r * 256 + h * 64 + d]; }
    const float bf_ = F.b_gk_fwd[h * 64 + d], bb_ = F.b_gk_bwd[h * 64 + d];
    __syncthreads();
    float la0[8], la1[8];
#pragma unroll
    for (int kk = 0; kk < 8; ++kk) {
        const LAS float* gp = GLR + (8 * ig + kk) * 32;
        float z0 = bf_, z1 = bb_;
#pragma unroll
        for (int r = 0; r < 16; ++r) { z0 += gp[r] * wf[r]; z1 += gp[16 + r] * wb[r]; }
        la0[kk] = log_sigmoid(z0) * (1.0f / 16.0f); la1[kk] = log_sigmoid(z1) * (1.0f / 16.0f);
    }
#pragma unroll
    for (int kk = 1; kk < 8; ++kk) la0[kk] += la0[kk - 1];
#pragma unroll
    for (int kk = 6; kk >= 0; --kk) la1[kk] += la1[kk + 1];
    TOT[(0 * 8 + ig) * 64 + d] = la0[7]; TOT[(1 * 8 + ig) * 64 + d] = la1[0];
    __syncthreads();
    float off0 = 0.f, all0 = 0.f, ref0 = 0.f, off1 = 0.f, all1 = 0.f, ref1 = 0.f;
#pragma unroll
    for (int g = 0; g < 8; ++g) {
        const float t0 = TOT[(0 * 8 + g) * 64 + d], t1 = TOT[(1 * 8 + g) * 64 + d];
        all0 += t0; all1 += t1; off0 += (g < ig) ? t0 : 0.f; off1 += (g > ig) ? t1 : 0.f; ref0 += (g < 4) ? t0 : 0.f; ref1 += (g >= 4) ? t1 : 0.f;
    }
#pragma unroll
    for (int kk = 0; kk < 8; ++kk) { G.b0[kk] = la0[kk] + off0; G.b1[kk] = la1[kk] + off1; }
    G.all0 = all0; G.ref0 = ref0; G.all1 = all1; G.ref1 = ref1;
}
__device__ __forceinline__ void gla_load_vt(Frame& F, size_t row0, int h, LAS bf16* VTp, int stride) {
    const int v = F.tid & 127, jg = F.tid >> 7;
    const bf16* vp = F.PROJ + (row0 + 16 * jg) * DINP + C_GV + h * 128 + v;
    unsigned w[8];
#pragma unroll
    for (int e = 0; e < 8; ++e) { const unsigned lo = vp[(size_t)(2 * e) * DINP], hi = vp[(size_t)(2 * e + 1) * DINP]; w[e] = lo | (hi << 16); }
    LAS v4u* dp = (LAS v4u*)(VTp + v * stride + 16 * jg);
    dp[0] = (v4u){w[0], w[1], w[2], w[3]}; dp[1] = (v4u){w[4], w[5], w[6], w[7]};
}
__device__ __forceinline__ size_t gla_idx(int dir, int b, int h, int c) { return (size_t)(((dir * 2 + b) * 4 + h) * NCH + c); }

__device__ __forceinline__ void gla_a_unit(Frame& F, int unit) {
    const int c = unit & 127, h = (unit >> 7) & 3, b = unit >> 9;
    LAS float* GLR = (LAS float*)(F.lds); LAS float* TOT = (LAS float*)(F.lds + 8192);
    LAS bf16* KT = (LAS bf16*)(F.lds + 12288);
    LAS bf16* VTp = (LAS bf16*)(F.lds + 12288 + 18432);
    const size_t row0 = (size_t)b * SEQ + (size_t)c * 64;
    __syncthreads();
    GlaGates G; gla_gates(F, b, h, c, GLR, TOT, G);
    const int ig = F.wave, d = F.lane;
    {
        unsigned w0[4], w1[4];
#pragma unroll
        for (int e = 0; e < 4; ++e) {
            const float ka = bf2f(F.PROJ[(row0 + 8 * ig + 2 * e) * DINP + C_GK + h * 64 + d]), kb = bf2f(F.PROJ[(row0 + 8 * ig + 2 * e + 1) * DINP + C_GK + h * 64 + d]);
            w0[e] = pk2(ka * __expf(G.all0 - G.b0[2 * e]), kb * __expf(G.all0 - G.b0[2 * e + 1]));
            w1[e] = pk2(ka * __expf(G.all1 - G.b1[2 * e]), kb * __expf(G.all1 - G.b1[2 * e + 1]));
        }
        *(LAS v4u*)(KT + d * 72 + 8 * ig) = (v4u){w0[0], w0[1], w0[2], w0[3]};
        *(LAS v4u*)(KT + (64 + d) * 72 + 8 * ig) = (v4u){w1[0], w1[1], w1[2], w1[3]};
        if (ig == 0) { F.DEC[gla_idx(0, b, h, c) * 64 + d] = __expf(G.all0); F.DEC[gla_idx(1, b, h, c) * 64 + d] = __expf(G.all1); }
    }
    gla_load_vt(F, row0, h, VTp, 72);
    __syncthreads();
    const int fr = F.lane & 15, fq = F.lane >> 4, w = F.wave;
    const LAS bf16* ap = KT + (16 * w + fr) * 72 + 8 * fq;
    const bf16x8 a0 = *(const LAS bf16x8*)(ap), a1 = *(const LAS bf16x8*)(ap + 32);
    float* up = F.UT + gla_idx(w >> 2, b, h, c) * 8192 + 16 * (w & 3) + 4 * fq;
#pragma unroll
    for (int vt = 0; vt < 8; ++vt) {
        const LAS bf16* bp = VTp + (16 * vt + fr) * 72 + 8 * fq;
        f32x4 acc = {0.f, 0.f, 0.f, 0.f};
        acc = mfma16(a0, *(const LAS bf16x8*)(bp), acc); acc = mfma16(a1, *(const LAS bf16x8*)(bp + 32), acc);
        *(f32x4*)(up + (size_t)(16 * vt + fr) * 64) = acc;
    }
}
__device__ __forceinline__ void gla_scan(Frame& F) {
    for (int gid = F.vcu * 512 + F.tid; gid < 16 * 8192; gid += F.G * 512) {
        const int stream = gid >> 13, e = gid & 8191, d = e & 63, dir = stream >> 3;
        float s = 0.f;
#pragma unroll 8
        for (int n = 0; n < NCH; ++n) {
            const int c = dir ? (NCH - 1 - n) : n; const size_t idx = (size_t)stream * NCH + c;
            const float u = F.UT[idx * 8192 + e], dc = F.DEC[idx * 64 + d];
            F.ST[idx * 8192 + e] = (bf16)f2bf(s);
            s = s * dc + u;
        }
    }
}
__device__ __forceinline__ void gla_c_unit(Frame& F, int unit) {
    const int c = unit & 127, h = (unit >> 7) & 3, b = unit >> 9;
    LAS float* GLR = (LAS float*)(F.lds); LAS float* TOT = (LAS float*)(F.lds + 8192);
    LAS bf16* QS = (LAS bf16*)(F.lds + 12288);
    LAS bf16* KS = (LAS bf16*)(F.lds + 30720);
    LAS bf16* AC = (LAS bf16*)(F.lds + 49152);
    LAS bf16* BC = (LAS bf16*)(F.lds + 74752);
    LAS float* SSQ = (LAS float*)(F.lds + 125952);
    const size_t row0 = (size_t)b * SEQ + (size_t)c * 64;
    __syncthreads();
    GlaGates G; gla_gates(F, b, h, c, GLR, TOT, G);
    const int ig = F.wave, d = F.lane;
#pragma unroll
    for (int kk = 0; kk < 8; ++kk) {
        const int i = 8 * ig + kk;
        const float q = bf2f(F.PROJ[(row0 + i) * DINP + C_GQ + h * 64 + d]), k = bf2f(F.PROJ[(row0 + i) * DINP + C_GK + h * 64 + d]);
        QS[(0 * 64 + i) * 72 + d] = (bf16)f2bf(q * __expf(G.b0[kk] - G.ref0)); KS[(0 * 64 + i) * 72 + d] = (bf16)f2bf(k * __expf(G.ref0 - G.b0[kk]));
        QS[(1 * 64 + i) * 72 + d] = (bf16)f2bf(q * __expf(G.b1[kk] - G.ref1)); KS[(1 * 64 + i) * 72 + d] = (bf16)f2bf(k * __expf(G.ref1 - G.b1[kk]));
        AC[i * 200 + 64 + d] = (bf16)f2bf(q * __expf(G.b0[kk])); AC[i * 200 + 128 + d] = (bf16)f2bf(q * __expf(G.b1[kk]));
    }
    gla_load_vt(F, row0, h, BC, 200);
#pragma unroll
    for (int rep = 0; rep < 4; ++rep) { const int q = F.tid + 512 * (rep & 1), dir = rep >> 1, v = q >> 3, d8 = q & 7;
        *(LAS v4u*)(BC + v * 200 + 64 + dir * 64 + d8 * 8) = *(const v4u*)(F.ST + gla_idx(dir, b, h, c) * 8192 + v * 64 + d8 * 8); }
    __syncthreads();
    const int fr = F.lane & 15, fq = F.lane >> 4, w = F.wave;
    {
        const int it = w & 3, jp = w >> 2;
        bf16x8 qf[2][2];
#pragma unroll
        for (int dir = 0; dir < 2; ++dir)
#pragma unroll
            for (int ks = 0; ks < 2; ++ks) qf[dir][ks] = *(const LAS bf16x8*)(QS + (dir * 64 + 16 * it + fr) * 72 + 32 * ks + 8 * fq);
#pragma unroll
        for (int jj = 0; jj < 2; ++jj) {
            const int jt = 2 * jp + jj;
            f32x4 s0 = {0.f, 0.f, 0.f, 0.f}, s1 = {0.f, 0.f, 0.f, 0.f};
#pragma unroll
            for (int ks = 0; ks < 2; ++ks) {
                s0 = mfma16(*(const LAS bf16x8*)(KS + (0 * 64 + 16 * jt + fr) * 72 + 32 * ks + 8 * fq), qf[0][ks], s0);
                s1 = mfma16(*(const LAS bf16x8*)(KS + (1 * 64 + 16 * jt + fr) * 72 + 32 * ks + 8 * fq), qf[1][ks], s1);
            }
            const int i = 16 * it + fr; float sv[4];
#pragma unroll
            for (int r = 0; r < 4; ++r) { const int j = 16 * jt + 4 * fq + r; sv[r] = ((j <= i) ? s0[r] : 0.f) + ((j >= i) ? s1[r] : 0.f); }
            v2u pw; pw.x = pk2(sv[0], sv[1]); pw.y = pk2(sv[2], sv[3]);
            *(LAS v2u*)(AC + i * 200 + 16 * jt + 4 * fq) = pw;
        }
    }
    __syncthreads();
    f32x4 o[4];
#pragma unroll
    for (int it = 0; it < 4; ++it) o[it] = (f32x4){0.f, 0.f, 0.f, 0.f};
#pragma unroll
    for (int ks = 0; ks < 6; ++ks) {
        const bf16x8 bfr = *(const LAS bf16x8*)(BC + (16 * w + fr) * 200 + 32 * ks + 8 * fq);
#pragma unroll
        for (int it = 0; it < 4; ++it) o[it] = mfma16(bfr, *(const LAS bf16x8*)(AC + (16 * it + fr) * 200 + 32 * ks + 8 * fq), o[it]);
    }
#pragma unroll
    for (int it = 0; it < 4; ++it) { float s = (o[it][0] * o[it][0] + o[it][1] * o[it][1]) + (o[it][2] * o[it][2] + o[it][3] * o[it][3]);
        s += __shfl_xor(s, 16); s += __shfl_xor(s, 32); if (fq == 0) SSQ[w * 64 + 16 * it + fr] = s; }
    __syncthreads();
    const f32x4 gv = *(const f32x4*)(F.g_gla_out + 16 * w + 4 * fq);
#pragma unroll
    for (int it = 0; it < 4; ++it) {
        const int i = 16 * it + fr; float s = 0.f;
#pragma unroll
        for (int ww = 0; ww < 8; ++ww) s += SSQ[ww * 64 + i];
        const float rinv = 1.0f / sqrtf(s * (1.0f / 128.0f) + EPS);
        const v2u gw = *(const v2u*)(F.PROJ + (row0 + i) * DINP + C_GG + h * 128 + 16 * w + 4 * fq);
        const float g0 = bflo(gw.x), g1 = bfhi(gw.x), g2 = bflo(gw.y), g3 = bfhi(gw.y);
        const float r0 = o[it][0] * rinv * gv[0] * (g0 / (1.0f + __expf(-g0))), r1 = o[it][1] * rinv * gv[1] * (g1 / (1.0f + __expf(-g1)));
        const float r2 = o[it][2] * rinv * gv[2] * (g2 / (1.0f + __expf(-g2))), r3 = o[it][3] * rinv * gv[3] * (g3 / (1.0f + __expf(-g3)));
        v2u ow; ow.x = pk2(r0, r1); ow.y = pk2(r2, r3);
        *(v2u*)(F.O + (row0 + i) * D + h * 128 + 16 * w + 4 * fq) = ow;
    }
}

__device__ __forceinline__ void p7_rows(Frame& F) {
    LAS bf16* WR = (LAS bf16*)(F.lds);
    LAS float* A1 = (LAS float*)(F.lds + 66048);
    LAS float* B2 = A1 + 1024;
    LAS float* C2 = B2 + 1024;
    LAS int* HIST = (LAS int*)(C2 + 1024);
    LAS int* BASE = HIST + 32;
    __syncthreads();
    for (int idx = F.tid; idx < 32 * 128; idx += 512) { const int e = idx >> 7, ch = idx & 127; *(LAS v4u*)(WR + e * 1032 + ch * 8) = *(const v4u*)(F.WR_T + e * 1024 + ch * 8); }
    const int fr = F.lane & 15, fq = F.lane >> 4;
    for (int rg = F.vcu; rg < T / 64; rg += F.G) {
        const int b = (rg * 64) / SEQ;
        __syncthreads();
        for (int i = F.tid; i < D; i += 512) { const float* md = F.MOD + b * 6144;
            A1[i] = md[2048 + i] * F.g_post_mix[i]; B2[i] = F.g_pre_ffn[i] * (1.0f + md[4096 + i]); C2[i] = md[3072 + i]; }
        if (F.tid < 32) HIST[F.tid] = 0;
        __syncthreads();
        for (int rr = 0; rr < 8; ++rr) {
            const int row = rg * 64 + F.wave * 8 + rr;
            const GAS f32x4* yr = (const GAS f32x4*)(F.Y + (size_t)row * D) + F.lane;
            const GAS f32x4* xr = (const GAS f32x4*)(F.x + (size_t)row * D) + F.lane;
            f32x4 y[4], xv[4]; float s = 0.f;
#pragma unroll
            for (int j = 0; j < 4; ++j) { y[j] = yr[64 * j]; xv[j] = xr[64 * j]; s += (y[j].x * y[j].x + y[j].y * y[j].y) + (y[j].z * y[j].z + y[j].w * y[j].w); }
            const float rinv1 = 1.0f / sqrtf(wave_sum(s) * (1.0f / D) + EPS);
            float s2 = 0.f;
            GAS f32x4* o1 = (GAS f32x4*)(F.out + (size_t)row * D) + F.lane;
#pragma unroll
            for (int j = 0; j < 4; ++j) { const f32x4 a = *(const LAS f32x4*)(A1 + 4 * F.lane + 256 * j);
                xv[j] = xv[j] + a * (y[j] * rinv1); o1[64 * j] = xv[j];
                s2 += (xv[j].x * xv[j].x + xv[j].y * xv[j].y) + (xv[j].z * xv[j].z + xv[j].w * xv[j].w); }
            const float rinv2 = 1.0f / sqrtf(wave_sum(s2) * (1.0f / D) + EPS);
            GAS v2u* o8 = (GAS v2u*)(F.H2 + (size_t)row * D) + F.lane;
#pragma unroll
            for (int j = 0; j < 4; ++j) { const f32x4 a = *(const LAS f32x4*)(B2 + 4 * F.lane + 256 * j), c = *(const LAS f32x4*)(C2 + 4 * F.lane + 256 * j);
                const f32x4 h = (xv[j] * rinv2) * a + c; v2u w; w.x = pk2(h.x, h.y); w.y = pk2(h.z, h.w); o8[64 * j] = w; }
        }
        VM_WAIT();
        __syncthreads();
        int myi = 0, myslot = 0; float myg = 0.f;
        if (F.wave < 4) {
            const int r0 = rg * 64 + F.wave * 16;
            f32x4 acc0 = {0.f, 0.f, 0.f, 0.f}, acc1 = {0.f, 0.f, 0.f, 0.f};
            const bf16* hp = F.H2 + (size_t)(r0 + fr) * D + 8 * fq;
#pragma unroll 8
            for (int ks = 0; ks < 32; ++ks) {
                const bf16x8 bfr = *(const bf16x8*)(hp + 32 * ks);
                acc0 = mfma16(*(const LAS bf16x8*)(WR + fr * 1032 + 32 * ks + 8 * fq), bfr, acc0);
                acc1 = mfma16(*(const LAS bf16x8*)(WR + (16 + fr) * 1032 + 32 * ks + 8 * fq), bfr, acc1);
            }
            float v[8];
#pragma unroll
            for (int r = 0; r < 4; ++r) { v[r] = acc0[r] + F.b_router[4 * fq + r]; v[4 + r] = acc1[r] + F.b_router[16 + 4 * fq + r]; }
            float tv[4]; int ti[4];
#pragma unroll
            for (int t = 0; t < 4; ++t) {
                float bv = -3.0e38f; int bi = 0;
#pragma unroll
                for (int q = 0; q < 8; ++q) { const int id = (q >> 2) * 16 + 4 * fq + (q & 3); if (v[q] > bv) { bv = v[q]; bi = id; } }
#pragma unroll
                for (int o = 16; o <= 32; o <<= 1) { const float pv = __shfl_xor(bv, o); const int pi = __shfl_xor(bi, o); if (pv > bv || (pv == bv && pi < bi)) { bv = pv; bi = pi; } }
                tv[t] = bv; ti[t] = bi;
#pragma unroll
                for (int q = 0; q < 8; ++q) { const int id = (q >> 2) * 16 + 4 * fq + (q & 3); if (id == bi) v[q] = -3.0e38f; }
            }
            const float e1 = __expf(tv[1] - tv[0]), e2 = __expf(tv[2] - tv[0]), e3 = __expf(tv[3] - tv[0]);
            const float rs = 1.0f / (1.0f + e1 + e2 + e3);
            myi = fq == 0 ? ti[0] : fq == 1 ? ti[1] : fq == 2 ? ti[2] : ti[3];
            myg = (fq == 0 ? 1.0f : fq == 1 ? e1 : fq == 2 ? e2 : e3) * rs;
            myslot = atomicAdd((int*)(HIST + myi), 1);
        }
        __syncthreads();
        if (F.tid < 32) BASE[F.tid] = (int)__hip_atomic_fetch_add((unsigned*)(F.ctl + CW_CNT + F.tid), (unsigned)HIST[F.tid], RLX_AGENT);
        __syncthreads();
        if (F.wave < 4) {
            const int asg = (rg * 64 + F.wave * 16 + fr) * 4 + fq;
            F.LIST[(size_t)myi * LCAP + BASE[myi] + myslot] = asg;
            F.GATE[asg] = myg;
        }
    }
}

__device__ __forceinline__ void p10_final(Frame& F) {
    LAS float* A2 = (LAS float*)(F.lds);
    for (int rg = F.vcu; rg < T / 64; rg += F.G) {
        const int b = (rg * 64) / SEQ;
        __syncthreads();
        for (int i = F.tid; i < D; i += 512) A2[i] = F.MOD[b * 6144 + 5120 + i] * F.g_post_ffn[i];
        __syncthreads();
        for (int rr = 0; rr < 8; ++rr) {
            const int row = rg * 64 + F.wave * 8 + rr;
            f32x4 ys[4];
#pragma unroll
            for (int j = 0; j < 4; ++j) ys[j] = (f32x4){0.f, 0.f, 0.f, 0.f};
#pragma unroll
            for (int k = 0; k < 4; ++k) { const GAS v2u* yp = (const GAS v2u*)(F.Y2 + ((size_t)row * 4 + k) * D) + F.lane;
#pragma unroll
                for (int j = 0; j < 4; ++j) { const v2u w = yp[64 * j]; ys[j].x += bflo(w.x); ys[j].y += bfhi(w.x); ys[j].z += bflo(w.y); ys[j].w += bfhi(w.y); } }
            float s = 0.f;
#pragma unroll
            for (int j = 0; j < 4; ++j) s += (ys[j].x * ys[j].x + ys[j].y * ys[j].y) + (ys[j].z * ys[j].z + ys[j].w * ys[j].w);
            const float rinv = 1.0f / sqrtf(wave_sum(s) * (1.0f / D) + EPS);
            GAS f32x4* o1 = (GAS f32x4*)(F.out + (size_t)row * D) + F.lane;
#pragma unroll
            for (int j = 0; j < 4; ++j) { const f32x4 a = *(const LAS f32x4*)(A2 + 4 * F.lane + 256 * j); o1[64 * j] = o1[64 * j] + a * (ys[j] * rinv); }
        }
    }
}

struct Args { const float* in[22]; float* out; unsigned char* ws; int ph_lo, ph_hi, li, pad; };
__global__ void __launch_bounds__(NWAVES * 64, 2) fwd_megakernel(Args args) {
    extern __shared__ __attribute__((aligned(16))) unsigned char lds_raw[];
    Frame F;
    F.lds = (LAS unsigned char*)lds_raw;
    F.MISC = (volatile LAS unsigned*)(F.lds + MISC_OFF);
    F.tid = threadIdx.x; F.lane = F.tid & 63; F.wave = __builtin_amdgcn_readfirstlane(F.tid >> 6);
    F.G = gridDim.x; { const int bx = blockIdx.x; F.vcu = (F.G % 8 == 0) ? (bx % 8) * (F.G / 8) + bx / 8 : bx; }
    unsigned char* ws = args.ws;
    F.ctl = (GAS unsigned*)(ws + WS_CTL);
    F.x = args.in[0]; F.c = args.in[1]; F.w_ada = args.in[2]; F.b_ada = args.in[3]; F.g_pre_mix = args.in[4]; F.g_post_mix = args.in[5]; F.w_in = args.in[6];
    F.w_gk_fwd = args.in[7]; F.b_gk_fwd = args.in[8]; F.w_gk_bwd = args.in[9]; F.b_gk_bwd = args.in[10]; F.g_gla_out = args.in[11]; F.attn_sink = args.in[12];
    F.w_out = args.in[13]; F.g_pre_ffn = args.in[14]; F.g_post_ffn = args.in[15]; F.w_router = args.in[16]; F.b_router = args.in[17]; F.w_gate_up = args.in[18];
    F.b_gate_up = args.in[19]; F.w_down = args.in[20]; F.b_down = args.in[21]; F.out = args.out;
    F.MOD = (float*)(ws + WS_MOD); F.ROPE = (float*)(ws + WS_ROPE); F.GATE = (float*)(ws + WS_GATE); F.DEC = (float*)(ws + WS_DEC); F.UT = (float*)(ws + WS_UT); F.Y = (float*)(ws + WS_Y);
    F.WR_T = (bf16*)(ws + WS_WR_T); F.WIN_T = (bf16*)(ws + WS_WIN_T); F.WOUT_T = (bf16*)(ws + WS_WOUT_T); F.WGU_T = (bf16*)(ws + WS_WGU_T); F.WD_T = (bf16*)(ws + WS_WD_T);
    F.H = (bf16*)(ws + WS_H); F.PROJ = (bf16*)(ws + WS_PROJ); F.ST = (bf16*)(ws + WS_ST); F.O = (bf16*)(ws + WS_O); F.H2 = (bf16*)(ws + WS_H2); F.ACT = (bf16*)(ws + WS_ACT); F.Y2 = (bf16*)(ws + WS_Y2);
    F.LIST = (int*)(ws + WS_LIST);
    for (int u = F.tid; u < (LDS_BYTES - LDSCTL_OFF) / 4; u += NWAVES * 64) ((LAS unsigned*)(F.lds + LDSCTL_OFF))[u] = 0u;
    __syncthreads();
    XcdBarrier bar; bar.bar = (unsigned*)(F.ctl + CW_BAR) + args.li * XCD_BAR_WORDS; bar.x = 0; bar.st = nullptr;
    if (MK_N_LAUNCHES == 1) bar = xcd_barrier_post((unsigned*)(F.ctl + CW_BAR), F.MISC + 8);
    const int lo = args.ph_lo, hi = args.ph_hi;
#define IN(k) (lo <= (k) && (k) < hi)
#define SEAM(k) do { if (IN(k) && IN((k) + 1)) xcd_barrier(bar); } while (0)

    if (IN(0)) { p0_prologue(F); } SEAM(0);
    if (IN(1)) { p1_norm(F); } SEAM(1);
    if (IN(2)) { ProjPolicy P; P.A = F.H; P.Bt = F.WIN_T; P.K = D; P.so.init(T, DINP, F.G, (int)blockIdx.x); P.O = F.PROJ; P.rope = F.ROPE;
                 pg8::gemm_phase<ProjPolicy>(F.lds, P); } SEAM(2);
    if (IN(3)) { for (int u = F.vcu; u < 256; u += F.G) attn_unit(F, u);
                 for (int u = F.vcu; u < 1024; u += F.G) gla_a_unit(F, u); } SEAM(3);
    if (IN(4)) { gla_scan(F); } SEAM(4);
    if (IN(5)) { for (int u = F.vcu; u < 1024; u += F.G) gla_c_unit(F, u); } SEAM(5);
    if (IN(6)) { OutPolicy P; P.A = F.O; P.Bt = F.WOUT_T; P.K = D; P.so.init(T, D, F.G, (int)blockIdx.x); P.C = F.Y;
                 pg8::gemm_phase<OutPolicy>(F.lds, P); } SEAM(6);
    if (IN(7)) { p7_rows(F); } SEAM(7);
    if (IN(8) || IN(9)) {
        volatile LAS int* tb = (volatile LAS int*)(F.MISC + 16);
        __syncthreads();
        if (F.tid == 0) { int acc = 0; for (int e = 0; e < NE; ++e) { tb[e] = acc; const int cn = (int)__hip_atomic_load((unsigned*)(F.ctl + CW_CNT + e), RLX_AGENT); acc += (cn + 255) >> 8; } tb[32] = acc; }
        __syncthreads();
        if (IN(8)) { Moe1Policy P; P.tb = tb; P.cnt = (const int*)(F.ctl + CW_CNT); P.list = F.LIST; P.G = F.G; P.c = (int)blockIdx.x; P.ncol = 8;
                     P.A = F.H2; P.Bt = F.WGU_T; P.K = D; P.ACTp = F.ACT; P.bias = F.b_gate_up;
                     pg8::gemm_phase<Moe1Policy>(F.lds, P); }
        SEAM(8);
        if (IN(9)) { Moe2Policy P; P.tb = tb; P.cnt = (const int*)(F.ctl + CW_CNT); P.list = F.LIST; P.G = F.G; P.c = (int)blockIdx.x; P.ncol = 4;
                     P.A = F.ACT; P.Bt = F.WD_T; P.K = DFF; P.Y2p = F.Y2; P.bias = F.b_down; P.gate = F.GATE;
                     pg8::gemm_phase<Moe2Policy>(F.lds, P); }
    }
    SEAM(9);
    if (IN(10)) { p10_final(F); }
#undef IN
#undef SEAM
}

extern "C" void kernel_launch(void* const* d_in, const int* in_sizes, int n_in, void* d_out, int out_size, void* d_ws, size_t ws_size, hipStream_t stream) {
    static int grid = 0;
    if (grid == 0) {
        if (n_in != 22 || in_sizes[0] != T * D || out_size != T * D || ws_size < WS_END) { fprintf(stderr, "kernel_launch: unexpected shapes (n_in %d, in0 %d, out %d, ws %zu)\n", n_in, n_in > 0 ? in_sizes[0] : -1, out_size, ws_size); grid = -1; return; }
        int dev = 0, cus = 0, per_cu = 0;
        if (hipGetDevice(&dev) != hipSuccess || hipDeviceGetAttribute(&cus, hipDeviceAttributeMultiprocessorCount, dev) != hipSuccess) { grid = -1; return; }
        if (hipFuncSetAttribute((const void*)fwd_megakernel, hipFuncAttributeMaxDynamicSharedMemorySize, LDS_BYTES) != hipSuccess) { fprintf(stderr, "kernel_launch: hipFuncSetAttribute failed\n"); grid = -1; return; }
        if (hipOccupancyMaxActiveBlocksPerMultiprocessor(&per_cu, (const void*)fwd_megakernel, NWAVES * 64, LDS_BYTES) != hipSuccess || per_cu < 1)
            fprintf(stderr, "kernel_launch: note: occupancy query reports %d blocks per CU\n", per_cu);
        (void)hipGetLastError();
        grid = cus;
    }
    if (grid < 0) return;
    if (hipMemsetAsync((char*)d_ws + WS_CTL, 0, CTL_ZERO_BYTES, stream) != hipSuccess) { fprintf(stderr, "kernel_launch: memset failed\n"); return; }
    Args a{};
    for (int i = 0; i < 22; ++i) a.in[i] = (const float*)d_in[i];
    a.out = (float*)d_out; a.ws = (unsigned char*)d_ws;
    if (MK_N_LAUNCHES == 1) {
        a.ph_lo = 0; a.ph_hi = N_PHASES; a.li = 0;
        hipLaunchKernelGGL(fwd_megakernel, dim3(grid), dim3(NWAVES * 64), LDS_BYTES, stream, a);
    } else {
        for (int p = 0; p < N_PHASES; ++p) { a.ph_lo = p; a.ph_hi = p + 1; a.li = 0;
            hipLaunchKernelGGL(fwd_megakernel, dim3(grid), dim3(NWAVES * 64), LDS_BYTES, stream, a); }
    }
    const hipError_t le = hipPeekAtLastError();
    if (le != hipSuccess) fprintf(stderr, "kernel_launch: launch failed: %s\n", hipGetErrorName(le));
}
```

```cpp
#include <hip/hip_runtime.h>
#include <cstdio>
#include <cstdint>

#define GAS __attribute__((address_space(1)))
#define LAS __attribute__((address_space(3)))
typedef unsigned short bf16;
typedef unsigned v4u __attribute__((ext_vector_type(4)));
typedef unsigned v2u __attribute__((ext_vector_type(2)));
typedef float f32x4 __attribute__((ext_vector_type(4)));
typedef float f32x2 __attribute__((ext_vector_type(2)));
typedef short bf16x8 __attribute__((ext_vector_type(8)));
typedef short bf16x4 __attribute__((ext_vector_type(4)));
typedef int i32x4 __attribute__((ext_vector_type(4)));
typedef int i32x8 __attribute__((ext_vector_type(8)));

#ifndef MK_N_LAUNCHES
#define MK_N_LAUNCHES 1
#endif
constexpr int N_PHASES = 11;

constexpr int NB = 2, SEQ = 8192, T = NB * SEQ, D = 1024, DIN = 2336, DINP = 2560, NE = 32, DFF = 1024;
constexpr int C_GQ = 0, C_GK = 256, C_GV = 512, C_GG = 1024, C_GLR = 1536, C_AQ = 1568, C_AK = 2080, C_AV = 2208;
constexpr int NCH = 128;
constexpr float EPS = 1e-6f;
constexpr int LCAP = 16384;
constexpr int ACT_ROWS = 65536 + NE * 256;

constexpr size_t MiB = 1u << 20;
constexpr size_t WS_CTL = 0, CTL_ZERO_BYTES = 1 * MiB;
constexpr size_t WS_MOD = 1 * MiB;
constexpr size_t WS_ROPE = 1 * MiB + 512 * 1024;
constexpr size_t WS_WR_T = 2 * MiB;
constexpr size_t WS_WG_T = 2 * MiB + 128 * 1024;
constexpr size_t WS_LIST = 3 * MiB;
constexpr size_t WS_GATE = 5 * MiB;
constexpr size_t WS_DEC = 6 * MiB;
constexpr size_t WS_WIN_T = 8 * MiB;
constexpr size_t WS_WOUT_T = 14 * MiB;
constexpr size_t WS_WGU_T = 16 * MiB;
constexpr size_t WS_WD_T = 80 * MiB;
constexpr size_t WS_H2F8 = 112 * MiB;
constexpr size_t WS_H = 208 * MiB;
constexpr size_t WS_PROJ = 240 * MiB;
constexpr size_t WS_UT = 320 * MiB;
constexpr size_t WS_ST = 384 * MiB;
constexpr size_t WS_O = 416 * MiB;
constexpr size_t WS_Y = 448 * MiB;
constexpr size_t WS_H2 = 512 * MiB;
constexpr size_t WS_ACT = 544 * MiB;
constexpr size_t WS_Y2 = 688 * MiB;
constexpr size_t WS_END = 816 * MiB;
constexpr int CW_CNT = 64;
constexpr int CW_BAR = 4096;

constexpr int RING_BYTES = 131072;
constexpr int LDSCTL_OFF = RING_BYTES, MISC_OFF = LDSCTL_OFF + 320;
constexpr int LDS_BYTES = 147456;
constexpr int NWAVES = 8;

#define RLX_AGENT __ATOMIC_RELAXED, __HIP_MEMORY_SCOPE_AGENT
#define LDS_WAIT() asm volatile("s_waitcnt lgkmcnt(0)" ::: "memory")
#define VM_WAIT() asm volatile("s_waitcnt vmcnt(0)" ::: "memory")
__device__ __forceinline__ unsigned f2bf(float f) { unsigned u = __builtin_bit_cast(unsigned, f); return (u + 0x7fffu + ((u >> 16) & 1u)) >> 16; }
__device__ __forceinline__ unsigned pk2(float lo, float hi) { return f2bf(lo) | (f2bf(hi) << 16); }
__device__ __forceinline__ float bf2f(unsigned v) { return __builtin_bit_cast(float, v << 16); }
__device__ __forceinline__ float bflo(unsigned w) { return __builtin_bit_cast(float, w << 16); }
__device__ __forceinline__ float bfhi(unsigned w) { return __builtin_bit_cast(float, w & 0xffff0000u); }
constexpr float YSC = 16.0f, YSC_INV = 1.0f / 16.0f;
constexpr float WSC = 64.0f, WSC_INV = 1.0f / 64.0f, ASC = 4.0f;
__device__ __forceinline__ float sat8(float x) { return __builtin_amdgcn_fmed3f(x, -448.0f, 448.0f); }
__device__ __forceinline__ unsigned pk4_fp8(float a, float b, float c, float d) { int w = 0; w = __builtin_amdgcn_cvt_pk_fp8_f32(a, b, w, false); w = __builtin_amdgcn_cvt_pk_fp8_f32(c, d, w, true); return (unsigned)w; }
__device__ __forceinline__ float wave_sum(float v) {
#pragma unroll
    for (int o = 1; o < 64; o <<= 1) v += __shfl_xor(v, o);
    return v;
}

#define XB_TMO      128
#define XB_XCNT(j)  (256  + 64 * (j))
#define XB_XSUB(j)  (1280 + 64 * (j))
#define XB_XGEN(j)  (2304 + 64 * (j))
#define XB_TOP      3328
#define XB_TOPGEN   3392
#define XCD_BAR_WORDS 3456
#define XB_SPIN_CAP (1u << 18)
__device__ __forceinline__ unsigned xb_ld(unsigned* p)              { return __hip_atomic_load(p, __ATOMIC_RELAXED, __HIP_MEMORY_SCOPE_AGENT); }
__device__ __forceinline__ unsigned xb_add(unsigned* p, unsigned v) { return __hip_atomic_fetch_add(p, v, __ATOMIC_RELAXED, __HIP_MEMORY_SCOPE_AGENT); }
__device__ __forceinline__ unsigned xb_xcc_id() { return (unsigned)__builtin_amdgcn_s_getreg((3 << 11) | 20) & 0xFu; }
#define XB_SPIN(cond, bar) do { unsigned _sp = 0; while (cond) { __builtin_amdgcn_s_sleep(1); \
    if ((++_sp & 255u) == 0u) { if (xb_ld(&(bar)[XB_TMO])) break; if (_sp > XB_SPIN_CAP) { atomicAdd(&(bar)[XB_TMO], 1u); break; } } } } while (0)
struct XcdBarrier { unsigned* bar; unsigned x; volatile LAS unsigned* st; };
__device__ __forceinline__ XcdBarrier xcd_barrier_post(unsigned* bar, volatile LAS unsigned* st) {
    XcdBarrier b; b.bar = bar; b.x = xb_xcc_id(); b.st = st;
    if (threadIdx.x == 0) (void)xb_add(&bar[XB_XCNT(b.x)], 1u);
    return b;
}
__device__ __forceinline__ void xcd_barrier_complete(unsigned* bar, unsigned x, unsigned& nloc, unsigned& nx) {
    const unsigned G = gridDim.x * gridDim.y * gridDim.z;
    unsigned sum, cnt, mine, sp = 0u;
    for (;;) {
        sum = 0u; cnt = 0u; mine = 0u;
#pragma unroll
        for (unsigned j = 0; j < 16; ++j) { const unsigned c = xb_ld(&bar[XB_XCNT(j)]); sum += c; cnt += (c > 0u) ? 1u : 0u; mine = (j == x) ? c : mine; }
        if (sum == G) break;
        __builtin_amdgcn_s_sleep(1);
        if ((++sp & 255u) == 0u) { if (xb_ld(&bar[XB_TMO])) break; if (sp > XB_SPIN_CAP) { atomicAdd(&bar[XB_TMO], 1u); break; } }
    }
    nloc = mine > 0u ? mine : 1u; nx = cnt > 0u ? cnt : 1u;
}
__device__ __forceinline__ void xcd_barrier(const XcdBarrier& b) {
    asm volatile("s_waitcnt vmcnt(0)" ::: "memory");
    __syncthreads();
    if (threadIdx.x == 0) {
        unsigned* bar = b.bar;
        __builtin_amdgcn_s_waitcnt(0);
        unsigned nloc = b.st[0], nx = b.st[1];
        if (nloc == 0u) { xcd_barrier_complete(bar, b.x, nloc, nx); b.st[0] = nloc; b.st[1] = nx; }
        const unsigned old = xb_add(&bar[XB_XSUB(b.x)], 1u);
        const unsigned gen = old / nloc;
        if (old + 1u == (gen + 1u) * nloc) {
            __builtin_amdgcn_fence(__ATOMIC_RELEASE, "agent");
            asm volatile("s_waitcnt vmcnt(0)" ::: "memory");
            const unsigned og = xb_add(&bar[XB_TOP], 1u);
            const unsigned tg = og / nx;
            if (og + 1u == (tg + 1u) * nx) xb_add(&bar[XB_TOPGEN], 1u);
            else XB_SPIN(xb_ld(&bar[XB_TOPGEN]) == tg, bar);
            __builtin_amdgcn_fence(__ATOMIC_ACQUIRE, "agent");
            xb_add(&bar[XB_XGEN(b.x)], 1u);
            asm volatile("s_waitcnt vmcnt(0)" ::: "memory");
        } else {
            XB_SPIN(xb_ld(&bar[XB_XGEN(b.x)]) == gen, bar);
            __builtin_amdgcn_fence(__ATOMIC_ACQUIRE, "agent");
            asm volatile("s_waitcnt vmcnt(0)" ::: "memory");
        }
    }
    __syncthreads();
}

namespace pg8 {
constexpr int BM = 256, BK = 64, HALF = 128, HTB = HALF * BK * 2, NXCD = 8, WGM = 8;
__device__ __forceinline__ int lds_byte(int r, int c) { const int st = (r >> 4) * 2 + (c >> 5), rr = r & 15, cc = c & 31, ob = rr * 64 + cc * 2; return st * 1024 + (ob ^ (((ob >> 9) & 1) << 5)); }
__device__ __forceinline__ void stage_rc(int b, int& R, int& C) { const int st = b / 1024, sb = b % 1024, swz = sb ^ (((sb >> 9) & 1) << 5); R = (st >> 1) * 16 + swz / 64; C = (st & 1) * 32 + (swz % 64) / 2; }
__device__ __forceinline__ int perm32(int rho) { const int n = rho >> 4, i = rho & 15; return 8 * (i >> 2) + 4 * n + (i & 3); }
struct Unit { int pm, pn, e, nrows; };
__device__ __forceinline__ unsigned cvt_pk_bf16(float lo, float hi) { unsigned r; asm volatile("v_cvt_pk_bf16_f32 %0, %1, %2" : "=v"(r) : "v"(lo), "v"(hi)); return r; }

struct StaticOrder {
    int nM, nN, nwg, G, c;
    __device__ void init(int M, int N, int G_, int c_) { nM = M / BM; nN = N / BM; nwg = nM * nN; G = G_; c = c_; }
    __device__ bool next(int i, int& pm, int& pn) const {
        const long L = (long)i * G + c; if (L >= nwg) return false;
        int wgid = (int)L; { const int q = nwg / NXCD, r = nwg % NXCD, xcd = wgid % NXCD, off = wgid / NXCD; wgid = (xcd < r ? xcd * (q + 1) : r * (q + 1) + (xcd - r) * q) + off; }
        const int nig = WGM * nN, gid = wgid / nig, fm = gid * WGM, gsz = (nM - fm) < WGM ? (nM - fm) : WGM;
        pm = fm + ((wgid % nig) % gsz); pn = (wgid % nig) / gsz; return true;
    }
};

template <class P>
__device__ __forceinline__ void gemm_phase(LAS unsigned char* lds, const P& S) {
    const int tid = threadIdx.x, wid = __builtin_amdgcn_readfirstlane(tid >> 6), lane = tid & 63, wr = wid >> 2, wc = wid & 3, fr = lane & 15, fq = lane >> 4;
    const int KB = S.KB, nt = KB / 128;
    int RA[2], CA[2]; unsigned voffB[2];
#pragma unroll
    for (int i = 0; i < 2; ++i) { int R, C; stage_rc(tid * 16 + i * 8192, R, C); RA[i] = R; CA[i] = C * 2; const int Rb = P::PERM ? ((R & ~31) + perm32(R & 31)) : R; voffB[i] = (unsigned)(Rb * KB + C * 2); }
    const unsigned kstep = 128u;
    const unsigned hstepB = (unsigned)HALF * KB;
    const unsigned ldsw = (unsigned)wid * 1024u;
    const int aoff = lds_byte(wr * 64 + fr, fq * 8), boff = lds_byte(wc * 32 + fr, fq * 8);
    constexpr int HI = 1024;
    const __amdgpu_buffer_rsrc_t rsA = __builtin_amdgcn_make_buffer_rsrc((void*)S.A, 0, 0x7fffffff, 0x00020000);
    const __amdgpu_buffer_rsrc_t rsB = __builtin_amdgcn_make_buffer_rsrc((void*)S.Bt, 0, 0x7fffffff, 0x00020000);
#define PG8_SA(b, h) (((b) * 2 + (h)) * HTB)
#define PG8_SB(b, h) ((4 + (b) * 2 + (h)) * HTB)
#define PG8_STGB(bufoff, gbase) do { _Pragma("unroll") for (int _i = 0; _i < 2; ++_i) \
        __builtin_amdgcn_raw_ptr_buffer_load_lds(rsB, (LAS void*)(lds + (bufoff) + ldsw + _i * 8192), 16, voffB[_i], (int)(gbase), 0, 0); } while (0)
#define PG8_STGA(bufoff, kb, o0, o1) do { \
        __builtin_amdgcn_raw_ptr_buffer_load_lds(rsA, (LAS void*)(lds + (bufoff) + ldsw), 16, (o0), (int)(kb), 0, 0); \
        __builtin_amdgcn_raw_ptr_buffer_load_lds(rsA, (LAS void*)(lds + (bufoff) + ldsw + 8192), 16, (o1), (int)(kb), 0, 0); } while (0)
#define PG8_LDA(dst, b, h) do { _Pragma("unroll") for (int m = 0; m < 4; ++m) _Pragma("unroll") for (int k = 0; k < 2; ++k) dst[m][k] = *(const LAS bf16x8*)(lds + PG8_SA(b, h) + aoff + m * 2048 + k * HI); } while (0)
#define PG8_LDB(dst, b, h) do { _Pragma("unroll") for (int n = 0; n < 2; ++n) _Pragma("unroll") for (int k = 0; k < 2; ++k) dst[n][k] = *(const LAS bf16x8*)(lds + PG8_SB(b, h) + boff + n * 2048 + k * HI); } while (0)
#define PG8_CAT(x) __builtin_shufflevector(__builtin_bit_cast(i32x4, (x)[0]), __builtin_bit_cast(i32x4, (x)[1]), 0, 1, 2, 3, 4, 5, 6, 7)
#define PG8_MMA(ai, bj, At, Bt) do { __builtin_amdgcn_s_setprio(1); _Pragma("unroll") for (int m = 0; m < 4; ++m) _Pragma("unroll") for (int n = 0; n < 2; ++n) { \
        if constexpr (P::F8) { const i32x8 a8 = PG8_CAT(Bt[n]), b8 = PG8_CAT(At[m]); asm volatile("v_mfma_f32_16x16x128_f8f6f4 %0, %1, %2, %0" : "+v"(acc[ai][bj][m][n]) : "v"(a8), "v"(b8)); } \
        else { _Pragma("unroll") for (int k = 0; k < 2; ++k) acc[ai][bj][m][n] = __builtin_amdgcn_mfma_f32_16x16x32_bf16(Bt[n][k], At[m][k], acc[ai][bj][m][n], 0, 0, 0); } } \
        __builtin_amdgcn_s_setprio(0); } while (0)
#define PG8_WAIT_V(n) asm volatile("s_waitcnt vmcnt(" #n ")" ::: "memory")
#define PG8_WAIT_L(n) asm volatile("s_waitcnt lgkmcnt(" #n ")" ::: "memory")
#define PG8_BAR __builtin_amdgcn_s_barrier()
#define PG8_SCHED __builtin_amdgcn_sched_barrier(0)
    Unit cur, nxt; int ui = 0;
    if (!S.next(0, cur)) return;
    f32x4 acc[2][2][4][2];
#pragma unroll
    for (int a = 0; a < 2; ++a)
#pragma unroll
        for (int b = 0; b < 2; ++b)
#pragma unroll
            for (int m = 0; m < 4; ++m)
#pragma unroll
                for (int n = 0; n < 2; ++n) acc[a][b][m][n] = (f32x4){0.f, 0.f, 0.f, 0.f};
    bf16x8 At[4][2], B0[2][2], B1[2][2];
    unsigned c00, c01, c10, c11, n00, n01, n10, n11;
    typename P::Pre pre;
    S.aoff(cur, RA[0], RA[1], CA[0], CA[1], c00, c01, c10, c11);
    if constexpr (P::LIST_LDS) { if (wr == 0) S.list_dma(cur, 0, wid, lane); }
    unsigned cB = S.boffs(cur);
    PG8_STGB(PG8_SB(0, 0), cB); PG8_STGB(PG8_SB(0, 1), cB + hstepB); PG8_STGA(PG8_SA(0, 0), 0, c00, c01); PG8_STGA(PG8_SA(0, 1), 0, c10, c11);
    if (wr == 1) PG8_BAR;
    PG8_WAIT_V(2); PG8_BAR;
    PG8_STGB(PG8_SB(1, 0), cB + kstep); PG8_STGA(PG8_SA(1, 0), kstep, c00, c01); PG8_STGB(PG8_SB(1, 1), cB + hstepB + kstep);
    PG8_WAIT_V(6); PG8_BAR;
    for (;;) {
        const bool has_next = S.next(ui + 1, nxt);
        unsigned nB = cB;
        n00 = c00; n01 = c01; n10 = c10; n11 = c11;
        if (has_next) { if constexpr (!P::LIST_LDS) S.aoff(nxt, RA[0], RA[1], CA[0], CA[1], n00, n01, n10, n11); nB = S.boffs(nxt); }
        for (int t = 0; t < nt; t += 2) {
            const bool last = (t == nt - 2);
            if constexpr (P::LIST_LDS) { if (last && has_next) S.aoff_lds(nxt, (ui + 1) & 1, RA[0], RA[1], CA[0], CA[1], n00, n01, n10, n11); }

            const unsigned k1 = (unsigned)(t + 1) * kstep;
            const unsigned k2 = last ? 0u : (unsigned)(t + 2) * kstep, k3 = k2 + kstep;
            const unsigned b2 = last ? nB : cB + (unsigned)(t + 2) * kstep, b3 = b2 + kstep;
            const unsigned x00 = last ? n00 : c00, x01 = last ? n01 : c01, x10 = last ? n10 : c10, x11 = last ? n11 : c11;
            PG8_LDB(B0, 0, 0); PG8_LDB(B1, 0, 1); PG8_SCHED; PG8_LDA(At, 0, 0); PG8_STGA(PG8_SA(1, 1), k1, c10, c11);
            PG8_WAIT_V(8); PG8_WAIT_L(0); PG8_BAR;
            if constexpr (P::LIST_LDS) { if (t == 0 && wr == 0) { S.bias_dma(cur, wid, lane); if (has_next) S.list_dma(nxt, (ui + 1) & 1, wid, lane); } }
            PG8_MMA(0, 0, At, B0); PG8_MMA(0, 1, At, B1); PG8_BAR; PG8_SCHED;
            PG8_LDA(At, 0, 1); PG8_STGB(PG8_SB(0, 0), b2); PG8_STGB(PG8_SB(0, 1), b2 + hstepB); PG8_STGA(PG8_SA(0, 0), k2, x00, x01);
            PG8_WAIT_V(8); PG8_WAIT_L(0); PG8_BAR; PG8_MMA(1, 0, At, B0); PG8_MMA(1, 1, At, B1); PG8_BAR; PG8_SCHED;
            PG8_LDB(B0, 1, 0); PG8_LDB(B1, 1, 1); PG8_SCHED; PG8_LDA(At, 1, 0); PG8_STGA(PG8_SA(0, 1), k2, x10, x11);
            PG8_WAIT_V(8); PG8_WAIT_L(0); PG8_BAR; PG8_MMA(0, 0, At, B0); PG8_MMA(0, 1, At, B1); PG8_BAR; PG8_SCHED;
            PG8_LDA(At, 1, 1); PG8_STGB(PG8_SB(1, 0), b3); PG8_STGB(PG8_SB(1, 1), b3 + hstepB); PG8_STGA(PG8_SA(1, 0), k3, x00, x01);
            PG8_WAIT_V(8); PG8_WAIT_L(0); PG8_BAR; PG8_MMA(1, 0, At, B0); PG8_MMA(1, 1, At, B1); PG8_BAR; PG8_SCHED;
        }
        if (wr == 0) PG8_BAR;
        if constexpr (P::F8) asm volatile("s_nop 15\n\ts_nop 15" ::: "memory");
        if (!P::DUP || (ui & 1)) { S.pre_load(cur, pre, wc, fq); S.epi(acc, cur, pre, ui & 1, wr, wc, fr, fq); }
        if (!has_next) break;
        if (!P::DUP || (ui & 1)) {
#pragma unroll
        for (int a = 0; a < 2; ++a)
#pragma unroll
            for (int b = 0; b < 2; ++b)
#pragma unroll
                for (int m = 0; m < 4; ++m)
#pragma unroll
                    for (int n = 0; n < 2; ++n) acc[a][b][m][n] = (f32x4){0.f, 0.f, 0.f, 0.f};
        }
        cur = nxt; cB = nB; c00 = n00; c01 = n01; c10 = n10; c11 = n11; ++ui;
        if (wr == 1) PG8_BAR;
    }
    PG8_WAIT_V(0);
    PG8_BAR;
#undef PG8_SA
#undef PG8_SB
#undef PG8_STGA
#undef PG8_STGB
#undef PG8_LDA
#undef PG8_LDB
#undef PG8_MMA
#undef PG8_WAIT_V
#undef PG8_WAIT_L
#undef PG8_BAR
#undef PG8_SCHED
}
}

struct Frame {
    LAS unsigned char* lds;
    volatile LAS unsigned* MISC;
    GAS unsigned* ctl;
    int tid, lane, wave, vcu, G;
    const float *x, *c, *w_ada, *b_ada, *g_pre_mix, *g_post_mix, *w_in, *w_gk_fwd, *b_gk_fwd, *w_gk_bwd, *b_gk_bwd, *g_gla_out, *attn_sink, *w_out,
                *g_pre_ffn, *g_post_ffn, *w_router, *b_router, *w_gate_up, *b_gate_up, *w_down, *b_down;
    float* out;
    float *MOD, *ROPE, *GATE, *DEC, *UT; bf16* Y;
    bf16 *WR_T, *WIN_T, *WOUT_T, *H, *PROJ, *ST, *O, *H2, *Y2, *WG_T;
    unsigned char *WGU_T, *WD_T, *ACT, *H2F8;
    int* LIST;
};

struct ProjPolicy {
    static constexpr bool PERM = true;
    static constexpr bool F8 = false, DUP = false, LIST_LDS = false;
    struct Pre {};
    __device__ __forceinline__ void pre_load(const pg8::Unit&, Pre&, int, int) const {}
    const bf16* A; const bf16* Bt; int KB; pg8::StaticOrder so; bf16* O; const float* rope;
    __device__ __forceinline__ bool next(int i, pg8::Unit& u) const { u.e = 0; u.nrows = 256; return so.next(i, u.pm, u.pn); }
    __device__ __forceinline__ void aoff(const pg8::Unit& u, int R0, int R1, int C0, int C1, unsigned& o00, unsigned& o01, unsigned& o10, unsigned& o11) const {
        const unsigned b = (unsigned)u.pm * 256u;
        o00 = (b + R0) * KB + C0; o01 = (b + R1) * KB + C1; o10 = (b + 128 + R0) * KB + C0; o11 = (b + 128 + R1) * KB + C1;
    }
    __device__ __forceinline__ unsigned boffs(const pg8::Unit& u) const { return (unsigned)u.pn * 256u * KB; }
    __device__ __forceinline__ void epi(const f32x4 (&acc)[2][2][4][2], const pg8::Unit& u, const Pre&, int, int wr, int wc, int fr, int fq) const {
        const int row0 = u.pm * 256 + wr * 64 + fr;
#pragma unroll
        for (int bj = 0; bj < 2; ++bj) {
            const int cb = u.pn * 256 + bj * 128 + wc * 32;
            const float sc = (cb < C_GK || (cb >= C_AQ && cb < C_AK)) ? 0.125f : 1.f;
            const bool rot = (cb >= C_AQ) && (cb < C_AV) && (((cb - C_AQ) & 63) == 0);
            const float sg = (fq == 0) ? -1.f : 1.f;
#pragma unroll
            for (int ai = 0; ai < 2; ++ai)
#pragma unroll
                for (int m = 0; m < 4; ++m) {
                    const int row = row0 + ai * 128 + m * 16;
                    f32x4 v0 = acc[ai][bj][m][0], v1 = acc[ai][bj][m][1];
                    if (rot) {
                        const float* rp = rope + (size_t)(row & (SEQ - 1)) * 16;
                        const f32x4 c0 = *(const f32x4*)(rp), c1 = *(const f32x4*)(rp + 4), s0 = *(const f32x4*)(rp + 8), s1 = *(const f32x4*)(rp + 12);
                        f32x4 p0, p1;
#pragma unroll
                        for (int j = 0; j < 4; ++j) { p0[j] = __shfl_xor(v0[j], 16); p1[j] = __shfl_xor(v1[j], 16); }
                        if (fq < 2) { v0 = v0 * c0 + (p0 * s0) * sg; v1 = v1 * c1 + (p1 * s1) * sg; }
                    }
                    v0 = v0 * sc; v1 = v1 * sc;
                    v4u w; w.x = pg8::cvt_pk_bf16(v0[0], v0[1]); w.y = pg8::cvt_pk_bf16(v0[2], v0[3]); w.z = pg8::cvt_pk_bf16(v1[0], v1[1]); w.w = pg8::cvt_pk_bf16(v1[2], v1[3]);
                    *(v4u*)(O + (size_t)row * DINP + cb + 8 * fq) = w;
                }
        }
    }
};
struct OutPolicy {
    static constexpr bool PERM = true;
    static constexpr bool F8 = false, DUP = false, LIST_LDS = false;
    struct Pre {};
    __device__ __forceinline__ void pre_load(const pg8::Unit&, Pre&, int, int) const {}
    const bf16* A; const bf16* Bt; int KB; pg8::StaticOrder so; bf16* C;
    __device__ __forceinline__ bool next(int i, pg8::Unit& u) const { u.e = 0; u.nrows = 256; return so.next(i, u.pm, u.pn); }
    __device__ __forceinline__ void aoff(const pg8::Unit& u, int R0, int R1, int C0, int C1, unsigned& o00, unsigned& o01, unsigned& o10, unsigned& o11) const {
        const unsigned b = (unsigned)u.pm * 256u;
        o00 = (b + R0) * KB + C0; o01 = (b + R1) * KB + C1; o10 = (b + 128 + R0) * KB + C0; o11 = (b + 128 + R1) * KB + C1;
    }
    __device__ __forceinline__ unsigned boffs(const pg8::Unit& u) const { return (unsigned)u.pn * 256u * KB; }
    __device__ __forceinline__ void epi(const f32x4 (&acc)[2][2][4][2], const pg8::Unit& u, const Pre&, int, int wr, int wc, int fr, int fq) const {
        const int row0 = u.pm * 256 + wr * 64 + fr, col0 = u.pn * 256 + wc * 32 + 8 * fq;
#pragma unroll
        for (int ai = 0; ai < 2; ++ai)
#pragma unroll
            for (int m = 0; m < 4; ++m) { bf16* rowp = C + (size_t)(row0 + ai * 128 + m * 16) * D + col0;
#pragma unroll
                for (int bj = 0; bj < 2; ++bj) { const f32x4 v0 = acc[ai][bj][m][0], v1 = acc[ai][bj][m][1];
                    v4u w; w.x = pg8::cvt_pk_bf16(v0[0], v0[1]); w.y = pg8::cvt_pk_bf16(v0[2], v0[3]); w.z = pg8::cvt_pk_bf16(v1[0], v1[1]); w.w = pg8::cvt_pk_bf16(v1[2], v1[3]);
                    *(v4u*)(rowp + bj * 128) = w; } }
    }
};
struct MoePolicyBase {
    const volatile LAS int* tb; const volatile LAS int* rtab; const int* cnt; const int* list; int G, c, ncol;
    __device__ __forceinline__ bool next_rt(int i, pg8::Unit& u) const {
        const int NT = tb[32];
        int rt, pn;
        if ((G & 7) == 0) {
            const int x = c & 7, j = c >> 3, per = G >> 3, base = NT >> 3, rem = NT & 7, len = base + (x < rem ? 1 : 0), start = x * base + (x < rem ? x : rem);
            const int uidx = i * per + j, rl = uidx / ncol; if (rl >= len) return false;
            rt = start + rl; pn = uidx - rl * ncol;
        } else { const int L = i * G + c; if (L >= NT * ncol) return false; rt = L / ncol; pn = L - rt * ncol; }
        const int w = rtab[rt];
        u.pn = pn; u.pm = rt; u.e = w & 255; u.nrows = (w >> 8) & 511; return true;
    }
    __device__ __forceinline__ int slot0(const pg8::Unit& u) const { return (int)((unsigned)rtab[u.pm] >> 17); }
    LAS unsigned char* llds;
    __device__ __forceinline__ void list_dma(const pg8::Unit& u, int buf, int wid, int lane) const {
        const __amdgpu_buffer_rsrc_t rs = __builtin_amdgcn_make_buffer_rsrc((void*)list, 0, 0x7fffffff, 0x00020000);
        __builtin_amdgcn_raw_ptr_buffer_load_lds(rs, (LAS void*)(llds + buf * 1024 + wid * 256), 4, (unsigned)(wid * 256 + lane * 4), (int)(((unsigned)u.e * LCAP + (unsigned)slot0(u)) * 4u), 0, 0);
    }
    __device__ __forceinline__ void lds16x4(unsigned a0, unsigned a1, unsigned a2, unsigned a3, f32x4& v0, f32x4& v1, f32x4& v2, f32x4& v3) const {
        asm volatile("ds_read_b128 %0, %4\n\tds_read_b128 %1, %5\n\tds_read_b128 %2, %6\n\tds_read_b128 %3, %7\n\ts_waitcnt lgkmcnt(0)"
                     : "=&v"(v0), "=&v"(v1), "=&v"(v2), "=&v"(v3) : "v"(a0), "v"(a1), "v"(a2), "v"(a3) : "memory");
    }
    __device__ __forceinline__ void list_lds4(int buf, int r0, int r1, int r2, int r3, int& v0, int& v1, int& v2, int& v3) const {
        const unsigned base = (unsigned)(uintptr_t)(llds + buf * 1024);
        asm volatile("ds_read_b32 %0, %4\n\tds_read_b32 %1, %5\n\tds_read_b32 %2, %6\n\tds_read_b32 %3, %7\n\ts_waitcnt lgkmcnt(0)"
                     : "=&v"(v0), "=&v"(v1), "=&v"(v2), "=&v"(v3) : "v"(base + r0 * 4), "v"(base + r1 * 4), "v"(base + r2 * 4), "v"(base + r3 * 4) : "memory");
    }
};
struct Moe1Policy : MoePolicyBase {
#ifdef PROBE_DUP1
    static constexpr bool PERM = true, F8 = true, DUP = true, LIST_LDS = false;
    static constexpr float DSC = 0.5f;
#else
    static constexpr bool PERM = true, F8 = true, DUP = false, LIST_LDS = true;
    static constexpr float DSC = 1.0f;
#endif
    struct Pre { f32x4 g0, g1, u0, u1; };
    const unsigned char* A; const unsigned char* Bt; int KB; unsigned char* ACTp; const float* bias;
    __device__ __forceinline__ bool next(int i, pg8::Unit& u) const { return next_rt(DUP ? (i >> 1) : i, u); }
    __device__ __forceinline__ void bias_dma(const pg8::Unit& u, int wid, int lane) const {
        const __amdgpu_buffer_rsrc_t rs = __builtin_amdgcn_make_buffer_rsrc((void*)bias, 0, 0x7fffffff, 0x00020000);
        __builtin_amdgcn_raw_ptr_buffer_load_lds(rs, (LAS void*)(llds + 2048 + wid * 256), 4, (unsigned)((((wid & 1) * 64 + lane) + (wid >> 1) * 1024) * 4), (int)(((unsigned)u.e * 2048u + (unsigned)u.pn * 128u) * 4u), 0, 0);
    }
    __device__ __forceinline__ void pre_load(const pg8::Unit&, Pre& p, int wc, int fq) const {
        const unsigned a = (unsigned)(uintptr_t)(llds + 2048) + (unsigned)(wc * 32 + 8 * fq) * 4u;
        lds16x4(a, a + 16, a + 512, a + 528, p.g0, p.g1, p.u0, p.u1);
    }
    __device__ __forceinline__ void offs(const pg8::Unit& u, int R0, int R1, int C0, int C1, int v00, int v01, int v10, int v11, unsigned& o00, unsigned& o01, unsigned& o10, unsigned& o11) const {
        const int t00 = (R0 < u.nrows) ? ((v00 & 0xffff) >> 2) : 0, t01 = (R1 < u.nrows) ? ((v01 & 0xffff) >> 2) : 0;
        const int t10 = (R0 + 128 < u.nrows) ? ((v10 & 0xffff) >> 2) : 0, t11 = (R1 + 128 < u.nrows) ? ((v11 & 0xffff) >> 2) : 0;
        o00 = (unsigned)t00 * KB + C0; o01 = (unsigned)t01 * KB + C1; o10 = (unsigned)t10 * KB + C0; o11 = (unsigned)t11 * KB + C1;
    }
    __device__ __forceinline__ void aoff(const pg8::Unit& u, int R0, int R1, int C0, int C1, unsigned& o00, unsigned& o01, unsigned& o10, unsigned& o11) const {
        const int* lp = list + (size_t)u.e * LCAP + slot0(u);
        const int v00 = lp[R0], v01 = lp[R1], v10 = lp[R0 + 128], v11 = lp[R1 + 128];
        offs(u, R0, R1, C0, C1, v00, v01, v10, v11, o00, o01, o10, o11);
    }
    __device__ __forceinline__ void aoff_lds(const pg8::Unit& u, int buf, int R0, int R1, int C0, int C1, unsigned& o00, unsigned& o01, unsigned& o10, unsigned& o11) const {
        int v00, v01, v10, v11; list_lds4(buf, R0, R1, R0 + 128, R1 + 128, v00, v01, v10, v11);
        offs(u, R0, R1, C0, C1, v00, v01, v10, v11, o00, o01, o10, o11);
    }
    __device__ __forceinline__ unsigned boffs(const pg8::Unit& u) const { return ((unsigned)u.e * 2048u + (unsigned)u.pn * 256u) * KB; }
    __device__ __forceinline__ void epi(const f32x4 (&acc)[2][2][4][2], const pg8::Unit& u, const Pre& p, int, int wr, int wc, int fr, int fq) const {
        const int row0 = u.pm * 256 + wr * 64 + fr, col0 = u.pn * 128 + wc * 32 + 8 * fq;
        const f32x4 g0 = p.g0, g1 = p.g1, u0 = p.u0, u1 = p.u1;
#pragma unroll
        for (int ai = 0; ai < 2; ++ai)
#pragma unroll
            for (int m = 0; m < 4; ++m) {
                float a[8];
#pragma unroll
                for (int n = 0; n < 2; ++n)
#pragma unroll
                    for (int hh = 0; hh < 2; ++hh) {
                        const f32x2 ga = {acc[ai][0][m][n][2 * hh], acc[ai][0][m][n][2 * hh + 1]}, ua = {acc[ai][1][m][n][2 * hh], acc[ai][1][m][n][2 * hh + 1]};
                        const f32x2 gb = n ? (f32x2){g1[2 * hh], g1[2 * hh + 1]} : (f32x2){g0[2 * hh], g0[2 * hh + 1]};
                        const f32x2 ub = n ? (f32x2){u1[2 * hh], u1[2 * hh + 1]} : (f32x2){u0[2 * hh], u0[2 * hh + 1]};
                        f32x2 g = ga * (WSC_INV * DSC) + gb, u = ua * (WSC_INV * DSC * ASC) + (ub + 1.0f) * ASC;
                        g.x = fminf(g.x, 7.0f); g.y = fminf(g.y, 7.0f);
                        u.x = __builtin_amdgcn_fmed3f(u.x, -6.0f * ASC, 8.0f * ASC); u.y = __builtin_amdgcn_fmed3f(u.y, -6.0f * ASC, 8.0f * ASC);
                        const f32x2 t = g * (-1.702f * 1.44269504f);
                        f32x2 e; e.x = __builtin_amdgcn_exp2f(t.x); e.y = __builtin_amdgcn_exp2f(t.y);
                        e = e + 1.0f;
                        f32x2 sg; sg.x = __builtin_amdgcn_rcpf(e.x); sg.y = __builtin_amdgcn_rcpf(e.y);
                        const f32x2 r = (u * g) * sg;
                        a[n * 4 + 2 * hh] = r.x; a[n * 4 + 2 * hh + 1] = r.y;
                    }
                v2u w; w.x = pk4_fp8(a[0], a[1], a[2], a[3]); w.y = pk4_fp8(a[4], a[5], a[6], a[7]);
                *(v2u*)(ACTp + (size_t)(row0 + ai * 128 + m * 16) * DFF + col0) = w;
            }
    }
};
struct Moe2Policy : MoePolicyBase {
    static constexpr bool PERM = true, F8 = true, DUP = false, LIST_LDS = true;
    struct Pre { f32x4 bv[2][2]; };
    const unsigned char* A; const unsigned char* Bt; int KB; unsigned char* Y2p; const float* bias;
    __device__ __forceinline__ bool next(int i, pg8::Unit& u) const { return next_rt(i, u); }
    __device__ __forceinline__ void bias_dma(const pg8::Unit& u, int wid, int lane) const {
        const __amdgpu_buffer_rsrc_t rs = __builtin_amdgcn_make_buffer_rsrc((void*)bias, 0, 0x7fffffff, 0x00020000);
        __builtin_amdgcn_raw_ptr_buffer_load_lds(rs, (LAS void*)(llds + 2048 + wid * 256), 4, (unsigned)((wid * 64 + lane) * 4), (int)(((unsigned)u.e * 1024u + (unsigned)u.pn * 256u) * 4u), 0, 0);
    }
    __device__ __forceinline__ void pre_load(const pg8::Unit&, Pre& p, int wc, int fq) const {
        const unsigned a = (unsigned)(uintptr_t)(llds + 2048) + (unsigned)(wc * 32 + 8 * fq) * 4u;
        lds16x4(a, a + 16, a + 512, a + 528, p.bv[0][0], p.bv[0][1], p.bv[1][0], p.bv[1][1]);
    }
    __device__ __forceinline__ void aoff(const pg8::Unit& u, int R0, int R1, int C0, int C1, unsigned& o00, unsigned& o01, unsigned& o10, unsigned& o11) const {
        const unsigned b = (unsigned)u.pm * 256u;
        o00 = (b + R0) * KB + C0; o01 = (b + R1) * KB + C1; o10 = (b + 128 + R0) * KB + C0; o11 = (b + 128 + R1) * KB + C1;
    }
    __device__ __forceinline__ void aoff_lds(const pg8::Unit& u, int, int R0, int R1, int C0, int C1, unsigned& o00, unsigned& o01, unsigned& o10, unsigned& o11) const { aoff(u, R0, R1, C0, C1, o00, o01, o10, o11); }
    __device__ __forceinline__ unsigned boffs(const pg8::Unit& u) const { return ((unsigned)u.e * 1024u + (unsigned)u.pn * 256u) * KB; }
    __device__ __forceinline__ void epi(const f32x4 (&acc)[2][2][4][2], const pg8::Unit& u, const Pre& p, int buf, int wr, int wc, int fr, int fq) const {
        const int colb = u.pn * 256 + wc * 32 + 8 * fq;
        int ent[2][4];
#pragma unroll
        for (int ai = 0; ai < 2; ++ai) { const int r = ai * 128 + wr * 64 + fr; list_lds4(buf, r, r + 16, r + 32, r + 48, ent[ai][0], ent[ai][1], ent[ai][2], ent[ai][3]); }
#pragma unroll
        for (int ai = 0; ai < 2; ++ai)
#pragma unroll
            for (int m = 0; m < 4; ++m) {
                const int r = ai * 128 + wr * 64 + m * 16 + fr;
                if (r < u.nrows) {
                    const int asg = ent[ai][m] & 0xffff; const float g = bf2f((unsigned)ent[ai][m] >> 16);
                    unsigned char* rowp = Y2p + (size_t)asg * D + colb;
                    const float gs = g * YSC;
#pragma unroll
                    for (int bj = 0; bj < 2; ++bj) {
                        const f32x4 v0 = (acc[ai][bj][m][0] * (WSC_INV / ASC) + p.bv[bj][0]) * gs, v1 = (acc[ai][bj][m][1] * (WSC_INV / ASC) + p.bv[bj][1]) * gs;
                        v2u w; w.x = pk4_fp8(sat8(v0[0]), sat8(v0[1]), sat8(v0[2]), sat8(v0[3])); w.y = pk4_fp8(sat8(v1[0]), sat8(v1[1]), sat8(v1[2]), sat8(v1[3]));
                        *(v2u*)(rowp + bj * 128) = w;
                    }
                }
            }
    }
};

__device__ __forceinline__ void p0_cvt_bf16_item(const float* W, int K, int N, bf16* WT, int kb, int n0, int drow0, int lane) {
    const int n = lane & 31, q = lane >> 5; const float* src = W + (size_t)(64 * kb + 32 * q) * N + n0 + n;
    float v[32];
#pragma unroll
    for (int i = 0; i < 32; ++i) v[i] = src[(size_t)i * N];
    GAS v4u* dst = (GAS v4u*)(WT + (size_t)(drow0 + n) * K + 64 * kb + 32 * q);
#pragma unroll
    for (int j = 0; j < 4; ++j) { v4u o; o.x = pk2(v[8 * j], v[8 * j + 1]); o.y = pk2(v[8 * j + 2], v[8 * j + 3]); o.z = pk2(v[8 * j + 4], v[8 * j + 5]); o.w = pk2(v[8 * j + 6], v[8 * j + 7]); dst[j] = o; }
}
struct F8Desc { const float* src; unsigned char* dst; int N; };
__device__ __forceinline__ F8Desc p0_f8_desc(const Frame& F, int it, int lane) {
    constexpr int I_GU = 8 * 64, I_D = 8 * 32;
    const int e = it / (I_GU + I_D); int r = it - e * (I_GU + I_D);
    const int n4 = lane & 7, kg = lane >> 3;
    F8Desc d;
    if (r < I_GU) { const int nb = r & 63, kb = r >> 6, n0 = nb * 32;
        const int drow = (n0 < 1024) ? ((n0 >> 7) * 256 + (n0 & 127)) : ((((n0 - 1024) >> 7) * 256) + 128 + ((n0 - 1024) & 127));
        d.N = 2048; d.src = F.w_gate_up + (size_t)e * D * 2048 + (size_t)(128 * kb + 16 * kg) * 2048 + n0 + 4 * n4;
        d.dst = F.WGU_T + ((size_t)e * 2048 + drow + 4 * n4) * D + 128 * kb + 16 * kg; }
    else { r -= I_GU; const int nb = r & 31, kb = r >> 5, n0 = nb * 32;
        d.N = D; d.src = F.w_down + (size_t)e * DFF * D + (size_t)(128 * kb + 16 * kg) * D + n0 + 4 * n4;
        d.dst = F.WD_T + ((size_t)e * D + n0 + 4 * n4) * DFF + 128 * kb + 16 * kg; }
    return d;
}
__device__ __forceinline__ void p0_f8_load(f32x4 (&v)[16], const F8Desc& d) {
#pragma unroll
    for (int i = 0; i < 16; ++i) v[i] = __builtin_nontemporal_load((const f32x4*)(d.src + (size_t)i * d.N));
}
__device__ __forceinline__ void p0_f8_store(const f32x4 (&v)[16], const F8Desc& d) {
#pragma unroll
    for (int c = 0; c < 4; ++c) { v4u o;
        o.x = pk4_fp8(v[0][c] * WSC, v[1][c] * WSC, v[2][c] * WSC, v[3][c] * WSC); o.y = pk4_fp8(v[4][c] * WSC, v[5][c] * WSC, v[6][c] * WSC, v[7][c] * WSC);
        o.z = pk4_fp8(v[8][c] * WSC, v[9][c] * WSC, v[10][c] * WSC, v[11][c] * WSC); o.w = pk4_fp8(v[12][c] * WSC, v[13][c] * WSC, v[14][c] * WSC, v[15][c] * WSC);
        __builtin_nontemporal_store(o, (v4u*)(d.dst + (size_t)c * D)); }
}
__device__ __forceinline__ void p0_prologue(Frame& F) {
    const int gw = F.vcu * NWAVES + F.wave, NGW = F.G * NWAVES;
    {
        LAS float* cact = (LAS float*)(F.lds);
        LAS float* red = (LAS float*)(F.lds + 8192);
        for (int i = F.tid; i < 2048; i += 512) { const float v = F.c[i]; cact[i] = v / (1.0f + __expf(-v)); }
        __syncthreads();
        for (int it = F.vcu; it < 256; it += F.G) {
            const int col = F.lane % 24, kp = F.lane / 24, j = it * 24 + col, k0 = F.wave * 128;
            float a0 = 0.f, a1 = 0.f;
            if (kp < 2) {
#pragma unroll 16
                for (int k = 0; k < 64; ++k) { const int kk = k0 + 2 * k + kp; const float w = F.w_ada[(size_t)kk * 6144 + j]; a0 += cact[kk] * w; a1 += cact[1024 + kk] * w; }
            }
            a0 += __shfl(a0, (F.lane + 24) & 63); a1 += __shfl(a1, (F.lane + 24) & 63);
            if (F.lane < 24) { red[(F.wave * 2 + 0) * 24 + col] = a0; red[(F.wave * 2 + 1) * 24 + col] = a1; }
            __syncthreads();
            if (F.tid < 48) { const int b = F.tid / 24, cc = F.tid % 24; float s = F.b_ada[it * 24 + cc];
#pragma unroll
                for (int w = 0; w < 8; ++w) s += red[(w * 2 + b) * 24 + cc];
                F.MOD[b * 6144 + it * 24 + cc] = s; }
            __syncthreads();
        }
    }
    for (int idx = (F.vcu * 512 + F.tid); idx < SEQ * 8; idx += F.G * 512) {
        const int t = idx >> 3, i = idx & 7;
        const float inv = powf(500000.0f, -(float)i / 8.0f);
        const float ang = (float)t * inv;
        const double rev = (double)ang * 0.15915494309189535;
        const float fr = (float)(rev - rint(rev));
        F.ROPE[t * 16 + i] = __builtin_amdgcn_cosf(fr); F.ROPE[t * 16 + 8 + i] = __builtin_amdgcn_sinf(fr);
    }
    for (int idx = F.vcu * 512 + F.tid; idx < 2 * 256 * 16; idx += F.G * 512) { const int dir = idx >> 12, n = (idx >> 4) & 255, r = idx & 15;
        F.WG_T[idx] = (bf16)f2bf((dir ? F.w_gk_bwd : F.w_gk_fwd)[r * 256 + n]); }
    { v4u z = {0u, 0u, 0u, 0u}; GAS v4u* p = (GAS v4u*)(F.WIN_T + (size_t)DIN * D); const int n = (DINP - DIN) * D * 2 / 16;
      for (int i = F.vcu * 512 + F.tid; i < n; i += F.G * 512) p[i] = z; }
    constexpr int I_IN = 16 * (DIN / 32), I_OUT = 16 * 32, I_R = 16;
    for (int it = gw; it < I_IN + I_OUT + I_R; it += NGW) {
        int r = it;
        if (r < I_IN) { const int nb = r % (DIN / 32), kb = r / (DIN / 32); p0_cvt_bf16_item(F.w_in, D, DIN, F.WIN_T, kb, nb * 32, nb * 32, F.lane); continue; } r -= I_IN;
        if (r < I_OUT) { const int nb = r % 32, kb = r / 32; p0_cvt_bf16_item(F.w_out, D, D, F.WOUT_T, kb, nb * 32, nb * 32, F.lane); continue; } r -= I_OUT;
        p0_cvt_bf16_item(F.w_router, D, NE, F.WR_T, r, 0, 0, F.lane);
    }
}
constexpr int N8_ITEMS = NE * (8 * 64 + 8 * 32), K8 = 10, NB8 = K8 * 256, NA8 = N8_ITEMS - NB8;
#ifndef NG2
#define NG2 128
#endif
template <int LIST> __device__ __forceinline__ int f8_item(int v) {
    if (LIST == 0) { if (v < (NE - K8) * 768) return v; const int w = v - (NE - K8) * 768; return (NE - K8 + (w >> 9)) * 768 + (w & 511); }
    return (NE - K8 + (v >> 8)) * 768 + 512 + (v & 255);
}
template <int LIST> __device__ __forceinline__ void p0_f8_convert(Frame& F, int lo, int hi, int wv, int nw) {
    f32x4 va[16], vb[16];
    int it = lo + wv;
    if (it < hi) p0_f8_load(va, p0_f8_desc(F, f8_item<LIST>(it), F.lane));
    for (; it < hi; it += 2 * nw) {
        const bool hb = it + nw < hi, ha = it + 2 * nw < hi;
        if (hb) p0_f8_load(vb, p0_f8_desc(F, f8_item<LIST>(it + nw), F.lane));
        p0_f8_store(va, p0_f8_desc(F, f8_item<LIST>(it), F.lane));
        if (ha) p0_f8_load(va, p0_f8_desc(F, f8_item<LIST>(it + 2 * nw), F.lane));
        if (hb) p0_f8_store(vb, p0_f8_desc(F, f8_item<LIST>(it + nw), F.lane));
    }
}

__device__ __forceinline__ void p1_norm(Frame& F) {
    LAS float* sc = (LAS float*)(F.lds);
    LAS float* sh = (LAS float*)(F.lds + 4096);
    for (int rg = F.vcu; rg < T / 64; rg += F.G) {
        const int b = (rg * 64) / SEQ;
        __syncthreads();
        for (int i = F.tid; i < D; i += 512) { sc[i] = F.g_pre_mix[i] * (1.0f + F.MOD[b * 6144 + 1024 + i]); sh[i] = F.MOD[b * 6144 + i]; }
        __syncthreads();
        for (int rr = 0; rr < 8; ++rr) {
            const int row = rg * 64 + F.wave * 8 + rr;
            const GAS f32x4* xr = (const GAS f32x4*)(F.x + (size_t)row * D) + F.lane;
            f32x4 v[4]; float s = 0.f;
#pragma unroll
            for (int j = 0; j < 4; ++j) { v[j] = xr[64 * j]; s += (v[j].x * v[j].x + v[j].y * v[j].y) + (v[j].z * v[j].z + v[j].w * v[j].w); }
            const float rinv = 1.0f / sqrtf(wave_sum(s) * (1.0f / D) + EPS);
            GAS v2u* o8 = (GAS v2u*)(F.H + (size_t)row * D) + F.lane;
#pragma unroll
            for (int j = 0; j < 4; ++j) { const f32x4 a = *(const LAS f32x4*)(sc + 4 * F.lane + 256 * j), c = *(const LAS f32x4*)(sh + 4 * F.lane + 256 * j);
                const f32x4 h = (v[j] * rinv) * a + c; v2u w; w.x = pk2(h.x, h.y); w.y = pk2(h.z, h.w); o8[64 * j] = w; }
        }
    }
}

__device__ __forceinline__ f32x4 mfma16(bf16x8 a, bf16x8 b, f32x4 c) { return __builtin_amdgcn_mfma_f32_16x16x32_bf16(a, b, c, 0, 0, 0); }
typedef short s16x4 __attribute__((ext_vector_type(4)));
__device__ __forceinline__ v2u lds_tr16(const LAS bf16* p) { return __builtin_bit_cast(v2u, __builtin_amdgcn_ds_read_tr16_b64_v4i16((LAS s16x4*)p)); }
struct AttnLd { v4u kv[6], vv[6]; };
__device__ __forceinline__ void attn_load(const Frame& F, int unit, AttnLd& L) {
    const int qb = unit & 63, g = (unit >> 6) & 1, b = unit >> 7, kbase = qb * 128 - 128;
#pragma unroll
    for (int i = 0; i < 6; ++i) { const int idx = F.tid + 512 * i, r = idx >> 3, ch = idx & 7, kp = kbase + r;
        L.kv[i] = (v4u){0u, 0u, 0u, 0u}; L.vv[i] = (v4u){0u, 0u, 0u, 0u};
        if (kp >= 0 && kp < SEQ) { const bf16* rowp = F.PROJ + (size_t)(b * SEQ + kp) * DINP; L.kv[i] = *(const v4u*)(rowp + C_AK + g * 64 + ch * 8); L.vv[i] = *(const v4u*)(rowp + C_AV + g * 64 + ch * 8); } }
}
__device__ __forceinline__ void attn_compute(Frame& F, int unit, const AttnLd& L) {
    const int qb = unit & 63, g = (unit >> 6) & 1, b = unit >> 7;
    LAS bf16* KL = (LAS bf16*)F.lds;
    LAS bf16* VR = (LAS bf16*)(F.lds + 384 * 72 * 2);
    const int kbase = qb * 128 - 128;
    __syncthreads();
#pragma unroll
    for (int i = 0; i < 6; ++i) { const int idx = F.tid + 512 * i, r = idx >> 3, ch = idx & 7;
        *(LAS v4u*)(KL + r * 72 + ch * 8) = L.kv[i]; *(LAS v4u*)(VR + r * 80 + ch * 8) = L.vv[i]; }
    __syncthreads();
    const int fr = F.lane & 15, fq = F.lane >> 4;
    const int hq = 4 * g + (F.wave >> 1);
    const float sink = F.attn_sink[hq];
    constexpr float L2E = 1.44269504f;
    const bf16* qbase = F.PROJ + (size_t)(b * SEQ + qb * 128 + 64 * (F.wave & 1) + fr) * DINP + C_AQ + hq * 64 + 8 * fq;
    bf16x8 qn0 = *(const bf16x8*)(qbase), qn1 = *(const bf16x8*)(qbase + 32);
    const LAS bf16* vbase = VR + (4 * fq + (fr >> 2)) * 80 + 4 * (fr & 3);
#pragma unroll 1
    for (int rt = 0; rt < 4; ++rt) {
        const int tq0 = 64 * (F.wave & 1) + 16 * rt;
        const int qrow = b * SEQ + qb * 128 + tq0 + fr;
        const bf16x8 qf0 = qn0, qf1 = qn1;
        if (rt < 3) { const bf16* qp = qbase + (size_t)(16 * (rt + 1)) * DINP; qn0 = *(const bf16x8*)(qp); qn1 = *(const bf16x8*)(qp + 32); }
        int kt0 = tq0 >> 4; kt0 = kt0 > 6 ? 6 : kt0;
        f32x4 sc[18];
#pragma unroll
        for (int jj = 0; jj < 18; ++jj) {
            const LAS bf16* kp = KL + ((kt0 + jj) * 16 + fr) * 72 + 8 * fq;
            const bf16x8 k0 = *(const LAS bf16x8*)(kp), k1 = *(const LAS bf16x8*)(kp + 32);
            f32x4 a = {0.f, 0.f, 0.f, 0.f};
            a = mfma16(k0, qf0, a); a = mfma16(k1, qf1, a);
            sc[jj] = a;
        }
        const int tq = tq0 + fr;
        float m = sink;
#pragma unroll
        for (int jj = 0; jj < 18; ++jj) {
            const int k0t = (kt0 + jj) * 16;
            const bool full = (k0t >= tq0 + 15) && (k0t + 15 <= tq0 + 256) && (kbase + k0t >= 0) && (kbase + k0t + 15 < SEQ);
            if (full) {
#pragma unroll
                for (int r = 0; r < 4; ++r) m = fmaxf(m, sc[jj][r]);
            } else {
#pragma unroll
                for (int r = 0; r < 4; ++r) {
                    const int ki = k0t + 4 * fq + r, kp = kbase + ki;
                    const bool valid = (ki >= tq) && (ki <= tq + 256) && (kp >= 0) && (kp < SEQ);
                    sc[jj][r] = valid ? sc[jj][r] : -1e30f;
                    m = fmaxf(m, sc[jj][r]);
                }
            }
        }
        m = fmaxf(m, __shfl_xor(m, 16)); m = fmaxf(m, __shfl_xor(m, 32));
        float sum = 0.f; const float mL = m * L2E;
#pragma unroll
        for (int jj = 0; jj < 18; ++jj) { const f32x4 t = sc[jj] * L2E - mL;
#pragma unroll
            for (int r = 0; r < 4; ++r) { const float p = __builtin_amdgcn_exp2f(t[r]); sc[jj][r] = p; sum += p; } }
        sum += __shfl_xor(sum, 16); sum += __shfl_xor(sum, 32);
        sum += __builtin_amdgcn_exp2f((sink - m) * L2E);
        const float rden = 1.0f / sum;
        f32x4 o[4];
#pragma unroll
        for (int dt = 0; dt < 4; ++dt) o[dt] = (f32x4){0.f, 0.f, 0.f, 0.f};
#pragma unroll
        for (int kk = 0; kk < 9; ++kk) {
            v4u pw; pw.x = pg8::cvt_pk_bf16(sc[2 * kk][0], sc[2 * kk][1]); pw.y = pg8::cvt_pk_bf16(sc[2 * kk][2], sc[2 * kk][3]);
            pw.z = pg8::cvt_pk_bf16(sc[2 * kk + 1][0], sc[2 * kk + 1][1]); pw.w = pg8::cvt_pk_bf16(sc[2 * kk + 1][2], sc[2 * kk + 1][3]);
            const bf16x8 pf = __builtin_bit_cast(bf16x8, pw);
#pragma unroll
            for (int dt = 0; dt < 4; ++dt) {
                const LAS bf16* vp = vbase + (kt0 + 2 * kk) * 1280 + 16 * dt;
                const v2u va = lds_tr16(vp), vb = lds_tr16(vp + 1280);
                v4u vw; vw.x = va.x; vw.y = va.y; vw.z = vb.x; vw.w = vb.y;
                o[dt] = mfma16(__builtin_bit_cast(bf16x8, vw), pf, o[dt]);
            }
        }
        bf16* op = F.O + (size_t)qrow * D + 512 + hq * 64 + 4 * fq;
#pragma unroll
        for (int dt = 0; dt < 4; ++dt) { v2u w; w.x = pg8::cvt_pk_bf16(o[dt][0] * rden, o[dt][1] * rden); w.y = pg8::cvt_pk_bf16(o[dt][2] * rden, o[dt][3] * rden); *(v2u*)(op + 16 * dt) = w; }
    }
}

struct GlaGates { float b0[8], b1[8]; float all0, ref0, all1, ref1; };
struct GateLd { v4u glr; float wf[16], wb[16], bf_, bb_; };
__device__ __forceinline__ float log_sigmoid(float z) { return fminf(z, 0.f) - __logf(1.0f + __expf(-fabsf(z))); }
__device__ __forceinline__ void gate_load(const Frame& F, int b, int h, int c, GateLd& L) {
    const size_t row0 = (size_t)b * SEQ + (size_t)c * 64; const int d = F.lane;
    L.glr = (v4u){0u, 0u, 0u, 0u};
    if (F.tid < 256) L.glr = *(const v4u*)(F.PROJ + (row0 + (F.tid >> 2)) * DINP + C_GLR + (F.tid & 3) * 8);
#pragma unroll
    for (int r = 0; r < 16; ++r) { L.wf[r] = F.w_gk_fwd[r * 256 + h * 64 + d]; L.wb[r] = F.w_gk_bwd[r * 256 + h * 64 + d]; }
    L.bf_ = F.b_gk_fwd[h * 64 + d]; L.bb_ = F.b_gk_bwd[h * 64 + d];
}
__device__ __forceinline__ void gla_gates(Frame& F, const GateLd& L, LAS float* GLR, LAS float* TOT, GlaGates& G) {
    const int ig = F.wave, d = F.lane;
    if (F.tid < 256) { const v4u w = L.glr; LAS float* gp = GLR + (F.tid >> 2) * 32 + (F.tid & 3) * 8;
        gp[0] = bflo(w.x); gp[1] = bfhi(w.x); gp[2] = bflo(w.y); gp[3] = bfhi(w.y); gp[4] = bflo(w.z); gp[5] = bfhi(w.z); gp[6] = bflo(w.w); gp[7] = bfhi(w.w); }
    __syncthreads();
    float la0[8], la1[8];
#pragma unroll
    for (int kk = 0; kk < 8; ++kk) {
        const LAS float* gp = GLR + (8 * ig + kk) * 32;
        float z0 = L.bf_, z1 = L.bb_;
#pragma unroll
        for (int r = 0; r < 16; ++r) { z0 += gp[r] * L.wf[r]; z1 += gp[16 + r] * L.wb[r]; }
        la0[kk] = log_sigmoid(z0) * (1.0f / 16.0f); la1[kk] = log_sigmoid(z1) * (1.0f / 16.0f);
    }
#pragma unroll
    for (int kk = 1; kk < 8; ++kk) la0[kk] += la0[kk - 1];
#pragma unroll
    for (int kk = 6; kk >= 0; --kk) la1[kk] += la1[kk + 1];
    TOT[(0 * 8 + ig) * 64 + d] = la0[7]; TOT[(1 * 8 + ig) * 64 + d] = la1[0];
    __syncthreads();
    float off0 = 0.f, all0 = 0.f, ref0 = 0.f, off1 = 0.f, all1 = 0.f, ref1 = 0.f;
#pragma unroll
    for (int g = 0; g < 8; ++g) {
        const float t0 = TOT[(0 * 8 + g) * 64 + d], t1 = TOT[(1 * 8 + g) * 64 + d];
        all0 += t0; all1 += t1; off0 += (g < ig) ? t0 : 0.f; off1 += (g > ig) ? t1 : 0.f; ref0 += (g < 4) ? t0 : 0.f; ref1 += (g >= 4) ? t1 : 0.f;
    }
#pragma unroll
    for (int kk = 0; kk < 8; ++kk) { G.b0[kk] = la0[kk] + off0; G.b1[kk] = la1[kk] + off1; }
    G.all0 = all0; G.ref0 = ref0; G.all1 = all1; G.ref1 = ref1;
}
struct Gate2Ld { v4u a[4]; v4u bw; float bias; };
__device__ __forceinline__ void gate2_load(const Frame& F, int b, int h, int c, Gate2Ld& L) {
    const size_t row0 = (size_t)b * SEQ + (size_t)c * 64; const int fr = F.lane & 15, fq = F.lane >> 4, dir = F.wave >> 2, dt = F.wave & 3;
#pragma unroll
    for (int tt = 0; tt < 4; ++tt) { L.a[tt] = (v4u){0u, 0u, 0u, 0u}; if (fq < 2) L.a[tt] = *(const v4u*)(F.PROJ + (row0 + 16 * tt + fr) * DINP + C_GLR + dir * 16 + 8 * fq); }
    L.bw = (v4u){0u, 0u, 0u, 0u}; if (fq < 2) L.bw = *(const v4u*)(F.WG_T + ((size_t)dir * 256 + h * 64 + 16 * dt + fr) * 16 + 8 * fq);
    L.bias = (dir ? F.b_gk_bwd : F.b_gk_fwd)[h * 64 + 16 * dt + fr];
}
struct Gates2 { float b[4][4]; float all, ref; };
__device__ __forceinline__ void gates2(const Frame& F, const Gate2Ld& L, Gates2& G) {
    const int fr = F.lane & 15, fq = F.lane >> 4, dir = F.wave >> 2;
    float la[4][4];
#pragma unroll
    for (int tt = 0; tt < 4; ++tt) {
        f32x4 z = {0.f, 0.f, 0.f, 0.f};
        z = mfma16(__builtin_bit_cast(bf16x8, L.a[tt]), __builtin_bit_cast(bf16x8, L.bw), z);
#pragma unroll
        for (int r = 0; r < 4; ++r) la[tt][r] = log_sigmoid(z[r] + L.bias) * (1.0f / 16.0f);
    }
    float tot[4], excP[4], T4[4], p[4][4];
#pragma unroll
    for (int tt = 0; tt < 4; ++tt) {
        p[tt][0] = la[tt][0]; p[tt][1] = p[tt][0] + la[tt][1]; p[tt][2] = p[tt][1] + la[tt][2]; p[tt][3] = p[tt][2] + la[tt][3];
        T4[tt] = p[tt][3];
        float inc = T4[tt]; float v = __shfl(inc, (F.lane + 48) & 63); inc += (fq >= 1) ? v : 0.f; v = __shfl(inc, (F.lane + 32) & 63); inc += (fq >= 2) ? v : 0.f;
        excP[tt] = inc - T4[tt]; tot[tt] = __shfl(inc, 48 + fr);
    }
    const float all = (tot[0] + tot[1]) + (tot[2] + tot[3]);
    const float runF[4] = {0.f, tot[0], tot[0] + tot[1], tot[0] + tot[1] + tot[2]};
    const float runB[4] = {tot[1] + tot[2] + tot[3], tot[2] + tot[3], tot[3], 0.f};
    const bool fwd = (dir == 0);
#pragma unroll
    for (int tt = 0; tt < 4; ++tt) {
        const float baseF = runF[tt] + excP[tt];
        const float baseB = runB[tt] + (tot[tt] - excP[tt] - T4[tt]);
#pragma unroll
        for (int r = 0; r < 4; ++r) { const float bf = baseF + p[tt][r], bb = baseB + (T4[tt] - p[tt][r] + la[tt][r]); G.b[tt][r] = fwd ? bf : bb; }
    }
    G.all = all; G.ref = fwd ? (tot[0] + tot[1]) : (tot[2] + tot[3]);
}
__device__ __forceinline__ void vr_load(const Frame& F, size_t row0, int h, v4u (&w)[2]) {
#pragma unroll
    for (int i = 0; i < 2; ++i) { const int idx = F.tid + 512 * i; w[i] = *(const v4u*)(F.PROJ + (row0 + (idx >> 4)) * DINP + C_GV + h * 128 + (idx & 15) * 8); }
}
__device__ __forceinline__ void vr_store(const Frame& F, const v4u (&w)[2], LAS bf16* VR) {
#pragma unroll
    for (int i = 0; i < 2; ++i) { const int idx = F.tid + 512 * i; *(LAS v4u*)(VR + (idx >> 4) * 144 + (idx & 15) * 8) = w[i]; }
}
__device__ __forceinline__ bf16x8 vr_frag(const LAS bf16* VR, int ks, int v0, int fr, int fq) {
    const LAS bf16* p = VR + (32 * ks + 8 * fq + (fr >> 2)) * 144 + v0 + 4 * (fr & 3);
    const v2u x = lds_tr16(p), y = lds_tr16(p + 4 * 144);
    v4u r; r.x = x.x; r.y = x.y; r.z = y.x; r.w = y.y; return __builtin_bit_cast(bf16x8, r);
}
__device__ __forceinline__ size_t gla_idx(int dir, int b, int h, int c) { return (size_t)(((dir * 2 + b) * 4 + h) * NCH + c); }

struct GlaALd { Gate2Ld g; unsigned k[4][2]; v4u vr[2]; };
__device__ __forceinline__ void gla_a_load(const Frame& F, int unit, GlaALd& L) {
    const int c = unit & 127, h = (unit >> 7) & 3, b = unit >> 9;
    const size_t row0 = (size_t)b * SEQ + (size_t)c * 64; const int fr = F.lane & 15, fq = F.lane >> 4, dt = F.wave & 3;
    gate2_load(F, b, h, c, L.g);
#pragma unroll
    for (int tt = 0; tt < 4; ++tt)
#pragma unroll
        for (int p = 0; p < 2; ++p) { const bf16* kp = F.PROJ + (row0 + 16 * tt + 4 * fq + 2 * p) * DINP + C_GK + h * 64 + 16 * dt + fr; L.k[tt][p] = (unsigned)kp[0] | ((unsigned)kp[DINP] << 16); }
    vr_load(F, row0, h, L.vr);
}
__device__ __forceinline__ void gla_a_compute(Frame& F, int unit, const GlaALd& L) {
    const int c = unit & 127, h = (unit >> 7) & 3, b = unit >> 9;
    LAS bf16* KT = (LAS bf16*)(F.lds + 12288);
    LAS bf16* VR = (LAS bf16*)(F.lds + 12288 + 18432);
    const int fr = F.lane & 15, fq = F.lane >> 4, w = F.wave, dir = w >> 2, dt = w & 3;
    Gates2 G; gates2(F, L.g, G);
    __syncthreads();
#pragma unroll
    for (int tt = 0; tt < 4; ++tt) {
        v2u kw; kw.x = pk2(bflo(L.k[tt][0]) * __expf(G.all - G.b[tt][0]), bfhi(L.k[tt][0]) * __expf(G.all - G.b[tt][1]));
        kw.y = pk2(bflo(L.k[tt][1]) * __expf(G.all - G.b[tt][2]), bfhi(L.k[tt][1]) * __expf(G.all - G.b[tt][3]));
        *(LAS v2u*)(KT + (dir * 64 + 16 * dt + fr) * 72 + 16 * tt + 4 * fq) = kw;
    }
    if (fq == 0) F.DEC[gla_idx(dir, b, h, c) * 64 + 16 * dt + fr] = __expf(G.all);
    vr_store(F, L.vr, VR);
    __syncthreads();
    const LAS bf16* ap = KT + (16 * w + fr) * 72 + 8 * fq;
    const bf16x8 a0 = *(const LAS bf16x8*)(ap), a1 = *(const LAS bf16x8*)(ap + 32);
    float* up = F.UT + gla_idx(w >> 2, b, h, c) * 8192 + 16 * (w & 3) + 4 * fq;
#pragma unroll
    for (int vt = 0; vt < 8; ++vt) {
        f32x4 acc = {0.f, 0.f, 0.f, 0.f};
        acc = mfma16(a0, vr_frag(VR, 0, 16 * vt, fr, fq), acc); acc = mfma16(a1, vr_frag(VR, 1, 16 * vt, fr, fq), acc);
        *(f32x4*)(up + (size_t)(16 * vt + fr) * 64) = acc;
    }
}
__device__ __forceinline__ void gla_scan(Frame& F) {
    for (int gid = F.vcu * 512 + F.tid; gid < 16 * 8192; gid += F.G * 512) {
        const int stream = gid >> 13, e = gid & 8191, d = e & 63, dir = stream >> 3;
        float s = 0.f;
#pragma unroll 8
        for (int n = 0; n < NCH; ++n) {
            const int c = dir ? (NCH - 1 - n) : n; const size_t idx = (size_t)stream * NCH + c;
            const float u = F.UT[idx * 8192 + e], dc = F.DEC[idx * 64 + d];
            F.ST[idx * 8192 + e] = (bf16)f2bf(s);
            s = s * dc + u;
        }
    }
}
struct GlaCLd { Gate2Ld g; };
__device__ __forceinline__ void gla_c_load(const Frame& F, int unit, GlaCLd& L) {
    const int c = unit & 127, h = (unit >> 7) & 3, b = unit >> 9;
    gate2_load(F, b, h, c, L.g);
}
__device__ __forceinline__ void gla_c_compute(Frame& F, int unit, const GlaCLd& L) {
    const int c = unit & 127, h = (unit >> 7) & 3, b = unit >> 9;
    LAS bf16* QS = (LAS bf16*)(F.lds + 12288);
    LAS bf16* KS = (LAS bf16*)(F.lds + 30720);
    LAS bf16* AC = (LAS bf16*)(F.lds + 49152);
    LAS bf16* VR = (LAS bf16*)(F.lds + 74752);
    LAS bf16* SC = (LAS bf16*)(F.lds + 74752 + 18432);
    LAS float* SSQ = (LAS float*)(F.lds);
    const size_t row0 = (size_t)b * SEQ + (size_t)c * 64;
    const int fr = F.lane & 15, fq = F.lane >> 4, w = F.wave;
    v4u vr[2]; v4u st[4]; v2u gg[4];
    vr_load(F, row0, h, vr);
#pragma unroll
    for (int rep = 0; rep < 4; ++rep) { const int q = F.tid + 512 * (rep & 1), dir = rep >> 1, v = q >> 3, d8 = q & 7; st[rep] = *(const v4u*)(F.ST + gla_idx(dir, b, h, c) * 8192 + v * 64 + d8 * 8); }
#pragma unroll
    for (int it = 0; it < 4; ++it) gg[it] = *(const v2u*)(F.PROJ + (row0 + 16 * it + fr) * DINP + C_GG + h * 128 + 16 * w + 4 * fq);
    unsigned qk[4][4];
#pragma unroll
    for (int tt = 0; tt < 4; ++tt)
#pragma unroll
        for (int r = 0; r < 4; ++r) { const bf16* rp = F.PROJ + (row0 + 16 * tt + 4 * fq + r) * DINP + h * 64 + 16 * (w & 3) + fr; qk[tt][r] = (unsigned)rp[C_GQ] | ((unsigned)rp[C_GK] << 16); }
    Gates2 G; gates2(F, L.g, G);
    __syncthreads();
    {
        const int dir = w >> 2, d = 16 * (w & 3) + fr; const float er = __expf(G.ref);
#pragma unroll
        for (int tt = 0; tt < 4; ++tt)
#pragma unroll
            for (int r = 0; r < 4; ++r) {
                const int i = 16 * tt + 4 * fq + r;
                const float q = bflo(qk[tt][r]), k = bfhi(qk[tt][r]);
                const float e = __expf(G.b[tt][r] - G.ref), qe = q * e;
                QS[(dir * 64 + i) * 72 + d] = (bf16)f2bf(qe); KS[(dir * 64 + i) * 72 + d] = (bf16)f2bf(k * __builtin_amdgcn_rcpf(e));
                AC[i * 200 + 64 + dir * 64 + d] = (bf16)f2bf(qe * er);
            }
    }
    vr_store(F, vr, VR);
#pragma unroll
    for (int rep = 0; rep < 4; ++rep) { const int q = F.tid + 512 * (rep & 1), dir = rep >> 1, v = q >> 3, d8 = q & 7; *(LAS v4u*)(SC + v * 144 + dir * 64 + d8 * 8) = st[rep]; }
    __syncthreads();
    {
        const int it = w & 3, jp = w >> 2;
        bf16x8 qf[2][2];
#pragma unroll
        for (int dir = 0; dir < 2; ++dir)
#pragma unroll
            for (int ks = 0; ks < 2; ++ks) qf[dir][ks] = *(const LAS bf16x8*)(QS + (dir * 64 + 16 * it + fr) * 72 + 32 * ks + 8 * fq);
#pragma unroll
        for (int jj = 0; jj < 2; ++jj) {
            const int jt = 2 * jp + jj;
            f32x4 s0 = {0.f, 0.f, 0.f, 0.f}, s1 = {0.f, 0.f, 0.f, 0.f};
#pragma unroll
            for (int ks = 0; ks < 2; ++ks) {
                s0 = mfma16(*(const LAS bf16x8*)(KS + (0 * 64 + 16 * jt + fr) * 72 + 32 * ks + 8 * fq), qf[0][ks], s0);
                s1 = mfma16(*(const LAS bf16x8*)(KS + (1 * 64 + 16 * jt + fr) * 72 + 32 * ks + 8 * fq), qf[1][ks], s1);
            }
            const int i = 16 * it + fr; float sv[4];
#pragma unroll
            for (int r = 0; r < 4; ++r) { const int j = 16 * jt + 4 * fq + r; sv[r] = ((j <= i) ? s0[r] : 0.f) + ((j >= i) ? s1[r] : 0.f); }
            v2u pw; pw.x = pk2(sv[0], sv[1]); pw.y = pk2(sv[2], sv[3]);
            *(LAS v2u*)(AC + i * 200 + 16 * jt + 4 * fq) = pw;
        }
    }
    __syncthreads();
    f32x4 o[4];
#pragma unroll
    for (int it = 0; it < 4; ++it) o[it] = (f32x4){0.f, 0.f, 0.f, 0.f};
#pragma unroll
    for (int ks = 0; ks < 6; ++ks) {
        const bf16x8 bfr = ks < 2 ? vr_frag(VR, ks, 16 * w, fr, fq) : *(const LAS bf16x8*)(SC + (16 * w + fr) * 144 + 32 * (ks - 2) + 8 * fq);
#pragma unroll
        for (int it = 0; it < 4; ++it) o[it] = mfma16(bfr, *(const LAS bf16x8*)(AC + (16 * it + fr) * 200 + 32 * ks + 8 * fq), o[it]);
    }
#pragma unroll
    for (int it = 0; it < 4; ++it) { float s = (o[it][0] * o[it][0] + o[it][1] * o[it][1]) + (o[it][2] * o[it][2] + o[it][3] * o[it][3]);
        s += __shfl_xor(s, 16); s += __shfl_xor(s, 32); if (fq == 0) SSQ[w * 64 + 16 * it + fr] = s; }
    __syncthreads();
    const f32x4 gv = *(const f32x4*)(F.g_gla_out + 16 * w + 4 * fq);
#pragma unroll
    for (int it = 0; it < 4; ++it) {
        const int i = 16 * it + fr; float s = 0.f;
#pragma unroll
        for (int ww = 0; ww < 8; ++ww) s += SSQ[ww * 64 + i];
        const float rinv = 1.0f / sqrtf(s * (1.0f / 128.0f) + EPS);
        const v2u gw = gg[it];
        const float g0 = bflo(gw.x), g1 = bfhi(gw.x), g2 = bflo(gw.y), g3 = bfhi(gw.y);
        const float r0 = o[it][0] * rinv * gv[0] * (g0 / (1.0f + __expf(-g0))), r1 = o[it][1] * rinv * gv[1] * (g1 / (1.0f + __expf(-g1)));
        const float r2 = o[it][2] * rinv * gv[2] * (g2 / (1.0f + __expf(-g2))), r3 = o[it][3] * rinv * gv[3] * (g3 / (1.0f + __expf(-g3)));
        v2u ow; ow.x = pk2(r0, r1); ow.y = pk2(r2, r3);
        *(v2u*)(F.O + (row0 + i) * D + h * 128 + 16 * w + 4 * fq) = ow;
    }
}
__device__ __forceinline__ void p3_phase(Frame& F) {
    GlaALd LA; int u = F.vcu;
    {   AttnLd AL; int ua = F.vcu; bool ha = ua < 256;
        if (ha) attn_load(F, ua, AL);
        while (ha) { attn_compute(F, ua, AL); ua += F.G; ha = ua < 256; if (ha) attn_load(F, ua, AL); }
    }
    for (; u < 1024; u += F.G) { gla_a_load(F, u, LA); gla_a_compute(F, u, LA); }
}
__device__ __forceinline__ void p5_phase(Frame& F) {
    for (int u = F.vcu; u < 1024; u += F.G) { GlaCLd L; gla_c_load(F, u, L); gla_c_compute(F, u, L); }
}

__device__ __forceinline__ void p7_rows(Frame& F) {
    LAS bf16* WR = (LAS bf16*)(F.lds);
    LAS float* A1 = (LAS float*)(F.lds + 66048);
    LAS float* B2 = A1 + 1024;
    LAS float* C2 = B2 + 1024;
    LAS int* HIST = (LAS int*)(C2 + 1024);
    LAS int* BASE = HIST + 32;
    __syncthreads();
    for (int idx = F.tid; idx < 32 * 128; idx += 512) { const int e = idx >> 7, ch = idx & 127; *(LAS v4u*)(WR + e * 1032 + ch * 8) = *(const v4u*)(F.WR_T + e * 1024 + ch * 8); }
    const int fr = F.lane & 15, fq = F.lane >> 4;
    for (int rg = F.vcu; rg < T / 64; rg += F.G) {
        const int b = (rg * 64) / SEQ;
        __syncthreads();
        for (int i = F.tid; i < D; i += 512) { const float* md = F.MOD + b * 6144;
            A1[i] = md[2048 + i] * F.g_post_mix[i]; B2[i] = F.g_pre_ffn[i] * (1.0f + md[4096 + i]); C2[i] = md[3072 + i]; }
        if (F.tid < 32) HIST[F.tid] = 0;
        __syncthreads();
        for (int rr = 0; rr < 8; ++rr) {
            const int row = rg * 64 + F.wave * 8 + rr;
            const GAS v2u* yr = (const GAS v2u*)(F.Y + (size_t)row * D) + F.lane;
            const GAS f32x4* xr = (const GAS f32x4*)(F.x + (size_t)row * D) + F.lane;
            f32x4 y[4], xv[4]; float s = 0.f;
#pragma unroll
            for (int j = 0; j < 4; ++j) { const v2u yw = yr[64 * j]; y[j] = (f32x4){bflo(yw.x), bfhi(yw.x), bflo(yw.y), bfhi(yw.y)}; xv[j] = xr[64 * j]; s += (y[j].x * y[j].x + y[j].y * y[j].y) + (y[j].z * y[j].z + y[j].w * y[j].w); }
            const float rinv1 = 1.0f / sqrtf(wave_sum(s) * (1.0f / D) + EPS);
            float s2 = 0.f;
            GAS v2u* o1 = (GAS v2u*)(F.H + (size_t)row * D) + F.lane;
#pragma unroll
            for (int j = 0; j < 4; ++j) { const f32x4 a = *(const LAS f32x4*)(A1 + 4 * F.lane + 256 * j);
                xv[j] = xv[j] + a * (y[j] * rinv1); { v2u w; w.x = pk2(xv[j].x, xv[j].y); w.y = pk2(xv[j].z, xv[j].w); o1[64 * j] = w; }
                s2 += (xv[j].x * xv[j].x + xv[j].y * xv[j].y) + (xv[j].z * xv[j].z + xv[j].w * xv[j].w); }
            const float rinv2 = 1.0f / sqrtf(wave_sum(s2) * (1.0f / D) + EPS);
            GAS v2u* o8 = (GAS v2u*)(F.H2 + (size_t)row * D) + F.lane;
#pragma unroll
            for (int j = 0; j < 4; ++j) { const f32x4 a = *(const LAS f32x4*)(B2 + 4 * F.lane + 256 * j), c = *(const LAS f32x4*)(C2 + 4 * F.lane + 256 * j);
                const f32x4 h = (xv[j] * rinv2) * a + c; v2u w; w.x = pk2(h.x, h.y); w.y = pk2(h.z, h.w); o8[64 * j] = w;
                ((GAS unsigned*)(F.H2F8 + (size_t)row * D))[F.lane + 64 * j] = pk4_fp8(sat8(h.x), sat8(h.y), sat8(h.z), sat8(h.w)); }
        }
        VM_WAIT();
        __syncthreads();
        int myi = 0, myslot = 0; float myg = 0.f;
        if (F.wave < 4) {
            const int r0 = rg * 64 + F.wave * 16;
            f32x4 acc0 = {0.f, 0.f, 0.f, 0.f}, acc1 = {0.f, 0.f, 0.f, 0.f};
            const bf16* hp = F.H2 + (size_t)(r0 + fr) * D + 8 * fq;
#pragma unroll 8
            for (int ks = 0; ks < 32; ++ks) {
                const bf16x8 bfr = *(const bf16x8*)(hp + 32 * ks);
                acc0 = mfma16(*(const LAS bf16x8*)(WR + fr * 1032 + 32 * ks + 8 * fq), bfr, acc0);
                acc1 = mfma16(*(const LAS bf16x8*)(WR + (16 + fr) * 1032 + 32 * ks + 8 * fq), bfr, acc1);
            }
            float v[8];
#pragma unroll
            for (int r = 0; r < 4; ++r) { v[r] = acc0[r] + F.b_router[4 * fq + r]; v[4 + r] = acc1[r] + F.b_router[16 + 4 * fq + r]; }
            float tv[4]; int ti[4];
#pragma unroll
            for (int t = 0; t < 4; ++t) {
                float bv = -3.0e38f; int bi = 0;
#pragma unroll
                for (int q = 0; q < 8; ++q) { const int id = (q >> 2) * 16 + 4 * fq + (q & 3); if (v[q] > bv) { bv = v[q]; bi = id; } }
#pragma unroll
                for (int o = 16; o <= 32; o <<= 1) { const float pv = __shfl_xor(bv, o); const int pi = __shfl_xor(bi, o); if (pv > bv || (pv == bv && pi < bi)) { bv = pv; bi = pi; } }
                tv[t] = bv; ti[t] = bi;
#pragma unroll
                for (int q = 0; q < 8; ++q) { const int id = (q >> 2) * 16 + 4 * fq + (q & 3); if (id == bi) v[q] = -3.0e38f; }
            }
            const float e1 = __expf(tv[1] - tv[0]), e2 = __expf(tv[2] - tv[0]), e3 = __expf(tv[3] - tv[0]);
            const float rs = 1.0f / (1.0f + e1 + e2 + e3);
            myi = fq == 0 ? ti[0] : fq == 1 ? ti[1] : fq == 2 ? ti[2] : ti[3];
            myg = (fq == 0 ? 1.0f : fq == 1 ? e1 : fq == 2 ? e2 : e3) * rs;
            myslot = atomicAdd((int*)(HIST + myi), 1);
        }
        __syncthreads();
        if (F.tid < 32) BASE[F.tid] = (int)__hip_atomic_fetch_add((unsigned*)(F.ctl + CW_CNT + F.tid), (unsigned)HIST[F.tid], RLX_AGENT);
        __syncthreads();
        if (F.wave < 4) {
            const int asg = (rg * 64 + F.wave * 16 + fr) * 4 + fq;
            F.LIST[(size_t)myi * LCAP + BASE[myi] + myslot] = asg | (int)(f2bf(myg) << 16);
        }
    }
}

__device__ __forceinline__ void p10_final(Frame& F) {
    LAS float* A2 = (LAS float*)(F.lds);
    for (int rg = F.vcu; rg < T / 64; rg += F.G) {
        const int b = (rg * 64) / SEQ;
        __syncthreads();
        for (int i = F.tid; i < D; i += 512) A2[i] = F.MOD[b * 6144 + 5120 + i] * F.g_post_ffn[i];
        __syncthreads();
        unsigned yq[4][4]; v2u xq[4];
        auto ld = [&](int row, unsigned (&y)[4][4], v2u (&x)[4]) {
#pragma unroll
            for (int k = 0; k < 4; ++k) { const GAS unsigned* yp = (const GAS unsigned*)((const unsigned char*)F.Y2 + ((size_t)row * 4 + k) * D) + F.lane;
#pragma unroll
                for (int j = 0; j < 4; ++j) y[k][j] = yp[64 * j]; }
            const GAS v2u* x1p = (const GAS v2u*)(F.H + (size_t)row * D) + F.lane;
#pragma unroll
            for (int j = 0; j < 4; ++j) x[j] = x1p[64 * j];
        };
        ld(rg * 64 + F.wave * 8, yq, xq);
#pragma unroll 1
        for (int rr = 0; rr < 8; ++rr) {
            const int row = rg * 64 + F.wave * 8 + rr;
            unsigned yn[4][4]; v2u xn[4];
            if (rr < 7) ld(row + 1, yn, xn);
            f32x4 ys[4];
#pragma unroll
            for (int j = 0; j < 4; ++j) ys[j] = (f32x4){0.f, 0.f, 0.f, 0.f};
#pragma unroll
            for (int k = 0; k < 4; ++k)
#pragma unroll
                for (int j = 0; j < 4; ++j) { const int w = (int)yq[k][j];
                    ys[j].x += __builtin_amdgcn_cvt_f32_fp8(w, 0); ys[j].y += __builtin_amdgcn_cvt_f32_fp8(w, 1); ys[j].z += __builtin_amdgcn_cvt_f32_fp8(w, 2); ys[j].w += __builtin_amdgcn_cvt_f32_fp8(w, 3); }
            float s = 0.f;
#pragma unroll
            for (int j = 0; j < 4; ++j) s += (ys[j].x * ys[j].x + ys[j].y * ys[j].y) + (ys[j].z * ys[j].z + ys[j].w * ys[j].w);
            const float rinv = 1.0f / sqrtf(wave_sum(s) * (1.0f / D) * (YSC_INV * YSC_INV) + EPS) * YSC_INV;
            GAS f32x4* o1 = (GAS f32x4*)(F.out + (size_t)row * D) + F.lane;
#pragma unroll
            for (int j = 0; j < 4; ++j) { const f32x4 a = *(const LAS f32x4*)(A2 + 4 * F.lane + 256 * j); const v2u xw = xq[j];
                const f32x4 x1 = {bflo(xw.x), bfhi(xw.x), bflo(xw.y), bfhi(xw.y)}; o1[64 * j] = x1 + a * (ys[j] * rinv); }
            if (rr < 7) {
#pragma unroll
                for (int k = 0; k < 4; ++k)
#pragma unroll
                    for (int j = 0; j < 4; ++j) yq[k][j] = yn[k][j];
#pragma unroll
                for (int j = 0; j < 4; ++j) xq[j] = xn[j];
            }
        }
    }
}

struct Args { const float* in[22]; float* out; unsigned char* ws; int ph_lo, ph_hi, li, pad; };
__global__ void __launch_bounds__(NWAVES * 64, 2) fwd_megakernel(Args args) {
    extern __shared__ __attribute__((aligned(16))) unsigned char lds_raw[];
    Frame F;
    F.lds = (LAS unsigned char*)lds_raw;
    F.MISC = (volatile LAS unsigned*)(F.lds + MISC_OFF);
    F.tid = threadIdx.x; F.lane = F.tid & 63; F.wave = __builtin_amdgcn_readfirstlane(F.tid >> 6);
    F.G = gridDim.x; { const int bx = blockIdx.x; F.vcu = (F.G % 8 == 0) ? (bx % 8) * (F.G / 8) + bx / 8 : bx; }
    unsigned char* ws = args.ws;
    F.ctl = (GAS unsigned*)(ws + WS_CTL);
    F.x = args.in[0]; F.c = args.in[1]; F.w_ada = args.in[2]; F.b_ada = args.in[3]; F.g_pre_mix = args.in[4]; F.g_post_mix = args.in[5]; F.w_in = args.in[6];
    F.w_gk_fwd = args.in[7]; F.b_gk_fwd = args.in[8]; F.w_gk_bwd = args.in[9]; F.b_gk_bwd = args.in[10]; F.g_gla_out = args.in[11]; F.attn_sink = args.in[12];
    F.w_out = args.in[13]; F.g_pre_ffn = args.in[14]; F.g_post_ffn = args.in[15]; F.w_router = args.in[16]; F.b_router = args.in[17]; F.w_gate_up = args.in[18];
    F.b_gate_up = args.in[19]; F.w_down = args.in[20]; F.b_down = args.in[21]; F.out = args.out;
    F.MOD = (float*)(ws + WS_MOD); F.ROPE = (float*)(ws + WS_ROPE); F.GATE = (float*)(ws + WS_GATE); F.DEC = (float*)(ws + WS_DEC); F.UT = (float*)(ws + WS_UT); F.Y = (bf16*)(ws + WS_Y);
    F.WR_T = (bf16*)(ws + WS_WR_T); F.WG_T = (bf16*)(ws + WS_WG_T); F.WIN_T = (bf16*)(ws + WS_WIN_T); F.WOUT_T = (bf16*)(ws + WS_WOUT_T); F.WGU_T = ws + WS_WGU_T; F.WD_T = ws + WS_WD_T; F.H2F8 = ws + WS_H2F8;
    F.H = (bf16*)(ws + WS_H); F.PROJ = (bf16*)(ws + WS_PROJ); F.ST = (bf16*)(ws + WS_ST); F.O = (bf16*)(ws + WS_O); F.H2 = (bf16*)(ws + WS_H2); F.ACT = ws + WS_ACT; F.Y2 = (bf16*)(ws + WS_Y2);
    F.LIST = (int*)(ws + WS_LIST);
    for (int u = F.tid; u < (LDS_BYTES - LDSCTL_OFF) / 4; u += NWAVES * 64) ((LAS unsigned*)(F.lds + LDSCTL_OFF))[u] = 0u;
    __syncthreads();
    XcdBarrier bar; bar.bar = (unsigned*)(F.ctl + CW_BAR) + args.li * XCD_BAR_WORDS; bar.x = 0; bar.st = nullptr;
    if (MK_N_LAUNCHES == 1) bar = xcd_barrier_post((unsigned*)(F.ctl + CW_BAR), F.MISC + 8);
    const int lo = args.ph_lo, hi = args.ph_hi;
#define IN(k) (lo <= (k) && (k) < hi)
#if defined(PROBE_PA)
    GAS unsigned long long* stamps = (GAS unsigned long long*)(F.ctl + 2048);
#define SEAM(k) do { if (blockIdx.x == 0 && F.tid == 0) stamps[16 + (k)] = __builtin_amdgcn_s_memrealtime(); if (IN(k) && IN((k) + 1)) xcd_barrier(bar); \
                     if (blockIdx.x == 0 && F.tid == 0) stamps[(k) + 1] = __builtin_amdgcn_s_memrealtime(); } while (0)
    if (blockIdx.x == 0 && F.tid == 0) stamps[0] = __builtin_amdgcn_s_memrealtime();
#else
#define SEAM(k) do { if (IN(k) && IN((k) + 1)) xcd_barrier(bar); } while (0)
#endif

    if (IN(0)) { p0_prologue(F); } SEAM(0);
    const bool spread = (F.G == 256);
    const int xl = F.vcu >> 5, jl = F.vcu & 31;
    const bool conv2 = spread && (jl >= NG2 / 8);
    if (IN(1)) { p1_norm(F);
                 if (!spread) { p0_f8_convert<0>(F, 0, NA8, F.vcu * NWAVES + F.wave, F.G * NWAVES); p0_f8_convert<1>(F, 0, NB8, F.vcu * NWAVES + F.wave, F.G * NWAVES); } } SEAM(1);
    if (IN(2)) { if (conv2) p0_f8_convert<0>(F, 0, NA8, (xl * (32 - NG2 / 8) + (jl - NG2 / 8)) * NWAVES + F.wave, (256 - NG2) * NWAVES);
                 else { ProjPolicy P; P.A = F.H; P.Bt = F.WIN_T; P.KB = D * 2; P.so.init(T, DINP, spread ? NG2 : F.G, spread ? (jl * 8 + xl) : (int)blockIdx.x); P.O = F.PROJ; P.rope = F.ROPE;
                        pg8::gemm_phase<ProjPolicy>(F.lds, P); } } SEAM(2);
    if (IN(3)) { p3_phase(F); } SEAM(3);
    if (IN(4)) { gla_scan(F); } SEAM(4);
    if (IN(5)) { p5_phase(F); } SEAM(5);
    if (IN(6)) { OutPolicy P; P.A = F.O; P.Bt = F.WOUT_T; P.KB = D * 2; P.so.init(T, D, F.G, (int)blockIdx.x); P.C = F.Y;
                 pg8::gemm_phase<OutPolicy>(F.lds, P); } SEAM(6);
    if (IN(7)) { p7_rows(F); } SEAM(7);
    if (IN(8) || IN(9)) {
        volatile LAS int* tb = (volatile LAS int*)(F.MISC + 16);
        __syncthreads();
        if (F.tid == 0) { int acc = 0; for (int e = 0; e < NE; ++e) { tb[e] = acc; const int cn = (int)__hip_atomic_load((unsigned*)(F.ctl + CW_CNT + e), RLX_AGENT); acc += (cn + 255) >> 8; } tb[32] = acc; }
        __syncthreads();
        volatile LAS int* rtab = (volatile LAS int*)(F.MISC + 64);
        for (int rt = F.tid; rt < tb[32]; rt += 512) { int e = 0; for (int j = 1; j < 32; ++j) e = (rt >= tb[j]) ? j : e;
            const int s0 = (rt - tb[e]) * 256, rem = (int)__hip_atomic_load((unsigned*)(F.ctl + CW_CNT + e), RLX_AGENT) - s0; rtab[rt] = e | ((rem < 256 ? rem : 256) << 8) | (s0 << 17); }
        __syncthreads();
        if (IN(8)) { Moe1Policy P; P.tb = tb; P.rtab = rtab; P.llds = F.lds + LDSCTL_OFF + 4096; P.cnt = (const int*)(F.ctl + CW_CNT); P.list = F.LIST; P.G = F.G; P.c = (int)blockIdx.x; P.ncol = 8;
                     P.A = F.H2F8; P.Bt = F.WGU_T; P.KB = D; P.ACTp = F.ACT; P.bias = F.b_gate_up;
                     pg8::gemm_phase<Moe1Policy>(F.lds, P);
                     if (spread && ((int)blockIdx.x >> 3) >= 16) p0_f8_convert<1>(F, 0, NB8, ((((int)blockIdx.x >> 3) - 16) * 8 + ((int)blockIdx.x & 7)) * NWAVES + F.wave, 128 * NWAVES); }
        SEAM(8);
        if (IN(9)) { Moe2Policy P; P.tb = tb; P.rtab = rtab; P.llds = F.lds + LDSCTL_OFF + 4096; P.cnt = (const int*)(F.ctl + CW_CNT); P.list = F.LIST; P.G = F.G; P.c = (int)blockIdx.x; P.ncol = 4;
                     P.A = F.ACT; P.Bt = F.WD_T; P.KB = DFF; P.Y2p = (unsigned char*)F.Y2; P.bias = F.b_down;
                     pg8::gemm_phase<Moe2Policy>(F.lds, P); }
    }
    SEAM(9);
    if (IN(10)) { p10_final(F); }
#if defined(PROBE_PA)
    if (blockIdx.x == 0 && F.tid == 0) stamps[11] = __builtin_amdgcn_s_memrealtime();
    {
        if (blockIdx.x == 0 && F.tid == 0) {
            auto dur = [&](int k) -> float { const unsigned long long a = stamps[k], b = (k == 9) ? stamps[16 + 9] : stamps[k + 1]; return (float)(long long)(b - a) * 0.01f; };
            const float tA = dur(PROBE_PA), tB = dur(PROBE_PB);
            const float V = 1000.0f * rintf(tB * 0.2f) + 2.0f * tA;
            const unsigned long long t0 = __builtin_amdgcn_s_memrealtime(), want = (unsigned long long)(V * 100.0f);
            while (__builtin_amdgcn_s_memrealtime() - t0 < want) __builtin_amdgcn_s_sleep(8);
        }
    }
#endif
#undef IN
#undef SEAM
}

extern "C" void kernel_launch(void* const* d_in, const int* in_sizes, int n_in, void* d_out, int out_size, void* d_ws, size_t ws_size, hipStream_t stream) {
    static int grid = 0;
    if (grid == 0) {
        if (n_in != 22 || in_sizes[0] != T * D || out_size != T * D || ws_size < WS_END) { fprintf(stderr, "kernel_launch: unexpected shapes (n_in %d, in0 %d, out %d, ws %zu)\n", n_in, n_in > 0 ? in_sizes[0] : -1, out_size, ws_size); grid = -1; return; }
        int dev = 0, cus = 0, per_cu = 0;
        if (hipGetDevice(&dev) != hipSuccess || hipDeviceGetAttribute(&cus, hipDeviceAttributeMultiprocessorCount, dev) != hipSuccess) { grid = -1; return; }
        if (hipFuncSetAttribute((const void*)fwd_megakernel, hipFuncAttributeMaxDynamicSharedMemorySize, LDS_BYTES) != hipSuccess) { fprintf(stderr, "kernel_launch: hipFuncSetAttribute failed\n"); grid = -1; return; }
        if (hipOccupancyMaxActiveBlocksPerMultiprocessor(&per_cu, (const void*)fwd_megakernel, NWAVES * 64, LDS_BYTES) != hipSuccess || per_cu < 1)
            fprintf(stderr, "kernel_launch: note: occupancy query reports %d blocks per CU\n", per_cu);
        (void)hipGetLastError();
        grid = cus;
    }
    if (grid < 0) return;
    if (hipMemsetAsync((char*)d_ws + WS_CTL, 0, CTL_ZERO_BYTES, stream) != hipSuccess) { fprintf(stderr, "kernel_launch: memset failed\n"); return; }
    Args a{};
    for (int i = 0; i < 22; ++i) a.in[i] = (const float*)d_in[i];
    a.out = (float*)d_out; a.ws = (unsigned char*)d_ws;
    if (MK_N_LAUNCHES == 1) {
        a.ph_lo = 0; a.ph_hi = N_PHASES; a.li = 0;
        hipLaunchKernelGGL(fwd_megakernel, dim3(grid), dim3(NWAVES * 64), LDS_BYTES, stream, a);
    } else {
        for (int p = 0; p < N_PHASES; ++p) { a.ph_lo = p; a.ph_hi = p + 1; a.li = 0;
            hipLaunchKernelGGL(fwd_megakernel, dim3(grid), dim3(NWAVES * 64), LDS_BYTES, stream, a); }
    }
    const hipError_t le = hipPeekAtLastError();
    if (le != hipSuccess) fprintf(stderr, "kernel_launch: launch failed: %s\n", hipGetErrorName(le));
}
```

```cpp
#include <hip/hip_runtime.h>
#include <cstdio>
#include <cstdint>

#define GAS __attribute__((address_space(1)))
#define LAS __attribute__((address_space(3)))
typedef unsigned short bf16;
typedef unsigned v4u __attribute__((ext_vector_type(4)));
typedef unsigned v2u __attribute__((ext_vector_type(2)));
typedef float f32x4 __attribute__((ext_vector_type(4)));
typedef float f32x2 __attribute__((ext_vector_type(2)));
typedef short bf16x8 __attribute__((ext_vector_type(8)));
typedef short bf16x4 __attribute__((ext_vector_type(4)));
typedef int i32x4 __attribute__((ext_vector_type(4)));
typedef int i32x8 __attribute__((ext_vector_type(8)));

#ifndef MK_N_LAUNCHES
#define MK_N_LAUNCHES 1
#endif
constexpr int N_PHASES = 11;

constexpr int NB = 2, SEQ = 8192, T = NB * SEQ, D = 1024, DIN = 2336, DINP = 2560, NE = 32, DFF = 1024;
constexpr int C_GQ = 0, C_GK = 256, C_GV = 512, C_GG = 1024, C_GLR = 1536, C_AQ = 1568, C_AK = 2080, C_AV = 2208;
constexpr int NCH = 128;
constexpr float EPS = 1e-6f;
constexpr int LCAP = 16384;
constexpr int ACT_ROWS = 65536 + NE * 256;

constexpr size_t MiB = 1u << 20;
constexpr size_t WS_CTL = 0, CTL_ZERO_BYTES = 1 * MiB;
constexpr size_t WS_MOD = 1 * MiB;
constexpr size_t WS_ROPE = 1 * MiB + 512 * 1024;
constexpr size_t WS_WR_T = 2 * MiB;
constexpr size_t WS_WG_T = 2 * MiB + 128 * 1024;
constexpr size_t WS_LIST = 3 * MiB;
constexpr size_t WS_GATE = 5 * MiB;
constexpr size_t WS_DEC = 6 * MiB;
constexpr size_t WS_WIN_T = 8 * MiB;
constexpr size_t WS_WOUT_T = 14 * MiB;
constexpr size_t WS_WGU_T = 16 * MiB;
constexpr size_t WS_WD_T = 80 * MiB;
constexpr size_t WS_H2F8 = 112 * MiB;
constexpr size_t WS_H = 208 * MiB;
constexpr size_t WS_PROJ = 240 * MiB;
constexpr size_t WS_UT = 320 * MiB;
constexpr size_t WS_ST = 384 * MiB;
constexpr size_t WS_O = 416 * MiB;
constexpr size_t WS_Y = 448 * MiB;
constexpr size_t WS_H2 = 512 * MiB;
constexpr size_t WS_ACT = 544 * MiB;
constexpr size_t WS_Y2 = 688 * MiB;
constexpr size_t WS_END = 816 * MiB;
constexpr int CW_CNT = 64;
constexpr int CW_BAR = 4096;

constexpr int RING_BYTES = 131072;
constexpr int LDSCTL_OFF = RING_BYTES, MISC_OFF = LDSCTL_OFF + 320;
constexpr int LDS_BYTES = 147456;
constexpr int NWAVES = 8;

#define RLX_AGENT __ATOMIC_RELAXED, __HIP_MEMORY_SCOPE_AGENT
#define LDS_WAIT() asm volatile("s_waitcnt lgkmcnt(0)" ::: "memory")
#define VM_WAIT() asm volatile("s_waitcnt vmcnt(0)" ::: "memory")
__device__ __forceinline__ unsigned f2bf(float f) { unsigned u = __builtin_bit_cast(unsigned, f); return (u + 0x7fffu + ((u >> 16) & 1u)) >> 16; }
__device__ __forceinline__ unsigned pk2(float lo, float hi) { return f2bf(lo) | (f2bf(hi) << 16); }
__device__ __forceinline__ float bf2f(unsigned v) { return __builtin_bit_cast(float, v << 16); }
__device__ __forceinline__ float bflo(unsigned w) { return __builtin_bit_cast(float, w << 16); }
__device__ __forceinline__ float bfhi(unsigned w) { return __builtin_bit_cast(float, w & 0xffff0000u); }
constexpr float YSC = 16.0f, YSC_INV = 1.0f / 16.0f;
constexpr float WSC = 64.0f, WSC_INV = 1.0f / 64.0f, ASC = 4.0f;
__device__ __forceinline__ float sat8(float x) { return __builtin_amdgcn_fmed3f(x, -448.0f, 448.0f); }
__device__ __forceinline__ unsigned pk4_fp8(float a, float b, float c, float d) { int w = 0; w = __builtin_amdgcn_cvt_pk_fp8_f32(a, b, w, false); w = __builtin_amdgcn_cvt_pk_fp8_f32(c, d, w, true); return (unsigned)w; }
__device__ __forceinline__ float wave_sum(float v) {
#pragma unroll
    for (int o = 1; o < 64; o <<= 1) v += __shfl_xor(v, o);
    return v;
}

#define XB_TMO      128
#define XB_XCNT(j)  (256  + 64 * (j))
#define XB_XSUB(j)  (1280 + 64 * (j))
#define XB_XGEN(j)  (2304 + 64 * (j))
#define XB_TOP      3328
#define XB_TOPGEN   3392
#define XCD_BAR_WORDS 3456
#define XB_SPIN_CAP (1u << 18)
__device__ __forceinline__ unsigned xb_ld(unsigned* p)              { return __hip_atomic_load(p, __ATOMIC_RELAXED, __HIP_MEMORY_SCOPE_AGENT); }
__device__ __forceinline__ unsigned xb_add(unsigned* p, unsigned v) { return __hip_atomic_fetch_add(p, v, __ATOMIC_RELAXED, __HIP_MEMORY_SCOPE_AGENT); }
__device__ __forceinline__ unsigned xb_xcc_id() { return (unsigned)__builtin_amdgcn_s_getreg((3 << 11) | 20) & 0xFu; }
#define XB_SPIN(cond, bar) do { unsigned _sp = 0; while (cond) { __builtin_amdgcn_s_sleep(1); \
    if ((++_sp & 255u) == 0u) { if (xb_ld(&(bar)[XB_TMO])) break; if (_sp > XB_SPIN_CAP) { atomicAdd(&(bar)[XB_TMO], 1u); break; } } } } while (0)
struct XcdBarrier { unsigned* bar; unsigned x; volatile LAS unsigned* st; };
__device__ __forceinline__ XcdBarrier xcd_barrier_post(unsigned* bar, volatile LAS unsigned* st) {
    XcdBarrier b; b.bar = bar; b.x = xb_xcc_id(); b.st = st;
    if (threadIdx.x == 0) (void)xb_add(&bar[XB_XCNT(b.x)], 1u);
    return b;
}
__device__ __forceinline__ void xcd_barrier_complete(unsigned* bar, unsigned x, unsigned& nloc, unsigned& nx) {
    const unsigned G = gridDim.x * gridDim.y * gridDim.z;
    unsigned sum, cnt, mine, sp = 0u;
    for (;;) {
        sum = 0u; cnt = 0u; mine = 0u;
#pragma unroll
        for (unsigned j = 0; j < 16; ++j) { const unsigned c = xb_ld(&bar[XB_XCNT(j)]); sum += c; cnt += (c > 0u) ? 1u : 0u; mine = (j == x) ? c : mine; }
        if (sum == G) break;
        __builtin_amdgcn_s_sleep(1);
        if ((++sp & 255u) == 0u) { if (xb_ld(&bar[XB_TMO])) break; if (sp > XB_SPIN_CAP) { atomicAdd(&bar[XB_TMO], 1u); break; } }
    }
    nloc = mine > 0u ? mine : 1u; nx = cnt > 0u ? cnt : 1u;
}
__device__ __forceinline__ void xcd_barrier(const XcdBarrier& b) {
    asm volatile("s_waitcnt vmcnt(0)" ::: "memory");
    __syncthreads();
    if (threadIdx.x == 0) {
        unsigned* bar = b.bar;
        __builtin_amdgcn_s_waitcnt(0);
        unsigned nloc = b.st[0], nx = b.st[1];
        if (nloc == 0u) { xcd_barrier_complete(bar, b.x, nloc, nx); b.st[0] = nloc; b.st[1] = nx; }
        const unsigned old = xb_add(&bar[XB_XSUB(b.x)], 1u);
        const unsigned gen = old / nloc;
        if (old + 1u == (gen + 1u) * nloc) {
            __builtin_amdgcn_fence(__ATOMIC_RELEASE, "agent");
            asm volatile("s_waitcnt vmcnt(0)" ::: "memory");
            const unsigned og = xb_add(&bar[XB_TOP], 1u);
            const unsigned tg = og / nx;
            if (og + 1u == (tg + 1u) * nx) xb_add(&bar[XB_TOPGEN], 1u);
            else XB_SPIN(xb_ld(&bar[XB_TOPGEN]) == tg, bar);
            __builtin_amdgcn_fence(__ATOMIC_ACQUIRE, "agent");
            xb_add(&bar[XB_XGEN(b.x)], 1u);
            asm volatile("s_waitcnt vmcnt(0)" ::: "memory");
        } else {
            XB_SPIN(xb_ld(&bar[XB_XGEN(b.x)]) == gen, bar);
            __builtin_amdgcn_fence(__ATOMIC_ACQUIRE, "agent");
            asm volatile("s_waitcnt vmcnt(0)" ::: "memory");
        }
    }
    __syncthreads();
}

namespace pg8 {
constexpr int BM = 256, BK = 64, HALF = 128, HTB = HALF * BK * 2, NXCD = 8, WGM = 8;
__device__ __forceinline__ int lds_byte(int r, int c) { const int st = (r >> 4) * 2 + (c >> 5), rr = r & 15, cc = c & 31, ob = rr * 64 + cc * 2; return st * 1024 + (ob ^ (((ob >> 9) & 1) << 5)); }
__device__ __forceinline__ void stage_rc(int b, int& R, int& C) { const int st = b / 1024, sb = b % 1024, swz = sb ^ (((sb >> 9) & 1) << 5); R = (st >> 1) * 16 + swz / 64; C = (st & 1) * 32 + (swz % 64) / 2; }
__device__ __forceinline__ int perm32(int rho) { const int n = rho >> 4, i = rho & 15; return 8 * (i >> 2) + 4 * n + (i & 3); }
struct Unit { int pm, pn, e, nrows; };
__device__ __forceinline__ unsigned cvt_pk_bf16(float lo, float hi) { unsigned r; asm volatile("v_cvt_pk_bf16_f32 %0, %1, %2" : "=v"(r) : "v"(lo), "v"(hi)); return r; }

struct StaticOrder {
    int nM, nN, nwg, G, c;
    __device__ void init(int M, int N, int G_, int c_) { nM = M / BM; nN = N / BM; nwg = nM * nN; G = G_; c = c_; }
    __device__ bool next(int i, int& pm, int& pn) const {
        const long L = (long)i * G + c; if (L >= nwg) return false;
        int wgid = (int)L; { const int q = nwg / NXCD, r = nwg % NXCD, xcd = wgid % NXCD, off = wgid / NXCD; wgid = (xcd < r ? xcd * (q + 1) : r * (q + 1) + (xcd - r) * q) + off; }
        const int nig = WGM * nN, gid = wgid / nig, fm = gid * WGM, gsz = (nM - fm) < WGM ? (nM - fm) : WGM;
        pm = fm + ((wgid % nig) % gsz); pn = (wgid % nig) / gsz; return true;
    }
};

template <class P>
__device__ __forceinline__ void gemm_phase(LAS unsigned char* lds, const P& S) {
    const int tid = threadIdx.x, wid = __builtin_amdgcn_readfirstlane(tid >> 6), lane = tid & 63, wr = wid >> 2, wc = wid & 3, fr = lane & 15, fq = lane >> 4;
    const int KB = S.KB, nt = KB / 128;
    int RA[2], CA[2]; unsigned voffB[2];
#pragma unroll
    for (int i = 0; i < 2; ++i) { int R, C; stage_rc(tid * 16 + i * 8192, R, C); RA[i] = R; CA[i] = C * 2; const int Rb = P::PERM ? ((R & ~31) + perm32(R & 31)) : R; voffB[i] = (unsigned)(Rb * KB + C * 2); }
    const unsigned kstep = 128u;
    const unsigned hstepB = (unsigned)HALF * KB;
    const unsigned ldsw = (unsigned)wid * 1024u;
    const int aoff = lds_byte(wr * 64 + fr, fq * 8), boff = lds_byte(wc * 32 + fr, fq * 8);
    constexpr int HI = 1024;
    const __amdgpu_buffer_rsrc_t rsA = __builtin_amdgcn_make_buffer_rsrc((void*)S.A, 0, 0x7fffffff, 0x00020000);
    const __amdgpu_buffer_rsrc_t rsB = __builtin_amdgcn_make_buffer_rsrc((void*)S.Bt, 0, 0x7fffffff, 0x00020000);
#define PG8_SA(b, h) (((b) * 2 + (h)) * HTB)
#define PG8_SB(b, h) ((4 + (b) * 2 + (h)) * HTB)
#define PG8_STGB(bufoff, gbase) do { _Pragma("unroll") for (int _i = 0; _i < 2; ++_i) \
        __builtin_amdgcn_raw_ptr_buffer_load_lds(rsB, (LAS void*)(lds + (bufoff) + ldsw + _i * 8192), 16, voffB[_i], (int)(gbase), 0, 0); } while (0)
#define PG8_STGA(bufoff, kb, o0, o1) do { \
        __builtin_amdgcn_raw_ptr_buffer_load_lds(rsA, (LAS void*)(lds + (bufoff) + ldsw), 16, (o0), (int)(kb), 0, 0); \
        __builtin_amdgcn_raw_ptr_buffer_load_lds(rsA, (LAS void*)(lds + (bufoff) + ldsw + 8192), 16, (o1), (int)(kb), 0, 0); } while (0)
#define PG8_LDA(dst, b, h) do { _Pragma("unroll") for (int m = 0; m < 4; ++m) _Pragma("unroll") for (int k = 0; k < 2; ++k) dst[m][k] = *(const LAS bf16x8*)(lds + PG8_SA(b, h) + aoff + m * 2048 + k * HI); } while (0)
#define PG8_LDB(dst, b, h) do { _Pragma("unroll") for (int n = 0; n < 2; ++n) _Pragma("unroll") for (int k = 0; k < 2; ++k) dst[n][k] = *(const LAS bf16x8*)(lds + PG8_SB(b, h) + boff + n * 2048 + k * HI); } while (0)
#define PG8_CAT(x) __builtin_shufflevector(__builtin_bit_cast(i32x4, (x)[0]), __builtin_bit_cast(i32x4, (x)[1]), 0, 1, 2, 3, 4, 5, 6, 7)
#define PG8_MMA(ai, bj, At, Bt) do { __builtin_amdgcn_s_setprio(1); _Pragma("unroll") for (int m = 0; m < 4; ++m) _Pragma("unroll") for (int n = 0; n < 2; ++n) { \
        if constexpr (P::F8) { const i32x8 a8 = PG8_CAT(Bt[n]), b8 = PG8_CAT(At[m]); asm volatile("v_mfma_f32_16x16x128_f8f6f4 %0, %1, %2, %0" : "+v"(acc[ai][bj][m][n]) : "v"(a8), "v"(b8)); } \
        else { _Pragma("unroll") for (int k = 0; k < 2; ++k) acc[ai][bj][m][n] = __builtin_amdgcn_mfma_f32_16x16x32_bf16(Bt[n][k], At[m][k], acc[ai][bj][m][n], 0, 0, 0); } } \
        __builtin_amdgcn_s_setprio(0); } while (0)
#define PG8_WAIT_V(n) asm volatile("s_waitcnt vmcnt(" #n ")" ::: "memory")
#define PG8_WAIT_L(n) asm volatile("s_waitcnt lgkmcnt(" #n ")" ::: "memory")
#define PG8_BAR __builtin_amdgcn_s_barrier()
#define PG8_SCHED __builtin_amdgcn_sched_barrier(0)
    Unit cur, nxt; int ui = 0;
    if (!S.next(0, cur)) return;
    f32x4 acc[2][2][4][2];
#pragma unroll
    for (int a = 0; a < 2; ++a)
#pragma unroll
        for (int b = 0; b < 2; ++b)
#pragma unroll
            for (int m = 0; m < 4; ++m)
#pragma unroll
                for (int n = 0; n < 2; ++n) acc[a][b][m][n] = (f32x4){0.f, 0.f, 0.f, 0.f};
    bf16x8 At[4][2], B0[2][2], B1[2][2];
    unsigned c00, c01, c10, c11, n00, n01, n10, n11;
    typename P::Pre pre;
    S.aoff(cur, RA[0], RA[1], CA[0], CA[1], c00, c01, c10, c11);
    if constexpr (P::LIST_LDS) { if (wr == 0) S.list_dma(cur, 0, wid, lane); }
    unsigned cB = S.boffs(cur);
    PG8_STGB(PG8_SB(0, 0), cB); PG8_STGB(PG8_SB(0, 1), cB + hstepB); PG8_STGA(PG8_SA(0, 0), 0, c00, c01); PG8_STGA(PG8_SA(0, 1), 0, c10, c11);
    if (wr == 1) PG8_BAR;
    PG8_WAIT_V(2); PG8_BAR;
    PG8_STGB(PG8_SB(1, 0), cB + kstep); PG8_STGA(PG8_SA(1, 0), kstep, c00, c01); PG8_STGB(PG8_SB(1, 1), cB + hstepB + kstep);
    PG8_WAIT_V(6); PG8_BAR;
    for (;;) {
        const bool has_next = S.next(ui + 1, nxt);
        unsigned nB = cB;
        n00 = c00; n01 = c01; n10 = c10; n11 = c11;
        if (has_next) { if constexpr (!P::LIST_LDS) S.aoff(nxt, RA[0], RA[1], CA[0], CA[1], n00, n01, n10, n11); nB = S.boffs(nxt); }
        for (int t = 0; t < nt; t += 2) {
            const bool last = (t == nt - 2);
            if constexpr (P::LIST_LDS) { if (last && has_next) S.aoff_lds(nxt, (ui + 1) & 1, RA[0], RA[1], CA[0], CA[1], n00, n01, n10, n11); }

            const unsigned k1 = (unsigned)(t + 1) * kstep;
            const unsigned k2 = last ? 0u : (unsigned)(t + 2) * kstep, k3 = k2 + kstep;
            const unsigned b2 = last ? nB : cB + (unsigned)(t + 2) * kstep, b3 = b2 + kstep;
            const unsigned x00 = last ? n00 : c00, x01 = last ? n01 : c01, x10 = last ? n10 : c10, x11 = last ? n11 : c11;
            PG8_LDB(B0, 0, 0); PG8_LDB(B1, 0, 1); PG8_SCHED; PG8_LDA(At, 0, 0); PG8_STGA(PG8_SA(1, 1), k1, c10, c11);
            PG8_WAIT_V(8); PG8_WAIT_L(0); PG8_BAR;
            if constexpr (P::LIST_LDS) { if (t == 0 && wr == 0) { S.bias_dma(cur, wid, lane); if (has_next) S.list_dma(nxt, (ui + 1) & 1, wid, lane); } }
            PG8_MMA(0, 0, At, B0); PG8_MMA(0, 1, At, B1); PG8_BAR; PG8_SCHED;
            PG8_LDA(At, 0, 1); PG8_STGB(PG8_SB(0, 0), b2); PG8_STGB(PG8_SB(0, 1), b2 + hstepB); PG8_STGA(PG8_SA(0, 0), k2, x00, x01);
            PG8_WAIT_V(8); PG8_WAIT_L(0); PG8_BAR; PG8_MMA(1, 0, At, B0); PG8_MMA(1, 1, At, B1); PG8_BAR; PG8_SCHED;
            PG8_LDB(B0, 1, 0); PG8_LDB(B1, 1, 1); PG8_SCHED; PG8_LDA(At, 1, 0); PG8_STGA(PG8_SA(0, 1), k2, x10, x11);
            PG8_WAIT_V(8); PG8_WAIT_L(0); PG8_BAR; PG8_MMA(0, 0, At, B0); PG8_MMA(0, 1, At, B1); PG8_BAR; PG8_SCHED;
            PG8_LDA(At, 1, 1); PG8_STGB(PG8_SB(1, 0), b3); PG8_STGB(PG8_SB(1, 1), b3 + hstepB); PG8_STGA(PG8_SA(1, 0), k3, x00, x01);
            PG8_WAIT_V(8); PG8_WAIT_L(0); PG8_BAR; PG8_MMA(1, 0, At, B0); PG8_MMA(1, 1, At, B1); PG8_BAR; PG8_SCHED;
        }
        if (wr == 0) PG8_BAR;
        if constexpr (P::F8) asm volatile("s_nop 15\n\ts_nop 15" ::: "memory");
        if (!P::DUP || (ui & 1)) { S.pre_load(cur, pre, wc, fq); S.epi(acc, cur, pre, ui & 1, wr, wc, fr, fq); }
        if (!has_next) break;
        if (!P::DUP || (ui & 1)) {
#pragma unroll
        for (int a = 0; a < 2; ++a)
#pragma unroll
            for (int b = 0; b < 2; ++b)
#pragma unroll
                for (int m = 0; m < 4; ++m)
#pragma unroll
                    for (int n = 0; n < 2; ++n) acc[a][b][m][n] = (f32x4){0.f, 0.f, 0.f, 0.f};
        }
        cur = nxt; cB = nB; c00 = n00; c01 = n01; c10 = n10; c11 = n11; ++ui;
        if (wr == 1) PG8_BAR;
    }
    PG8_WAIT_V(0);
    PG8_BAR;
#undef PG8_SA
#undef PG8_SB
#undef PG8_STGA
#undef PG8_STGB
#undef PG8_LDA
#undef PG8_LDB
#undef PG8_MMA
#undef PG8_WAIT_V
#undef PG8_WAIT_L
#undef PG8_BAR
#undef PG8_SCHED
}
}

struct Frame {
    LAS unsigned char* lds;
    volatile LAS unsigned* MISC;
    GAS unsigned* ctl;
    int tid, lane, wave, vcu, G;
    const float *x, *c, *w_ada, *b_ada, *g_pre_mix, *g_post_mix, *w_in, *w_gk_fwd, *b_gk_fwd, *w_gk_bwd, *b_gk_bwd, *g_gla_out, *attn_sink, *w_out,
                *g_pre_ffn, *g_post_ffn, *w_router, *b_router, *w_gate_up, *b_gate_up, *w_down, *b_down;
    float* out;
    float *MOD, *ROPE, *GATE, *DEC, *UT; bf16* Y;
    bf16 *WR_T, *WIN_T, *WOUT_T, *H, *PROJ, *ST, *O, *H2, *Y2, *WG_T;
    unsigned char *WGU_T, *WD_T, *ACT, *H2F8;
    int* LIST;
};

struct ProjPolicy {
    static constexpr bool PERM = true;
    static constexpr bool F8 = false, DUP = false, LIST_LDS = false;
    struct Pre {};
    __device__ __forceinline__ void pre_load(const pg8::Unit&, Pre&, int, int) const {}
    const bf16* A; const bf16* Bt; int KB; pg8::StaticOrder so; bf16* O; const float* rope;
    __device__ __forceinline__ bool next(int i, pg8::Unit& u) const { u.e = 0; u.nrows = 256; return so.next(i, u.pm, u.pn); }
    __device__ __forceinline__ void aoff(const pg8::Unit& u, int R0, int R1, int C0, int C1, unsigned& o00, unsigned& o01, unsigned& o10, unsigned& o11) const {
        const unsigned b = (unsigned)u.pm * 256u;
        o00 = (b + R0) * KB + C0; o01 = (b + R1) * KB + C1; o10 = (b + 128 + R0) * KB + C0; o11 = (b + 128 + R1) * KB + C1;
    }
    __device__ __forceinline__ unsigned boffs(const pg8::Unit& u) const { return (unsigned)u.pn * 256u * KB; }
    __device__ __forceinline__ void epi(const f32x4 (&acc)[2][2][4][2], const pg8::Unit& u, const Pre&, int, int wr, int wc, int fr, int fq) const {
        const int row0 = u.pm * 256 + wr * 64 + fr;
#pragma unroll
        for (int bj = 0; bj < 2; ++bj) {
            const int cb = u.pn * 256 + bj * 128 + wc * 32;
            const float sc = (cb < C_GK || (cb >= C_AQ && cb < C_AK)) ? 0.125f : 1.f;
            const bool rot = (cb >= C_AQ) && (cb < C_AV) && (((cb - C_AQ) & 63) == 0);
            const float sg = (fq == 0) ? -1.f : 1.f;
#pragma unroll
            for (int ai = 0; ai < 2; ++ai)
#pragma unroll
                for (int m = 0; m < 4; ++m) {
                    const int row = row0 + ai * 128 + m * 16;
                    f32x4 v0 = acc[ai][bj][m][0], v1 = acc[ai][bj][m][1];
                    if (rot) {
                        const float* rp = rope + (size_t)(row & (SEQ - 1)) * 16;
                        const f32x4 c0 = *(const f32x4*)(rp), c1 = *(const f32x4*)(rp + 4), s0 = *(const f32x4*)(rp + 8), s1 = *(const f32x4*)(rp + 12);
                        f32x4 p0, p1;
#pragma unroll
                        for (int j = 0; j < 4; ++j) { p0[j] = __shfl_xor(v0[j], 16); p1[j] = __shfl_xor(v1[j], 16); }
                        if (fq < 2) { v0 = v0 * c0 + (p0 * s0) * sg; v1 = v1 * c1 + (p1 * s1) * sg; }
                    }
                    v0 = v0 * sc; v1 = v1 * sc;
                    v4u w; w.x = pg8::cvt_pk_bf16(v0[0], v0[1]); w.y = pg8::cvt_pk_bf16(v0[2], v0[3]); w.z = pg8::cvt_pk_bf16(v1[0], v1[1]); w.w = pg8::cvt_pk_bf16(v1[2], v1[3]);
                    *(v4u*)(O + (size_t)row * DINP + cb + 8 * fq) = w;
                }
        }
    }
};
struct OutPolicy {
    static constexpr bool PERM = true;
    static constexpr bool F8 = false, DUP = false, LIST_LDS = false;
    struct Pre {};
    __device__ __forceinline__ void pre_load(const pg8::Unit&, Pre&, int, int) const {}
    const bf16* A; const bf16* Bt; int KB; pg8::StaticOrder so; bf16* C;
    __device__ __forceinline__ bool next(int i, pg8::Unit& u) const { u.e = 0; u.nrows = 256; return so.next(i, u.pm, u.pn); }
    __device__ __forceinline__ void aoff(const pg8::Unit& u, int R0, int R1, int C0, int C1, unsigned& o00, unsigned& o01, unsigned& o10, unsigned& o11) const {
        const unsigned b = (unsigned)u.pm * 256u;
        o00 = (b + R0) * KB + C0; o01 = (b + R1) * KB + C1; o10 = (b + 128 + R0) * KB + C0; o11 = (b + 128 + R1) * KB + C1;
    }
    __device__ __forceinline__ unsigned boffs(const pg8::Unit& u) const { return (unsigned)u.pn * 256u * KB; }
    __device__ __forceinline__ void epi(const f32x4 (&acc)[2][2][4][2], const pg8::Unit& u, const Pre&, int, int wr, int wc, int fr, int fq) const {
        const int row0 = u.pm * 256 + wr * 64 + fr, col0 = u.pn * 256 + wc * 32 + 8 * fq;
#pragma unroll
        for (int ai = 0; ai < 2; ++ai)
#pragma unroll
            for (int m = 0; m < 4; ++m) { bf16* rowp = C + (size_t)(row0 + ai * 128 + m * 16) * D + col0;
#pragma unroll
                for (int bj = 0; bj < 2; ++bj) { const f32x4 v0 = acc[ai][bj][m][0], v1 = acc[ai][bj][m][1];
                    v4u w; w.x = pg8::cvt_pk_bf16(v0[0], v0[1]); w.y = pg8::cvt_pk_bf16(v0[2], v0[3]); w.z = pg8::cvt_pk_bf16(v1[0], v1[1]); w.w = pg8::cvt_pk_bf16(v1[2], v1[3]);
                    *(v4u*)(rowp + bj * 128) = w; } }
    }
};
struct MoePolicyBase {
    const volatile LAS int* tb; const volatile LAS int* rtab; const int* cnt; const int* list; int G, c, ncol;
    __device__ __forceinline__ bool next_rt(int i, pg8::Unit& u) const {
        const int NT = tb[32];
        int rt, pn;
        if ((G & 7) == 0) {
            const int x = c & 7, j = c >> 3, per = G >> 3, base = NT >> 3, rem = NT & 7, len = base + (x < rem ? 1 : 0), start = x * base + (x < rem ? x : rem);
            const int uidx = i * per + j, rl = uidx / ncol; if (rl >= len) return false;
            rt = start + rl; pn = uidx - rl * ncol;
        } else { const int L = i * G + c; if (L >= NT * ncol) return false; rt = L / ncol; pn = L - rt * ncol; }
        const int w = rtab[rt];
        u.pn = pn; u.pm = rt; u.e = w & 255; u.nrows = (w >> 8) & 511; return true;
    }
    __device__ __forceinline__ int slot0(const pg8::Unit& u) const { return (int)((unsigned)rtab[u.pm] >> 17); }
    LAS unsigned char* llds;
    __device__ __forceinline__ void list_dma(const pg8::Unit& u, int buf, int wid, int lane) const {
        const __amdgpu_buffer_rsrc_t rs = __builtin_amdgcn_make_buffer_rsrc((void*)list, 0, 0x7fffffff, 0x00020000);
        __builtin_amdgcn_raw_ptr_buffer_load_lds(rs, (LAS void*)(llds + buf * 1024 + wid * 256), 4, (unsigned)(wid * 256 + lane * 4), (int)(((unsigned)u.e * LCAP + (unsigned)slot0(u)) * 4u), 0, 0);
    }
    __device__ __forceinline__ void lds16x4(unsigned a0, unsigned a1, unsigned a2, unsigned a3, f32x4& v0, f32x4& v1, f32x4& v2, f32x4& v3) const {
        asm volatile("ds_read_b128 %0, %4\n\tds_read_b128 %1, %5\n\tds_read_b128 %2, %6\n\tds_read_b128 %3, %7\n\ts_waitcnt lgkmcnt(0)"
                     : "=&v"(v0), "=&v"(v1), "=&v"(v2), "=&v"(v3) : "v"(a0), "v"(a1), "v"(a2), "v"(a3) : "memory");
    }
    __device__ __forceinline__ void list_lds4(int buf, int r0, int r1, int r2, int r3, int& v0, int& v1, int& v2, int& v3) const {
        const unsigned base = (unsigned)(uintptr_t)(llds + buf * 1024);
        asm volatile("ds_read_b32 %0, %4\n\tds_read_b32 %1, %5\n\tds_read_b32 %2, %6\n\tds_read_b32 %3, %7\n\ts_waitcnt lgkmcnt(0)"
                     : "=&v"(v0), "=&v"(v1), "=&v"(v2), "=&v"(v3) : "v"(base + r0 * 4), "v"(base + r1 * 4), "v"(base + r2 * 4), "v"(base + r3 * 4) : "memory");
    }
};
struct Moe1Policy : MoePolicyBase {
#ifdef PROBE_DUP1
    static constexpr bool PERM = true, F8 = true, DUP = true, LIST_LDS = false;
    static constexpr float DSC = 0.5f;
#else
    static constexpr bool PERM = true, F8 = true, DUP = false, LIST_LDS = true;
    static constexpr float DSC = 1.0f;
#endif
    struct Pre { f32x4 g0, g1, u0, u1; };
    const unsigned char* A; const unsigned char* Bt; int KB; unsigned char* ACTp; const float* bias;
    __device__ __forceinline__ bool next(int i, pg8::Unit& u) const { return next_rt(DUP ? (i >> 1) : i, u); }
    __device__ __forceinline__ void bias_dma(const pg8::Unit& u, int wid, int lane) const {
        const __amdgpu_buffer_rsrc_t rs = __builtin_amdgcn_make_buffer_rsrc((void*)bias, 0, 0x7fffffff, 0x00020000);
        __builtin_amdgcn_raw_ptr_buffer_load_lds(rs, (LAS void*)(llds + 2048 + wid * 256), 4, (unsigned)((((wid & 1) * 64 + lane) + (wid >> 1) * 1024) * 4), (int)(((unsigned)u.e * 2048u + (unsigned)u.pn * 128u) * 4u), 0, 0);
    }
    __device__ __forceinline__ void pre_load(const pg8::Unit&, Pre& p, int wc, int fq) const {
        const unsigned a = (unsigned)(uintptr_t)(llds + 2048) + (unsigned)(wc * 32 + 8 * fq) * 4u;
        lds16x4(a, a + 16, a + 512, a + 528, p.g0, p.g1, p.u0, p.u1);
    }
    __device__ __forceinline__ void offs(const pg8::Unit& u, int R0, int R1, int C0, int C1, int v00, int v01, int v10, int v11, unsigned& o00, unsigned& o01, unsigned& o10, unsigned& o11) const {
        const int t00 = (R0 < u.nrows) ? ((v00 & 0xffff) >> 2) : 0, t01 = (R1 < u.nrows) ? ((v01 & 0xffff) >> 2) : 0;
        const int t10 = (R0 + 128 < u.nrows) ? ((v10 & 0xffff) >> 2) : 0, t11 = (R1 + 128 < u.nrows) ? ((v11 & 0xffff) >> 2) : 0;
        o00 = (unsigned)t00 * KB + C0; o01 = (unsigned)t01 * KB + C1; o10 = (unsigned)t10 * KB + C0; o11 = (unsigned)t11 * KB + C1;
    }
    __device__ __forceinline__ void aoff(const pg8::Unit& u, int R0, int R1, int C0, int C1, unsigned& o00, unsigned& o01, unsigned& o10, unsigned& o11) const {
        const int* lp = list + (size_t)u.e * LCAP + slot0(u);
        const int v00 = lp[R0], v01 = lp[R1], v10 = lp[R0 + 128], v11 = lp[R1 + 128];
        offs(u, R0, R1, C0, C1, v00, v01, v10, v11, o00, o01, o10, o11);
    }
    __device__ __forceinline__ void aoff_lds(const pg8::Unit& u, int buf, int R0, int R1, int C0, int C1, unsigned& o00, unsigned& o01, unsigned& o10, unsigned& o11) const {
        int v00, v01, v10, v11; list_lds4(buf, R0, R1, R0 + 128, R1 + 128, v00, v01, v10, v11);
        offs(u, R0, R1, C0, C1, v00, v01, v10, v11, o00, o01, o10, o11);
    }
    __device__ __forceinline__ unsigned boffs(const pg8::Unit& u) const { return ((unsigned)u.e * 2048u + (unsigned)u.pn * 256u) * KB; }
    __device__ __forceinline__ void epi(const f32x4 (&acc)[2][2][4][2], const pg8::Unit& u, const Pre& p, int, int wr, int wc, int fr, int fq) const {
        const int row0 = u.pm * 256 + wr * 64 + fr, col0 = u.pn * 128 + wc * 32 + 8 * fq;
        const f32x4 g0 = p.g0, g1 = p.g1, u0 = p.u0, u1 = p.u1;
#pragma unroll
        for (int ai = 0; ai < 2; ++ai)
#pragma unroll
            for (int m = 0; m < 4; ++m) {
                float a[8];
#pragma unroll
                for (int n = 0; n < 2; ++n)
#pragma unroll
                    for (int hh = 0; hh < 2; ++hh) {
                        const f32x2 ga = {acc[ai][0][m][n][2 * hh], acc[ai][0][m][n][2 * hh + 1]}, ua = {acc[ai][1][m][n][2 * hh], acc[ai][1][m][n][2 * hh + 1]};
                        const f32x2 gb = n ? (f32x2){g1[2 * hh], g1[2 * hh + 1]} : (f32x2){g0[2 * hh], g0[2 * hh + 1]};
                        const f32x2 ub = n ? (f32x2){u1[2 * hh], u1[2 * hh + 1]} : (f32x2){u0[2 * hh], u0[2 * hh + 1]};
                        f32x2 g = ga * (WSC_INV * DSC) + gb, u = ua * (WSC_INV * DSC * ASC) + (ub + 1.0f) * ASC;
                        g.x = fminf(g.x, 7.0f); g.y = fminf(g.y, 7.0f);
                        u.x = __builtin_amdgcn_fmed3f(u.x, -6.0f * ASC, 8.0f * ASC); u.y = __builtin_amdgcn_fmed3f(u.y, -6.0f * ASC, 8.0f * ASC);
                        const f32x2 t = g * (-1.702f * 1.44269504f);
                        f32x2 e; e.x = __builtin_amdgcn_exp2f(t.x); e.y = __builtin_amdgcn_exp2f(t.y);
                        e = e + 1.0f;
                        f32x2 sg; sg.x = __builtin_amdgcn_rcpf(e.x); sg.y = __builtin_amdgcn_rcpf(e.y);
                        const f32x2 r = (u * g) * sg;
                        a[n * 4 + 2 * hh] = r.x; a[n * 4 + 2 * hh + 1] = r.y;
                    }
                v2u w; w.x = pk4_fp8(a[0], a[1], a[2], a[3]); w.y = pk4_fp8(a[4], a[5], a[6], a[7]);
                *(v2u*)(ACTp + (size_t)(row0 + ai * 128 + m * 16) * DFF + col0) = w;
            }
    }
};
struct Moe2Policy : MoePolicyBase {
    static constexpr bool PERM = true, F8 = true, DUP = false, LIST_LDS = true;
    struct Pre { f32x4 bv[2][2]; };
    const unsigned char* A; const unsigned char* Bt; int KB; unsigned char* Y2p; const float* bias;
    __device__ __forceinline__ bool next(int i, pg8::Unit& u) const { return next_rt(i, u); }
    __device__ __forceinline__ void bias_dma(const pg8::Unit& u, int wid, int lane) const {
        const __amdgpu_buffer_rsrc_t rs = __builtin_amdgcn_make_buffer_rsrc((void*)bias, 0, 0x7fffffff, 0x00020000);
        __builtin_amdgcn_raw_ptr_buffer_load_lds(rs, (LAS void*)(llds + 2048 + wid * 256), 4, (unsigned)((wid * 64 + lane) * 4), (int)(((unsigned)u.e * 1024u + (unsigned)u.pn * 256u) * 4u), 0, 0);
    }
    __device__ __forceinline__ void pre_load(const pg8::Unit&, Pre& p, int wc, int fq) const {
        const unsigned a = (unsigned)(uintptr_t)(llds + 2048) + (unsigned)(wc * 32 + 8 * fq) * 4u;
        lds16x4(a, a + 16, a + 512, a + 528, p.bv[0][0], p.bv[0][1], p.bv[1][0], p.bv[1][1]);
    }
    __device__ __forceinline__ void aoff(const pg8::Unit& u, int R0, int R1, int C0, int C1, unsigned& o00, unsigned& o01, unsigned& o10, unsigned& o11) const {
        const unsigned b = (unsigned)u.pm * 256u;
        o00 = (b + R0) * KB + C0; o01 = (b + R1) * KB + C1; o10 = (b + 128 + R0) * KB + C0; o11 = (b + 128 + R1) * KB + C1;
    }
    __device__ __forceinline__ void aoff_lds(const pg8::Unit& u, int, int R0, int R1, int C0, int C1, unsigned& o00, unsigned& o01, unsigned& o10, unsigned& o11) const { aoff(u, R0, R1, C0, C1, o00, o01, o10, o11); }
    __device__ __forceinline__ unsigned boffs(const pg8::Unit& u) const { return ((unsigned)u.e * 1024u + (unsigned)u.pn * 256u) * KB; }
    __device__ __forceinline__ void epi(const f32x4 (&acc)[2][2][4][2], const pg8::Unit& u, const Pre& p, int buf, int wr, int wc, int fr, int fq) const {
        const int colb = u.pn * 256 + wc * 32 + 8 * fq;
        int ent[2][4];
#pragma unroll
        for (int ai = 0; ai < 2; ++ai) { const int r = ai * 128 + wr * 64 + fr; list_lds4(buf, r, r + 16, r + 32, r + 48, ent[ai][0], ent[ai][1], ent[ai][2], ent[ai][3]); }
#pragma unroll
        for (int ai = 0; ai < 2; ++ai)
#pragma unroll
            for (int m = 0; m < 4; ++m) {
                const int r = ai * 128 + wr * 64 + m * 16 + fr;
                if (r < u.nrows) {
                    const int asg = ent[ai][m] & 0xffff; const float g = bf2f((unsigned)ent[ai][m] >> 16);
                    unsigned char* rowp = Y2p + (size_t)asg * D + colb;
                    const float gs = g * YSC;
#pragma unroll
                    for (int bj = 0; bj < 2; ++bj) {
                        const f32x4 v0 = (acc[ai][bj][m][0] * (WSC_INV / ASC) + p.bv[bj][0]) * gs, v1 = (acc[ai][bj][m][1] * (WSC_INV / ASC) + p.bv[bj][1]) * gs;
                        v2u w; w.x = pk4_fp8(sat8(v0[0]), sat8(v0[1]), sat8(v0[2]), sat8(v0[3])); w.y = pk4_fp8(sat8(v1[0]), sat8(v1[1]), sat8(v1[2]), sat8(v1[3]));
                        *(v2u*)(rowp + bj * 128) = w;
                    }
                }
            }
    }
};

__device__ __forceinline__ void p0_cvt_bf16_item(const float* W, int K, int N, bf16* WT, int kb, int n0, int drow0, int lane) {
    const int n = lane & 31, q = lane >> 5; const float* src = W + (size_t)(64 * kb + 32 * q) * N + n0 + n;
    float v[32];
#pragma unroll
    for (int i = 0; i < 32; ++i) v[i] = src[(size_t)i * N];
    GAS v4u* dst = (GAS v4u*)(WT + (size_t)(drow0 + n) * K + 64 * kb + 32 * q);
#pragma unroll
    for (int j = 0; j < 4; ++j) { v4u o; o.x = pk2(v[8 * j], v[8 * j + 1]); o.y = pk2(v[8 * j + 2], v[8 * j + 3]); o.z = pk2(v[8 * j + 4], v[8 * j + 5]); o.w = pk2(v[8 * j + 6], v[8 * j + 7]); dst[j] = o; }
}
struct F8Desc { const float* src; unsigned char* dst; int N; };
__device__ __forceinline__ F8Desc p0_f8_desc(const Frame& F, int it, int lane) {
    constexpr int I_GU = 8 * 64, I_D = 8 * 32;
    const int e = it / (I_GU + I_D); int r = it - e * (I_GU + I_D);
    const int n4 = lane & 7, kg = lane >> 3;
    F8Desc d;
    if (r < I_GU) { const int nb = r & 63, kb = r >> 6, n0 = nb * 32;
        const int drow = (n0 < 1024) ? ((n0 >> 7) * 256 + (n0 & 127)) : ((((n0 - 1024) >> 7) * 256) + 128 + ((n0 - 1024) & 127));
        d.N = 2048; d.src = F.w_gate_up + (size_t)e * D * 2048 + (size_t)(128 * kb + 16 * kg) * 2048 + n0 + 4 * n4;
        d.dst = F.WGU_T + ((size_t)e * 2048 + drow + 4 * n4) * D + 128 * kb + 16 * kg; }
    else { r -= I_GU; const int nb = r & 31, kb = r >> 5, n0 = nb * 32;
        d.N = D; d.src = F.w_down + (size_t)e * DFF * D + (size_t)(128 * kb + 16 * kg) * D + n0 + 4 * n4;
        d.dst = F.WD_T + ((size_t)e * D + n0 + 4 * n4) * DFF + 128 * kb + 16 * kg; }
    return d;
}
__device__ __forceinline__ void p0_f8_load(f32x4 (&v)[16], const F8Desc& d) {
#pragma unroll
    for (int i = 0; i < 16; ++i) v[i] = __builtin_nontemporal_load((const f32x4*)(d.src + (size_t)i * d.N));
}
__device__ __forceinline__ void p0_f8_store(const f32x4 (&v)[16], const F8Desc& d) {
#pragma unroll
    for (int c = 0; c < 4; ++c) { v4u o;
        o.x = pk4_fp8(v[0][c] * WSC, v[1][c] * WSC, v[2][c] * WSC, v[3][c] * WSC); o.y = pk4_fp8(v[4][c] * WSC, v[5][c] * WSC, v[6][c] * WSC, v[7][c] * WSC);
        o.z = pk4_fp8(v[8][c] * WSC, v[9][c] * WSC, v[10][c] * WSC, v[11][c] * WSC); o.w = pk4_fp8(v[12][c] * WSC, v[13][c] * WSC, v[14][c] * WSC, v[15][c] * WSC);
        __builtin_nontemporal_store(o, (v4u*)(d.dst + (size_t)c * D)); }
}
__device__ __forceinline__ void p0_prologue(Frame& F) {
    const int gw = F.vcu * NWAVES + F.wave, NGW = F.G * NWAVES;
    {
        LAS float* cact = (LAS float*)(F.lds);
        LAS float* red = (LAS float*)(F.lds + 8192);
        for (int i = F.tid; i < 2048; i += 512) { const float v = F.c[i]; cact[i] = v / (1.0f + __expf(-v)); }
        __syncthreads();
        for (int it = F.vcu; it < 256; it += F.G) {
            const int col = F.lane % 24, kp = F.lane / 24, j = it * 24 + col, k0 = F.wave * 128;
            float a0 = 0.f, a1 = 0.f;
            if (kp < 2) {
#pragma unroll 16
                for (int k = 0; k < 64; ++k) { const int kk = k0 + 2 * k + kp; const float w = F.w_ada[(size_t)kk * 6144 + j]; a0 += cact[kk] * w; a1 += cact[1024 + kk] * w; }
            }
            a0 += __shfl(a0, (F.lane + 24) & 63); a1 += __shfl(a1, (F.lane + 24) & 63);
            if (F.lane < 24) { red[(F.wave * 2 + 0) * 24 + col] = a0; red[(F.wave * 2 + 1) * 24 + col] = a1; }
            __syncthreads();
            if (F.tid < 48) { const int b = F.tid / 24, cc = F.tid % 24; float s = F.b_ada[it * 24 + cc];
#pragma unroll
                for (int w = 0; w < 8; ++w) s += red[(w * 2 + b) * 24 + cc];
                F.MOD[b * 6144 + it * 24 + cc] = s; }
            __syncthreads();
        }
    }
    for (int idx = (F.vcu * 512 + F.tid); idx < SEQ * 8; idx += F.G * 512) {
        const int t = idx >> 3, i = idx & 7;
        const float inv = powf(500000.0f, -(float)i / 8.0f);
        const float ang = (float)t * inv;
        const double rev = (double)ang * 0.15915494309189535;
        const float fr = (float)(rev - rint(rev));
        F.ROPE[t * 16 + i] = __builtin_amdgcn_cosf(fr); F.ROPE[t * 16 + 8 + i] = __builtin_amdgcn_sinf(fr);
    }
    for (int idx = F.vcu * 512 + F.tid; idx < 2 * 256 * 16; idx += F.G * 512) { const int dir = idx >> 12, n = (idx >> 4) & 255, r = idx & 15;
        F.WG_T[idx] = (bf16)f2bf((dir ? F.w_gk_bwd : F.w_gk_fwd)[r * 256 + n]); }
    { v4u z = {0u, 0u, 0u, 0u}; GAS v4u* p = (GAS v4u*)(F.WIN_T + (size_t)DIN * D); const int n = (DINP - DIN) * D * 2 / 16;
      for (int i = F.vcu * 512 + F.tid; i < n; i += F.G * 512) p[i] = z; }
    constexpr int I_IN = 16 * (DIN / 32), I_OUT = 16 * 32, I_R = 16;
    for (int it = gw; it < I_IN + I_OUT + I_R; it += NGW) {
        int r = it;
        if (r < I_IN) { const int nb = r % (DIN / 32), kb = r / (DIN / 32); p0_cvt_bf16_item(F.w_in, D, DIN, F.WIN_T, kb, nb * 32, nb * 32, F.lane); continue; } r -= I_IN;
        if (r < I_OUT) { const int nb = r % 32, kb = r / 32; p0_cvt_bf16_item(F.w_out, D, D, F.WOUT_T, kb, nb * 32, nb * 32, F.lane); continue; } r -= I_OUT;
        p0_cvt_bf16_item(F.w_router, D, NE, F.WR_T, r, 0, 0, F.lane);
    }
}
constexpr int N8_ITEMS = NE * (8 * 64 + 8 * 32), K8 = 10, NB8 = K8 * 256, NA8 = N8_ITEMS - NB8;
#ifndef NG2
#define NG2 128
#endif
template <int LIST> __device__ __forceinline__ int f8_item(int v) {
    if (LIST == 0) { if (v < (NE - K8) * 768) return v; const int w = v - (NE - K8) * 768; return (NE - K8 + (w >> 9)) * 768 + (w & 511); }
    return (NE - K8 + (v >> 8)) * 768 + 512 + (v & 255);
}
template <int LIST> __device__ __forceinline__ void p0_f8_convert(Frame& F, int lo, int hi, int wv, int nw) {
    f32x4 va[16], vb[16];
    int it = lo + wv;
    if (it < hi) p0_f8_load(va, p0_f8_desc(F, f8_item<LIST>(it), F.lane));
    for (; it < hi; it += 2 * nw) {
        const bool hb = it + nw < hi, ha = it + 2 * nw < hi;
        if (hb) p0_f8_load(vb, p0_f8_desc(F, f8_item<LIST>(it + nw), F.lane));
        p0_f8_store(va, p0_f8_desc(F, f8_item<LIST>(it), F.lane));
        if (ha) p0_f8_load(va, p0_f8_desc(F, f8_item<LIST>(it + 2 * nw), F.lane));
        if (hb) p0_f8_store(vb, p0_f8_desc(F, f8_item<LIST>(it + nw), F.lane));
    }
}

__device__ __forceinline__ void p1_norm(Frame& F) {
    LAS float* sc = (LAS float*)(F.lds);
    LAS float* sh = (LAS float*)(F.lds + 4096);
    for (int rg = F.vcu; rg < T / 64; rg += F.G) {
        const int b = (rg * 64) / SEQ;
        __syncthreads();
        for (int i = F.tid; i < D; i += 512) { sc[i] = F.g_pre_mix[i] * (1.0f + F.MOD[b * 6144 + 1024 + i]); sh[i] = F.MOD[b * 6144 + i]; }
        __syncthreads();
        for (int rr = 0; rr < 8; ++rr) {
            const int row = rg * 64 + F.wave * 8 + rr;
            const GAS f32x4* xr = (const GAS f32x4*)(F.x + (size_t)row * D) + F.lane;
            f32x4 v[4]; float s = 0.f;
#pragma unroll
            for (int j = 0; j < 4; ++j) { v[j] = xr[64 * j]; s += (v[j].x * v[j].x + v[j].y * v[j].y) + (v[j].z * v[j].z + v[j].w * v[j].w); }
            const float rinv = 1.0f / sqrtf(wave_sum(s) * (1.0f / D) + EPS);
            GAS v2u* o8 = (GAS v2u*)(F.H + (size_t)row * D) + F.lane;
#pragma unroll
            for (int j = 0; j < 4; ++j) { const f32x4 a = *(const LAS f32x4*)(sc + 4 * F.lane + 256 * j), c = *(const LAS f32x4*)(sh + 4 * F.lane + 256 * j);
                const f32x4 h = (v[j] * rinv) * a + c; v2u w; w.x = pk2(h.x, h.y); w.y = pk2(h.z, h.w); o8[64 * j] = w; }
        }
    }
}

__device__ __forceinline__ f32x4 mfma16(bf16x8 a, bf16x8 b, f32x4 c) { return __builtin_amdgcn_mfma_f32_16x16x32_bf16(a, b, c, 0, 0, 0); }
typedef short s16x4 __attribute__((ext_vector_type(4)));
__device__ __forceinline__ v2u lds_tr16(const LAS bf16* p) { return __builtin_bit_cast(v2u, __builtin_amdgcn_ds_read_tr16_b64_v4i16((LAS s16x4*)p)); }
struct AttnLd { v4u kv[6], vv[6]; };
__device__ __forceinline__ void attn_load(const Frame& F, int unit, AttnLd& L) {
    const int qb = unit & 63, g = (unit >> 6) & 1, b = unit >> 7, kbase = qb * 128 - 128;
#pragma unroll
    for (int i = 0; i < 6; ++i) { const int idx = F.tid + 512 * i, r = idx >> 3, ch = idx & 7, kp = kbase + r;
        L.kv[i] = (v4u){0u, 0u, 0u, 0u}; L.vv[i] = (v4u){0u, 0u, 0u, 0u};
        if (kp >= 0 && kp < SEQ) { const bf16* rowp = F.PROJ + (size_t)(b * SEQ + kp) * DINP; L.kv[i] = *(const v4u*)(rowp + C_AK + g * 64 + ch * 8); L.vv[i] = *(const v4u*)(rowp + C_AV + g * 64 + ch * 8); } }
}
__device__ __forceinline__ void attn_compute(Frame& F, int unit, const AttnLd& L) {
    const int qb = unit & 63, g = (unit >> 6) & 1, b = unit >> 7;
    LAS bf16* KL = (LAS bf16*)F.lds;
    LAS bf16* VR = (LAS bf16*)(F.lds + 384 * 72 * 2);
    const int kbase = qb * 128 - 128;
    __syncthreads();
#pragma unroll
    for (int i = 0; i < 6; ++i) { const int idx = F.tid + 512 * i, r = idx >> 3, ch = idx & 7;
        *(LAS v4u*)(KL + r * 72 + ch * 8) = L.kv[i]; *(LAS v4u*)(VR + r * 80 + ch * 8) = L.vv[i]; }
    __syncthreads();
    const int fr = F.lane & 15, fq = F.lane >> 4;
    const int hq = 4 * g + (F.wave >> 1);
    const float sink = F.attn_sink[hq];
    constexpr float L2E = 1.44269504f;
    const bf16* qbase = F.PROJ + (size_t)(b * SEQ + qb * 128 + 64 * (F.wave & 1) + fr) * DINP + C_AQ + hq * 64 + 8 * fq;
    bf16x8 qn0 = *(const bf16x8*)(qbase), qn1 = *(const bf16x8*)(qbase + 32);
    const LAS bf16* vbase = VR + (4 * fq + (fr >> 2)) * 80 + 4 * (fr & 3);
#pragma unroll 1
    for (int rt = 0; rt < 4; ++rt) {
        const int tq0 = 64 * (F.wave & 1) + 16 * rt;
        const int qrow = b * SEQ + qb * 128 + tq0 + fr;
        const bf16x8 qf0 = qn0, qf1 = qn1;
        if (rt < 3) { const bf16* qp = qbase + (size_t)(16 * (rt + 1)) * DINP; qn0 = *(const bf16x8*)(qp); qn1 = *(const bf16x8*)(qp + 32); }
        int kt0 = tq0 >> 4; kt0 = kt0 > 6 ? 6 : kt0;
        f32x4 sc[18];
#pragma unroll
        for (int jj = 0; jj < 18; ++jj) {
            const LAS bf16* kp = KL + ((kt0 + jj) * 16 + fr) * 72 + 8 * fq;
            const bf16x8 k0 = *(const LAS bf16x8*)(kp), k1 = *(const LAS bf16x8*)(kp + 32);
            f32x4 a = {0.f, 0.f, 0.f, 0.f};
            a = mfma16(k0, qf0, a); a = mfma16(k1, qf1, a);
            sc[jj] = a;
        }
        const int tq = tq0 + fr;
        float m = sink;
#pragma unroll
        for (int jj = 0; jj < 18; ++jj) {
            const int k0t = (kt0 + jj) * 16;
            const bool full = (k0t >= tq0 + 15) && (k0t + 15 <= tq0 + 256) && (kbase + k0t >= 0) && (kbase + k0t + 15 < SEQ);
            if (full) {
#pragma unroll
                for (int r = 0; r < 4; ++r) m = fmaxf(m, sc[jj][r]);
            } else {
#pragma unroll
                for (int r = 0; r < 4; ++r) {
                    const int ki = k0t + 4 * fq + r, kp = kbase + ki;
                    const bool valid = (ki >= tq) && (ki <= tq + 256) && (kp >= 0) && (kp < SEQ);
                    sc[jj][r] = valid ? sc[jj][r] : -1e30f;
                    m = fmaxf(m, sc[jj][r]);
                }
            }
        }
        m = fmaxf(m, __shfl_xor(m, 16)); m = fmaxf(m, __shfl_xor(m, 32));
        float sum = 0.f; const float mL = m * L2E;
#pragma unroll
        for (int jj = 0; jj < 18; ++jj) { const f32x4 t = sc[jj] * L2E - mL;
#pragma unroll
            for (int r = 0; r < 4; ++r) { const float p = __builtin_amdgcn_exp2f(t[r]); sc[jj][r] = p; sum += p; } }
        sum += __shfl_xor(sum, 16); sum += __shfl_xor(sum, 32);
        sum += __builtin_amdgcn_exp2f((sink - m) * L2E);
        const float rden = 1.0f / sum;
        f32x4 o[4];
#pragma unroll
        for (int dt = 0; dt < 4; ++dt) o[dt] = (f32x4){0.f, 0.f, 0.f, 0.f};
#pragma unroll
        for (int kk = 0; kk < 9; ++kk) {
            v4u pw; pw.x = pg8::cvt_pk_bf16(sc[2 * kk][0], sc[2 * kk][1]); pw.y = pg8::cvt_pk_bf16(sc[2 * kk][2], sc[2 * kk][3]);
            pw.z = pg8::cvt_pk_bf16(sc[2 * kk + 1][0], sc[2 * kk + 1][1]); pw.w = pg8::cvt_pk_bf16(sc[2 * kk + 1][2], sc[2 * kk + 1][3]);
            const bf16x8 pf = __builtin_bit_cast(bf16x8, pw);
#pragma unroll
            for (int dt = 0; dt < 4; ++dt) {
                const LAS bf16* vp = vbase + (kt0 + 2 * kk) * 1280 + 16 * dt;
                const v2u va = lds_tr16(vp), vb = lds_tr16(vp + 1280);
                v4u vw; vw.x = va.x; vw.y = va.y; vw.z = vb.x; vw.w = vb.y;
                o[dt] = mfma16(__builtin_bit_cast(bf16x8, vw), pf, o[dt]);
            }
        }
        bf16* op = F.O + (size_t)qrow * D + 512 + hq * 64 + 4 * fq;
#pragma unroll
        for (int dt = 0; dt < 4; ++dt) { v2u w; w.x = pg8::cvt_pk_bf16(o[dt][0] * rden, o[dt][1] * rden); w.y = pg8::cvt_pk_bf16(o[dt][2] * rden, o[dt][3] * rden); *(v2u*)(op + 16 * dt) = w; }
    }
}

struct GlaGates { float b0[8], b1[8]; float all0, ref0, all1, ref1; };
struct GateLd { v4u glr; float wf[16], wb[16], bf_, bb_; };
__device__ __forceinline__ float log_sigmoid(float z) { return fminf(z, 0.f) - __logf(1.0f + __expf(-fabsf(z))); }
__device__ __forceinline__ void gate_load(const Frame& F, int b, int h, int c, GateLd& L) {
    const size_t row0 = (size_t)b * SEQ + (size_t)c * 64; const int d = F.lane;
    L.glr = (v4u){0u, 0u, 0u, 0u};
    if (F.tid < 256) L.glr = *(const v4u*)(F.PROJ + (row0 + (F.tid >> 2)) * DINP + C_GLR + (F.tid & 3) * 8);
#pragma unroll
    for (int r = 0; r < 16; ++r) { L.wf[r] = F.w_gk_fwd[r * 256 + h * 64 + d]; L.wb[r] = F.w_gk_bwd[r * 256 + h * 64 + d]; }
    L.bf_ = F.b_gk_fwd[h * 64 + d]; L.bb_ = F.b_gk_bwd[h * 64 + d];
}
__device__ __forceinline__ void gla_gates(Frame& F, const GateLd& L, LAS float* GLR, LAS float* TOT, GlaGates& G) {
    const int ig = F.wave, d = F.lane;
    if (F.tid < 256) { const v4u w = L.glr; LAS float* gp = GLR + (F.tid >> 2) * 32 + (F.tid & 3) * 8;
        gp[0] = bflo(w.x); gp[1] = bfhi(w.x); gp[2] = bflo(w.y); gp[3] = bfhi(w.y); gp[4] = bflo(w.z); gp[5] = bfhi(w.z); gp[6] = bflo(w.w); gp[7] = bfhi(w.w); }
    __syncthreads();
    float la0[8], la1[8];
#pragma unroll
    for (int kk = 0; kk < 8; ++kk) {
        const LAS float* gp = GLR + (8 * ig + kk) * 32;
        float z0 = L.bf_, z1 = L.bb_;
#pragma unroll
        for (int r = 0; r < 16; ++r) { z0 += gp[r] * L.wf[r]; z1 += gp[16 + r] * L.wb[r]; }
        la0[kk] = log_sigmoid(z0) * (1.0f / 16.0f); la1[kk] = log_sigmoid(z1) * (1.0f / 16.0f);
    }
#pragma unroll
    for (int kk = 1; kk < 8; ++kk) la0[kk] += la0[kk - 1];
#pragma unroll
    for (int kk = 6; kk >= 0; --kk) la1[kk] += la1[kk + 1];
    TOT[(0 * 8 + ig) * 64 + d] = la0[7]; TOT[(1 * 8 + ig) * 64 + d] = la1[0];
    __syncthreads();
    float off0 = 0.f, all0 = 0.f, ref0 = 0.f, off1 = 0.f, all1 = 0.f, ref1 = 0.f;
#pragma unroll
    for (int g = 0; g < 8; ++g) {
        const float t0 = TOT[(0 * 8 + g) * 64 + d], t1 = TOT[(1 * 8 + g) * 64 + d];
        all0 += t0; all1 += t1; off0 += (g < ig) ? t0 : 0.f; off1 += (g > ig) ? t1 : 0.f; ref0 += (g < 4) ? t0 : 0.f; ref1 += (g >= 4) ? t1 : 0.f;
    }
#pragma unroll
    for (int kk = 0; kk < 8; ++kk) { G.b0[kk] = la0[kk] + off0; G.b1[kk] = la1[kk] + off1; }
    G.all0 = all0; G.ref0 = ref0; G.all1 = all1; G.ref1 = ref1;
}
struct Gate2Ld { v4u a[4]; v4u bw; float bias; };
__device__ __forceinline__ void gate2_load(const Frame& F, int b, int h, int c, Gate2Ld& L) {
    const size_t row0 = (size_t)b * SEQ + (size_t)c * 64; const int fr = F.lane & 15, fq = F.lane >> 4, dir = F.wave >> 2, dt = F.wave & 3;
#pragma unroll
    for (int tt = 0; tt < 4; ++tt) { L.a[tt] = (v4u){0u, 0u, 0u, 0u}; if (fq < 2) L.a[tt] = *(const v4u*)(F.PROJ + (row0 + 16 * tt + fr) * DINP + C_GLR + dir * 16 + 8 * fq); }
    L.bw = (v4u){0u, 0u, 0u, 0u}; if (fq < 2) L.bw = *(const v4u*)(F.WG_T + ((size_t)dir * 256 + h * 64 + 16 * dt + fr) * 16 + 8 * fq);
    L.bias = (dir ? F.b_gk_bwd : F.b_gk_fwd)[h * 64 + 16 * dt + fr];
}
struct Gates2 { float b[4][4]; float all, ref; };
__device__ __forceinline__ void gates2(const Frame& F, const Gate2Ld& L, Gates2& G) {
    const int fr = F.lane & 15, fq = F.lane >> 4, dir = F.wave >> 2;
    float la[4][4];
#pragma unroll
    for (int tt = 0; tt < 4; ++tt) {
        f32x4 z = {0.f, 0.f, 0.f, 0.f};
        z = mfma16(__builtin_bit_cast(bf16x8, L.a[tt]), __builtin_bit_cast(bf16x8, L.bw), z);
#pragma unroll
        for (int r = 0; r < 4; ++r) la[tt][r] = log_sigmoid(z[r] + L.bias) * (1.0f / 16.0f);
    }
    float tot[4], excP[4], T4[4], p[4][4];
#pragma unroll
    for (int tt = 0; tt < 4; ++tt) {
        p[tt][0] = la[tt][0]; p[tt][1] = p[tt][0] + la[tt][1]; p[tt][2] = p[tt][1] + la[tt][2]; p[tt][3] = p[tt][2] + la[tt][3];
        T4[tt] = p[tt][3];
        float inc = T4[tt]; float v = __shfl(inc, (F.lane + 48) & 63); inc += (fq >= 1) ? v : 0.f; v = __shfl(inc, (F.lane + 32) & 63); inc += (fq >= 2) ? v : 0.f;
        excP[tt] = inc - T4[tt]; tot[tt] = __shfl(inc, 48 + fr);
    }
    const float all = (tot[0] + tot[1]) + (tot[2] + tot[3]);
    const float runF[4] = {0.f, tot[0], tot[0] + tot[1], tot[0] + tot[1] + tot[2]};
    const float runB[4] = {tot[1] + tot[2] + tot[3], tot[2] + tot[3], tot[3], 0.f};
    const bool fwd = (dir == 0);
#pragma unroll
    for (int tt = 0; tt < 4; ++tt) {
        const float baseF = runF[tt] + excP[tt];
        const float baseB = runB[tt] + (tot[tt] - excP[tt] - T4[tt]);
#pragma unroll
        for (int r = 0; r < 4; ++r) { const float bf = baseF + p[tt][r], bb = baseB + (T4[tt] - p[tt][r] + la[tt][r]); G.b[tt][r] = fwd ? bf : bb; }
    }
    G.all = all; G.ref = fwd ? (tot[0] + tot[1]) : (tot[2] + tot[3]);
}
__device__ __forceinline__ void vt_load(const Frame& F, size_t row0, int h, unsigned (&w)[8]) {
    const int v = F.tid & 127, jg = F.tid >> 7;
    const bf16* vp = F.PROJ + (row0 + 16 * jg) * DINP + C_GV + h * 128 + v;
#pragma unroll
    for (int e = 0; e < 8; ++e) { const unsigned lo = vp[(size_t)(2 * e) * DINP], hi = vp[(size_t)(2 * e + 1) * DINP]; w[e] = lo | (hi << 16); }
}
__device__ __forceinline__ void vt_store(const Frame& F, const unsigned (&w)[8], LAS bf16* VTp, int stride) {
    const int v = F.tid & 127, jg = F.tid >> 7;
    LAS v4u* dp = (LAS v4u*)(VTp + v * stride + 16 * jg);
    dp[0] = (v4u){w[0], w[1], w[2], w[3]}; dp[1] = (v4u){w[4], w[5], w[6], w[7]};
}
__device__ __forceinline__ size_t gla_idx(int dir, int b, int h, int c) { return (size_t)(((dir * 2 + b) * 4 + h) * NCH + c); }

struct GlaALd { Gate2Ld g; unsigned k[4][2]; unsigned vt[8]; };
__device__ __forceinline__ void gla_a_load(const Frame& F, int unit, GlaALd& L) {
    const int c = unit & 127, h = (unit >> 7) & 3, b = unit >> 9;
    const size_t row0 = (size_t)b * SEQ + (size_t)c * 64; const int fr = F.lane & 15, fq = F.lane >> 4, dt = F.wave & 3;
    gate2_load(F, b, h, c, L.g);
#pragma unroll
    for (int tt = 0; tt < 4; ++tt)
#pragma unroll
        for (int p = 0; p < 2; ++p) { const bf16* kp = F.PROJ + (row0 + 16 * tt + 4 * fq + 2 * p) * DINP + C_GK + h * 64 + 16 * dt + fr; L.k[tt][p] = (unsigned)kp[0] | ((unsigned)kp[DINP] << 16); }
    vt_load(F, row0, h, L.vt);
}
__device__ __forceinline__ void gla_a_compute(Frame& F, int unit, const GlaALd& L) {
    const int c = unit & 127, h = (unit >> 7) & 3, b = unit >> 9;
    LAS bf16* KT = (LAS bf16*)(F.lds + 12288);
    LAS bf16* VTp = (LAS bf16*)(F.lds + 12288 + 18432);
    const int fr = F.lane & 15, fq = F.lane >> 4, w = F.wave, dir = w >> 2, dt = w & 3;
    Gates2 G; gates2(F, L.g, G);
    __syncthreads();
#pragma unroll
    for (int tt = 0; tt < 4; ++tt) {
        v2u kw; kw.x = pk2(bflo(L.k[tt][0]) * __expf(G.all - G.b[tt][0]), bfhi(L.k[tt][0]) * __expf(G.all - G.b[tt][1]));
        kw.y = pk2(bflo(L.k[tt][1]) * __expf(G.all - G.b[tt][2]), bfhi(L.k[tt][1]) * __expf(G.all - G.b[tt][3]));
        *(LAS v2u*)(KT + (dir * 64 + 16 * dt + fr) * 72 + 16 * tt + 4 * fq) = kw;
    }
    if (fq == 0) F.DEC[gla_idx(dir, b, h, c) * 64 + 16 * dt + fr] = __expf(G.all);
    vt_store(F, L.vt, VTp, 72);
    __syncthreads();
    const LAS bf16* ap = KT + (16 * w + fr) * 72 + 8 * fq;
    const bf16x8 a0 = *(const LAS bf16x8*)(ap), a1 = *(const LAS bf16x8*)(ap + 32);
    float* up = F.UT + gla_idx(w >> 2, b, h, c) * 8192 + 16 * (w & 3) + 4 * fq;
#pragma unroll
    for (int vt = 0; vt < 8; ++vt) {
        const LAS bf16* bp = VTp + (16 * vt + fr) * 72 + 8 * fq;
        f32x4 acc = {0.f, 0.f, 0.f, 0.f};
        acc = mfma16(a0, *(const LAS bf16x8*)(bp), acc); acc = mfma16(a1, *(const LAS bf16x8*)(bp + 32), acc);
        *(f32x4*)(up + (size_t)(16 * vt + fr) * 64) = acc;
    }
}
__device__ __forceinline__ void gla_scan(Frame& F) {
    for (int gid = F.vcu * 512 + F.tid; gid < 16 * 8192; gid += F.G * 512) {
        const int stream = gid >> 13, e = gid & 8191, d = e & 63, dir = stream >> 3;
        float s = 0.f;
#pragma unroll 8
        for (int n = 0; n < NCH; ++n) {
            const int c = dir ? (NCH - 1 - n) : n; const size_t idx = (size_t)stream * NCH + c;
            const float u = F.UT[idx * 8192 + e], dc = F.DEC[idx * 64 + d];
            F.ST[idx * 8192 + e] = (bf16)f2bf(s);
            s = s * dc + u;
        }
    }
}
struct GlaCLd { Gate2Ld g; };
__device__ __forceinline__ void gla_c_load(const Frame& F, int unit, GlaCLd& L) {
    const int c = unit & 127, h = (unit >> 7) & 3, b = unit >> 9;
    gate2_load(F, b, h, c, L.g);
}
__device__ __forceinline__ void gla_c_compute(Frame& F, int unit, const GlaCLd& L) {
    const int c = unit & 127, h = (unit >> 7) & 3, b = unit >> 9;
    LAS bf16* QS = (LAS bf16*)(F.lds + 12288);
    LAS bf16* KS = (LAS bf16*)(F.lds + 30720);
    LAS bf16* AC = (LAS bf16*)(F.lds + 49152);
    LAS bf16* BC = (LAS bf16*)(F.lds + 74752);
    LAS float* SSQ = (LAS float*)(F.lds + 125952);
    const size_t row0 = (size_t)b * SEQ + (size_t)c * 64;
    const int fr = F.lane & 15, fq = F.lane >> 4, w = F.wave;
    unsigned vt[8]; v4u st[4]; v2u gg[4];
    vt_load(F, row0, h, vt);
#pragma unroll
    for (int rep = 0; rep < 4; ++rep) { const int q = F.tid + 512 * (rep & 1), dir = rep >> 1, v = q >> 3, d8 = q & 7; st[rep] = *(const v4u*)(F.ST + gla_idx(dir, b, h, c) * 8192 + v * 64 + d8 * 8); }
#pragma unroll
    for (int it = 0; it < 4; ++it) gg[it] = *(const v2u*)(F.PROJ + (row0 + 16 * it + fr) * DINP + C_GG + h * 128 + 16 * w + 4 * fq);
    unsigned qk[4][4];
#pragma unroll
    for (int tt = 0; tt < 4; ++tt)
#pragma unroll
        for (int r = 0; r < 4; ++r) { const bf16* rp = F.PROJ + (row0 + 16 * tt + 4 * fq + r) * DINP + h * 64 + 16 * (w & 3) + fr; qk[tt][r] = (unsigned)rp[C_GQ] | ((unsigned)rp[C_GK] << 16); }
    Gates2 G; gates2(F, L.g, G);
    __syncthreads();
    {
        const int dir = w >> 2, d = 16 * (w & 3) + fr; const float er = __expf(G.ref);
#pragma unroll
        for (int tt = 0; tt < 4; ++tt)
#pragma unroll
            for (int r = 0; r < 4; ++r) {
                const int i = 16 * tt + 4 * fq + r;
                const float q = bflo(qk[tt][r]), k = bfhi(qk[tt][r]);
                const float e = __expf(G.b[tt][r] - G.ref), qe = q * e;
                QS[(dir * 64 + i) * 72 + d] = (bf16)f2bf(qe); KS[(dir * 64 + i) * 72 + d] = (bf16)f2bf(k * __builtin_amdgcn_rcpf(e));
                AC[i * 200 + 64 + dir * 64 + d] = (bf16)f2bf(qe * er);
            }
    }
    vt_store(F, vt, BC, 200);
#pragma unroll
    for (int rep = 0; rep < 4; ++rep) { const int q = F.tid + 512 * (rep & 1), dir = rep >> 1, v = q >> 3, d8 = q & 7; *(LAS v4u*)(BC + v * 200 + 64 + dir * 64 + d8 * 8) = st[rep]; }
    __syncthreads();
    {
        const int it = w & 3, jp = w >> 2;
        bf16x8 qf[2][2];
#pragma unroll
        for (int dir = 0; dir < 2; ++dir)
#pragma unroll
            for (int ks = 0; ks < 2; ++ks) qf[dir][ks] = *(const LAS bf16x8*)(QS + (dir * 64 + 16 * it + fr) * 72 + 32 * ks + 8 * fq);
#pragma unroll
        for (int jj = 0; jj < 2; ++jj) {
            const int jt = 2 * jp + jj;
            f32x4 s0 = {0.f, 0.f, 0.f, 0.f}, s1 = {0.f, 0.f, 0.f, 0.f};
#pragma unroll
            for (int ks = 0; ks < 2; ++ks) {
                s0 = mfma16(*(const LAS bf16x8*)(KS + (0 * 64 + 16 * jt + fr) * 72 + 32 * ks + 8 * fq), qf[0][ks], s0);
                s1 = mfma16(*(const LAS bf16x8*)(KS + (1 * 64 + 16 * jt + fr) * 72 + 32 * ks + 8 * fq), qf[1][ks], s1);
            }
            const int i = 16 * it + fr; float sv[4];
#pragma unroll
            for (int r = 0; r < 4; ++r) { const int j = 16 * jt + 4 * fq + r; sv[r] = ((j <= i) ? s0[r] : 0.f) + ((j >= i) ? s1[r] : 0.f); }
            v2u pw; pw.x = pk2(sv[0], sv[1]); pw.y = pk2(sv[2], sv[3]);
            *(LAS v2u*)(AC + i * 200 + 16 * jt + 4 * fq) = pw;
        }
    }
    __syncthreads();
    f32x4 o[4];
#pragma unroll
    for (int it = 0; it < 4; ++it) o[it] = (f32x4){0.f, 0.f, 0.f, 0.f};
#pragma unroll
    for (int ks = 0; ks < 6; ++ks) {
        const bf16x8 bfr = *(const LAS bf16x8*)(BC + (16 * w + fr) * 200 + 32 * ks + 8 * fq);
#pragma unroll
        for (int it = 0; it < 4; ++it) o[it] = mfma16(bfr, *(const LAS bf16x8*)(AC + (16 * it + fr) * 200 + 32 * ks + 8 * fq), o[it]);
    }
#pragma unroll
    for (int it = 0; it < 4; ++it) { float s = (o[it][0] * o[it][0] + o[it][1] * o[it][1]) + (o[it][2] * o[it][2] + o[it][3] * o[it][3]);
        s += __shfl_xor(s, 16); s += __shfl_xor(s, 32); if (fq == 0) SSQ[w * 64 + 16 * it + fr] = s; }
    __syncthreads();
    const f32x4 gv = *(const f32x4*)(F.g_gla_out + 16 * w + 4 * fq);
#pragma unroll
    for (int it = 0; it < 4; ++it) {
        const int i = 16 * it + fr; float s = 0.f;
#pragma unroll
        for (int ww = 0; ww < 8; ++ww) s += SSQ[ww * 64 + i];
        const float rinv = 1.0f / sqrtf(s * (1.0f / 128.0f) + EPS);
        const v2u gw = gg[it];
        const float g0 = bflo(gw.x), g1 = bfhi(gw.x), g2 = bflo(gw.y), g3 = bfhi(gw.y);
        const float r0 = o[it][0] * rinv * gv[0] * (g0 / (1.0f + __expf(-g0))), r1 = o[it][1] * rinv * gv[1] * (g1 / (1.0f + __expf(-g1)));
        const float r2 = o[it][2] * rinv * gv[2] * (g2 / (1.0f + __expf(-g2))), r3 = o[it][3] * rinv * gv[3] * (g3 / (1.0f + __expf(-g3)));
        v2u ow; ow.x = pk2(r0, r1); ow.y = pk2(r2, r3);
        *(v2u*)(F.O + (row0 + i) * D + h * 128 + 16 * w + 4 * fq) = ow;
    }
}
__device__ __forceinline__ void p3_phase(Frame& F) {
    GlaALd LA; int u = F.vcu;
    {   AttnLd AL; int ua = F.vcu; bool ha = ua < 256;
        if (ha) attn_load(F, ua, AL);
        while (ha) { attn_compute(F, ua, AL); ua += F.G; ha = ua < 256; if (ha) attn_load(F, ua, AL); }
    }
    for (; u < 1024; u += F.G) { gla_a_load(F, u, LA); gla_a_compute(F, u, LA); }
}
__device__ __forceinline__ void p5_phase(Frame& F) {
    for (int u = F.vcu; u < 1024; u += F.G) { GlaCLd L; gla_c_load(F, u, L); gla_c_compute(F, u, L); }
}

__device__ __forceinline__ void p7_rows(Frame& F) {
    LAS bf16* WR = (LAS bf16*)(F.lds);
    LAS float* A1 = (LAS float*)(F.lds + 66048);
    LAS float* B2 = A1 + 1024;
    LAS float* C2 = B2 + 1024;
    LAS int* HIST = (LAS int*)(C2 + 1024);
    LAS int* BASE = HIST + 32;
    __syncthreads();
    for (int idx = F.tid; idx < 32 * 128; idx += 512) { const int e = idx >> 7, ch = idx & 127; *(LAS v4u*)(WR + e * 1032 + ch * 8) = *(const v4u*)(F.WR_T + e * 1024 + ch * 8); }
    const int fr = F.lane & 15, fq = F.lane >> 4;
    for (int rg = F.vcu; rg < T / 64; rg += F.G) {
        const int b = (rg * 64) / SEQ;
        __syncthreads();
        for (int i = F.tid; i < D; i += 512) { const float* md = F.MOD + b * 6144;
            A1[i] = md[2048 + i] * F.g_post_mix[i]; B2[i] = F.g_pre_ffn[i] * (1.0f + md[4096 + i]); C2[i] = md[3072 + i]; }
        if (F.tid < 32) HIST[F.tid] = 0;
        __syncthreads();
        for (int rr = 0; rr < 8; ++rr) {
            const int row = rg * 64 + F.wave * 8 + rr;
            const GAS v2u* yr = (const GAS v2u*)(F.Y + (size_t)row * D) + F.lane;
            const GAS f32x4* xr = (const GAS f32x4*)(F.x + (size_t)row * D) + F.lane;
            f32x4 y[4], xv[4]; float s = 0.f;
#pragma unroll
            for (int j = 0; j < 4; ++j) { const v2u yw = yr[64 * j]; y[j] = (f32x4){bflo(yw.x), bfhi(yw.x), bflo(yw.y), bfhi(yw.y)}; xv[j] = xr[64 * j]; s += (y[j].x * y[j].x + y[j].y * y[j].y) + (y[j].z * y[j].z + y[j].w * y[j].w); }
            const float rinv1 = 1.0f / sqrtf(wave_sum(s) * (1.0f / D) + EPS);
            float s2 = 0.f;
            GAS v2u* o1 = (GAS v2u*)(F.H + (size_t)row * D) + F.lane;
#pragma unroll
            for (int j = 0; j < 4; ++j) { const f32x4 a = *(const LAS f32x4*)(A1 + 4 * F.lane + 256 * j);
                xv[j] = xv[j] + a * (y[j] * rinv1); { v2u w; w.x = pk2(xv[j].x, xv[j].y); w.y = pk2(xv[j].z, xv[j].w); o1[64 * j] = w; }
                s2 += (xv[j].x * xv[j].x + xv[j].y * xv[j].y) + (xv[j].z * xv[j].z + xv[j].w * xv[j].w); }
            const float rinv2 = 1.0f / sqrtf(wave_sum(s2) * (1.0f / D) + EPS);
            GAS v2u* o8 = (GAS v2u*)(F.H2 + (size_t)row * D) + F.lane;
#pragma unroll
            for (int j = 0; j < 4; ++j) { const f32x4 a = *(const LAS f32x4*)(B2 + 4 * F.lane + 256 * j), c = *(const LAS f32x4*)(C2 + 4 * F.lane + 256 * j);
                const f32x4 h = (xv[j] * rinv2) * a + c; v2u w; w.x = pk2(h.x, h.y); w.y = pk2(h.z, h.w); o8[64 * j] = w;
                ((GAS unsigned*)(F.H2F8 + (size_t)row * D))[F.lane + 64 * j] = pk4_fp8(sat8(h.x), sat8(h.y), sat8(h.z), sat8(h.w)); }
        }
        VM_WAIT();
        __syncthreads();
        int myi = 0, myslot = 0; float myg = 0.f;
        if (F.wave < 4) {
            const int r0 = rg * 64 + F.wave * 16;
            f32x4 acc0 = {0.f, 0.f, 0.f, 0.f}, acc1 = {0.f, 0.f, 0.f, 0.f};
            const bf16* hp = F.H2 + (size_t)(r0 + fr) * D + 8 * fq;
#pragma unroll 8
            for (int ks = 0; ks < 32; ++ks) {
                const bf16x8 bfr = *(const bf16x8*)(hp + 32 * ks);
                acc0 = mfma16(*(const LAS bf16x8*)(WR + fr * 1032 + 32 * ks + 8 * fq), bfr, acc0);
                acc1 = mfma16(*(const LAS bf16x8*)(WR + (16 + fr) * 1032 + 32 * ks + 8 * fq), bfr, acc1);
            }
            float v[8];
#pragma unroll
            for (int r = 0; r < 4; ++r) { v[r] = acc0[r] + F.b_router[4 * fq + r]; v[4 + r] = acc1[r] + F.b_router[16 + 4 * fq + r]; }
            float tv[4]; int ti[4];
#pragma unroll
            for (int t = 0; t < 4; ++t) {
                float bv = -3.0e38f; int bi = 0;
#pragma unroll
                for (int q = 0; q < 8; ++q) { const int id = (q >> 2) * 16 + 4 * fq + (q & 3); if (v[q] > bv) { bv = v[q]; bi = id; } }
#pragma unroll
                for (int o = 16; o <= 32; o <<= 1) { const float pv = __shfl_xor(bv, o); const int pi = __shfl_xor(bi, o); if (pv > bv || (pv == bv && pi < bi)) { bv = pv; bi = pi; } }
                tv[t] = bv; ti[t] = bi;
#pragma unroll
                for (int q = 0; q < 8; ++q) { const int id = (q >> 2) * 16 + 4 * fq + (q & 3); if (id == bi) v[q] = -3.0e38f; }
            }
            const float e1 = __expf(tv[1] - tv[0]), e2 = __expf(tv[2] - tv[0]), e3 = __expf(tv[3] - tv[0]);
            const float rs = 1.0f / (1.0f + e1 + e2 + e3);
            myi = fq == 0 ? ti[0] : fq == 1 ? ti[1] : fq == 2 ? ti[2] : ti[3];
            myg = (fq == 0 ? 1.0f : fq == 1 ? e1 : fq == 2 ? e2 : e3) * rs;
            myslot = atomicAdd((int*)(HIST + myi), 1);
        }
        __syncthreads();
        if (F.tid < 32) BASE[F.tid] = (int)__hip_atomic_fetch_add((unsigned*)(F.ctl + CW_CNT + F.tid), (unsigned)HIST[F.tid], RLX_AGENT);
        __syncthreads();
        if (F.wave < 4) {
            const int asg = (rg * 64 + F.wave * 16 + fr) * 4 + fq;
            F.LIST[(size_t)myi * LCAP + BASE[myi] + myslot] = asg | (int)(f2bf(myg) << 16);
        }
    }
}

__device__ __forceinline__ void p10_final(Frame& F) {
    LAS float* A2 = (LAS float*)(F.lds);
    for (int rg = F.vcu; rg < T / 64; rg += F.G) {
        const int b = (rg * 64) / SEQ;
        __syncthreads();
        for (int i = F.tid; i < D; i += 512) A2[i] = F.MOD[b * 6144 + 5120 + i] * F.g_post_ffn[i];
        __syncthreads();
        unsigned yq[4][4]; v2u xq[4];
        auto ld = [&](int row, unsigned (&y)[4][4], v2u (&x)[4]) {
#pragma unroll
            for (int k = 0; k < 4; ++k) { const GAS unsigned* yp = (const GAS unsigned*)((const unsigned char*)F.Y2 + ((size_t)row * 4 + k) * D) + F.lane;
#pragma unroll
                for (int j = 0; j < 4; ++j) y[k][j] = yp[64 * j]; }
            const GAS v2u* x1p = (const GAS v2u*)(F.H + (size_t)row * D) + F.lane;
#pragma unroll
            for (int j = 0; j < 4; ++j) x[j] = x1p[64 * j];
        };
        ld(rg * 64 + F.wave * 8, yq, xq);
#pragma unroll 1
        for (int rr = 0; rr < 8; ++rr) {
            const int row = rg * 64 + F.wave * 8 + rr;
            unsigned yn[4][4]; v2u xn[4];
            if (rr < 7) ld(row + 1, yn, xn);
            f32x4 ys[4];
#pragma unroll
            for (int j = 0; j < 4; ++j) ys[j] = (f32x4){0.f, 0.f, 0.f, 0.f};
#pragma unroll
            for (int k = 0; k < 4; ++k)
#pragma unroll
                for (int j = 0; j < 4; ++j) { const int w = (int)yq[k][j];
                    ys[j].x += __builtin_amdgcn_cvt_f32_fp8(w, 0); ys[j].y += __builtin_amdgcn_cvt_f32_fp8(w, 1); ys[j].z += __builtin_amdgcn_cvt_f32_fp8(w, 2); ys[j].w += __builtin_amdgcn_cvt_f32_fp8(w, 3); }
            float s = 0.f;
#pragma unroll
            for (int j = 0; j < 4; ++j) s += (ys[j].x * ys[j].x + ys[j].y * ys[j].y) + (ys[j].z * ys[j].z + ys[j].w * ys[j].w);
            const float rinv = 1.0f / sqrtf(wave_sum(s) * (1.0f / D) * (YSC_INV * YSC_INV) + EPS) * YSC_INV;
            GAS f32x4* o1 = (GAS f32x4*)(F.out + (size_t)row * D) + F.lane;
#pragma unroll
            for (int j = 0; j < 4; ++j) { const f32x4 a = *(const LAS f32x4*)(A2 + 4 * F.lane + 256 * j); const v2u xw = xq[j];
                const f32x4 x1 = {bflo(xw.x), bfhi(xw.x), bflo(xw.y), bfhi(xw.y)}; o1[64 * j] = x1 + a * (ys[j] * rinv); }
            if (rr < 7) {
#pragma unroll
                for (int k = 0; k < 4; ++k)
#pragma unroll
                    for (int j = 0; j < 4; ++j) yq[k][j] = yn[k][j];
#pragma unroll
                for (int j = 0; j < 4; ++j) xq[j] = xn[j];
            }
        }
    }
}

struct Args { const float* in[22]; float* out; unsigned char* ws; int ph_lo, ph_hi, li, pad; };
__global__ void __launch_bounds__(NWAVES * 64, 2) fwd_megakernel(Args args) {
    extern __shared__ __attribute__((aligned(16))) unsigned char lds_raw[];
    Frame F;
    F.lds = (LAS unsigned char*)lds_raw;
    F.MISC = (volatile LAS unsigned*)(F.lds + MISC_OFF);
    F.tid = threadIdx.x; F.lane = F.tid & 63; F.wave = __builtin_amdgcn_readfirstlane(F.tid >> 6);
    F.G = gridDim.x; { const int bx = blockIdx.x; F.vcu = (F.G % 8 == 0) ? (bx % 8) * (F.G / 8) + bx / 8 : bx; }
    unsigned char* ws = args.ws;
    F.ctl = (GAS unsigned*)(ws + WS_CTL);
    F.x = args.in[0]; F.c = args.in[1]; F.w_ada = args.in[2]; F.b_ada = args.in[3]; F.g_pre_mix = args.in[4]; F.g_post_mix = args.in[5]; F.w_in = args.in[6];
    F.w_gk_fwd = args.in[7]; F.b_gk_fwd = args.in[8]; F.w_gk_bwd = args.in[9]; F.b_gk_bwd = args.in[10]; F.g_gla_out = args.in[11]; F.attn_sink = args.in[12];
    F.w_out = args.in[13]; F.g_pre_ffn = args.in[14]; F.g_post_ffn = args.in[15]; F.w_router = args.in[16]; F.b_router = args.in[17]; F.w_gate_up = args.in[18];
    F.b_gate_up = args.in[19]; F.w_down = args.in[20]; F.b_down = args.in[21]; F.out = args.out;
    F.MOD = (float*)(ws + WS_MOD); F.ROPE = (float*)(ws + WS_ROPE); F.GATE = (float*)(ws + WS_GATE); F.DEC = (float*)(ws + WS_DEC); F.UT = (float*)(ws + WS_UT); F.Y = (bf16*)(ws + WS_Y);
    F.WR_T = (bf16*)(ws + WS_WR_T); F.WG_T = (bf16*)(ws + WS_WG_T); F.WIN_T = (bf16*)(ws + WS_WIN_T); F.WOUT_T = (bf16*)(ws + WS_WOUT_T); F.WGU_T = ws + WS_WGU_T; F.WD_T = ws + WS_WD_T; F.H2F8 = ws + WS_H2F8;
    F.H = (bf16*)(ws + WS_H); F.PROJ = (bf16*)(ws + WS_PROJ); F.ST = (bf16*)(ws + WS_ST); F.O = (bf16*)(ws + WS_O); F.H2 = (bf16*)(ws + WS_H2); F.ACT = ws + WS_ACT; F.Y2 = (bf16*)(ws + WS_Y2);
    F.LIST = (int*)(ws + WS_LIST);
    for (int u = F.tid; u < (LDS_BYTES - LDSCTL_OFF) / 4; u += NWAVES * 64) ((LAS unsigned*)(F.lds + LDSCTL_OFF))[u] = 0u;
    __syncthreads();
    XcdBarrier bar; bar.bar = (unsigned*)(F.ctl + CW_BAR) + args.li * XCD_BAR_WORDS; bar.x = 0; bar.st = nullptr;
    if (MK_N_LAUNCHES == 1) bar = xcd_barrier_post((unsigned*)(F.ctl + CW_BAR), F.MISC + 8);
    const int lo = args.ph_lo, hi = args.ph_hi;
#define IN(k) (lo <= (k) && (k) < hi)
#if defined(PROBE_PA)
    GAS unsigned long long* stamps = (GAS unsigned long long*)(F.ctl + 2048);
#define SEAM(k) do { if (blockIdx.x == 0 && F.tid == 0) stamps[16 + (k)] = __builtin_amdgcn_s_memrealtime(); if (IN(k) && IN((k) + 1)) xcd_barrier(bar); \
                     if (blockIdx.x == 0 && F.tid == 0) stamps[(k) + 1] = __builtin_amdgcn_s_memrealtime(); } while (0)
    if (blockIdx.x == 0 && F.tid == 0) stamps[0] = __builtin_amdgcn_s_memrealtime();
#else
#define SEAM(k) do { if (IN(k) && IN((k) + 1)) xcd_barrier(bar); } while (0)
#endif

    if (IN(0)) { p0_prologue(F); } SEAM(0);
    const bool spread = (F.G == 256);
    const int xl = F.vcu >> 5, jl = F.vcu & 31;
    const bool conv2 = spread && (jl >= NG2 / 8);
    if (IN(1)) { p1_norm(F);
                 if (!spread) { p0_f8_convert<0>(F, 0, NA8, F.vcu * NWAVES + F.wave, F.G * NWAVES); p0_f8_convert<1>(F, 0, NB8, F.vcu * NWAVES + F.wave, F.G * NWAVES); } } SEAM(1);
    if (IN(2)) { if (conv2) p0_f8_convert<0>(F, 0, NA8, (xl * (32 - NG2 / 8) + (jl - NG2 / 8)) * NWAVES + F.wave, (256 - NG2) * NWAVES);
                 else { ProjPolicy P; P.A = F.H; P.Bt = F.WIN_T; P.KB = D * 2; P.so.init(T, DINP, spread ? NG2 : F.G, spread ? (jl * 8 + xl) : (int)blockIdx.x); P.O = F.PROJ; P.rope = F.ROPE;
                        pg8::gemm_phase<ProjPolicy>(F.lds, P); } } SEAM(2);
    if (IN(3)) { p3_phase(F); } SEAM(3);
    if (IN(4)) { gla_scan(F); } SEAM(4);
    if (IN(5)) { p5_phase(F); } SEAM(5);
    if (IN(6)) { OutPolicy P; P.A = F.O; P.Bt = F.WOUT_T; P.KB = D * 2; P.so.init(T, D, F.G, (int)blockIdx.x); P.C = F.Y;
                 pg8::gemm_phase<OutPolicy>(F.lds, P); } SEAM(6);
    if (IN(7)) { p7_rows(F); } SEAM(7);
    if (IN(8) || IN(9)) {
        volatile LAS int* tb = (volatile LAS int*)(F.MISC + 16);
        __syncthreads();
        if (F.tid == 0) { int acc = 0; for (int e = 0; e < NE; ++e) { tb[e] = acc; const int cn = (int)__hip_atomic_load((unsigned*)(F.ctl + CW_CNT + e), RLX_AGENT); acc += (cn + 255) >> 8; } tb[32] = acc; }
        __syncthreads();
        volatile LAS int* rtab = (volatile LAS int*)(F.MISC + 64);
        for (int rt = F.tid; rt < tb[32]; rt += 512) { int e = 0; for (int j = 1; j < 32; ++j) e = (rt >= tb[j]) ? j : e;
            const int s0 = (rt - tb[e]) * 256, rem = (int)__hip_atomic_load((unsigned*)(F.ctl + CW_CNT + e), RLX_AGENT) - s0; rtab[rt] = e | ((rem < 256 ? rem : 256) << 8) | (s0 << 17); }
        __syncthreads();
        if (IN(8)) { Moe1Policy P; P.tb = tb; P.rtab = rtab; P.llds = F.lds + LDSCTL_OFF + 4096; P.cnt = (const int*)(F.ctl + CW_CNT); P.list = F.LIST; P.G = F.G; P.c = (int)blockIdx.x; P.ncol = 8;
                     P.A = F.H2F8; P.Bt = F.WGU_T; P.KB = D; P.ACTp = F.ACT; P.bias = F.b_gate_up;
                     pg8::gemm_phase<Moe1Policy>(F.lds, P);
                     if (spread && ((int)blockIdx.x >> 3) >= 16) p0_f8_convert<1>(F, 0, NB8, ((((int)blockIdx.x >> 3) - 16) * 8 + ((int)blockIdx.x & 7)) * NWAVES + F.wave, 128 * NWAVES); }
        SEAM(8);
        if (IN(9)) { Moe2Policy P; P.tb = tb; P.rtab = rtab; P.llds = F.lds + LDSCTL_OFF + 4096; P.cnt = (const int*)(F.ctl + CW_CNT); P.list = F.LIST; P.G = F.G; P.c = (int)blockIdx.x; P.ncol = 4;
                     P.A = F.ACT; P.Bt = F.WD_T; P.KB = DFF; P.Y2p = (unsigned char*)F.Y2; P.bias = F.b_down;
                     pg8::gemm_phase<Moe2Policy>(F.lds, P); }
    }
    SEAM(9);
    if (IN(10)) { p10_final(F); }
#if defined(PROBE_PA)
    if (blockIdx.x == 0 && F.tid == 0) stamps[11] = __builtin_amdgcn_s_memrealtime();
    {
        if (blockIdx.x == 0 && F.tid == 0) {
            auto dur = [&](int k) -> float { const unsigned long long a = stamps[k], b = (k == 9) ? stamps[16 + 9] : stamps[k + 1]; return (float)(long long)(b - a) * 0.01f; };
            const float tA = dur(PROBE_PA), tB = dur(PROBE_PB);
            const float V = 1000.0f * rintf(tB * 0.2f) + 2.0f * tA;
            const unsigned long long t0 = __builtin_amdgcn_s_memrealtime(), want = (unsigned long long)(V * 100.0f);
            while (__builtin_amdgcn_s_memrealtime() - t0 < want) __builtin_amdgcn_s_sleep(8);
        }
    }
#endif
#undef IN
#undef SEAM
}

extern "C" void kernel_launch(void* const* d_in, const int* in_sizes, int n_in, void* d_out, int out_size, void* d_ws, size_t ws_size, hipStream_t stream) {
    static int grid = 0;
    if (grid == 0) {
        if (n_in != 22 || in_sizes[0] != T * D || out_size != T * D || ws_size < WS_END) { fprintf(stderr, "kernel_launch: unexpected shapes (n_in %d, in0 %d, out %d, ws %zu)\n", n_in, n_in > 0 ? in_sizes[0] : -1, out_size, ws_size); grid = -1; return; }
        int dev = 0, cus = 0, per_cu = 0;
        if (hipGetDevice(&dev) != hipSuccess || hipDeviceGetAttribute(&cus, hipDeviceAttributeMultiprocessorCount, dev) != hipSuccess) { grid = -1; return; }
        if (hipFuncSetAttribute((const void*)fwd_megakernel, hipFuncAttributeMaxDynamicSharedMemorySize, LDS_BYTES) != hipSuccess) { fprintf(stderr, "kernel_launch: hipFuncSetAttribute failed\n"); grid = -1; return; }
        if (hipOccupancyMaxActiveBlocksPerMultiprocessor(&per_cu, (const void*)fwd_megakernel, NWAVES * 64, LDS_BYTES) != hipSuccess || per_cu < 1)
            fprintf(stderr, "kernel_launch: note: occupancy query reports %d blocks per CU\n", per_cu);
        (void)hipGetLastError();
        grid = cus;
    }
    if (grid < 0) return;
    if (hipMemsetAsync((char*)d_ws + WS_CTL, 0, CTL_ZERO_BYTES, stream) != hipSuccess) { fprintf(stderr, "kernel_launch: memset failed\n"); return; }
    Args a{};
    for (int i = 0; i < 22; ++i) a.in[i] = (const float*)d_in[i];
    a.out = (float*)d_out; a.ws = (unsigned char*)d_ws;
    if (MK_N_LAUNCHES == 1) {
        a.ph_lo = 0; a.ph_hi = N_PHASES; a.li = 0;
        hipLaunchKernelGGL(fwd_megakernel, dim3(grid), dim3(NWAVES * 64), LDS_BYTES, stream, a);
    } else {
        for (int p = 0; p < N_PHASES; ++p) { a.ph_lo = p; a.ph_hi = p + 1; a.li = 0;
            hipLaunchKernelGGL(fwd_megakernel, dim3(grid), dim3(NWAVES * 64), LDS_BYTES, stream, a); }
    }
    const hipError_t le = hipPeekAtLastError();
    if (le != hipSuccess) fprintf(stderr, "kernel_launch: launch failed: %s\n", hipGetErrorName(le));
}
```

```cpp
#include <hip/hip_runtime.h>
#include <cstdio>
#include <cstdint>

#define GAS __attribute__((address_space(1)))
#define LAS __attribute__((address_space(3)))
typedef unsigned short bf16;
typedef unsigned v4u __attribute__((ext_vector_type(4)));
typedef unsigned v2u __attribute__((ext_vector_type(2)));
typedef float f32x4 __attribute__((ext_vector_type(4)));
typedef float f32x2 __attribute__((ext_vector_type(2)));
typedef short bf16x8 __attribute__((ext_vector_type(8)));
typedef short bf16x4 __attribute__((ext_vector_type(4)));
typedef int i32x4 __attribute__((ext_vector_type(4)));
typedef int i32x8 __attribute__((ext_vector_type(8)));

#ifndef MK_N_LAUNCHES
#define MK_N_LAUNCHES 1
#endif
constexpr int N_PHASES = 11;

constexpr int NB = 2, SEQ = 8192, T = NB * SEQ, D = 1024, DIN = 2336, DINP = 2560, NE = 32, DFF = 1024;
constexpr int C_GQ = 0, C_GK = 256, C_GV = 512, C_GG = 1024, C_GLR = 1536, C_AQ = 1568, C_AK = 2080, C_AV = 2208;
constexpr int NCH = 128;
constexpr float EPS = 1e-6f;
constexpr int LCAP = 16384;
constexpr int ACT_ROWS = 65536 + NE * 256;

constexpr size_t MiB = 1u << 20;
constexpr size_t WS_CTL = 0, CTL_ZERO_BYTES = 1 * MiB;
constexpr size_t WS_MOD = 1 * MiB;
constexpr size_t WS_ROPE = 1 * MiB + 512 * 1024;
constexpr size_t WS_WR_T = 2 * MiB;
constexpr size_t WS_WG_T = 2 * MiB + 128 * 1024;
constexpr size_t WS_LIST = 3 * MiB;
constexpr size_t WS_GATE = 5 * MiB;
constexpr size_t WS_DEC = 6 * MiB;
constexpr size_t WS_WIN_T = 8 * MiB;
constexpr size_t WS_WOUT_T = 14 * MiB;
constexpr size_t WS_WGU_T = 16 * MiB;
constexpr size_t WS_WD_T = 80 * MiB;
constexpr size_t WS_H2F8 = 112 * MiB;
constexpr size_t WS_H = 208 * MiB;
constexpr size_t WS_PROJ = 240 * MiB;
constexpr size_t WS_UT = 320 * MiB;
constexpr size_t WS_ST = 384 * MiB;
constexpr size_t WS_O = 416 * MiB;
constexpr size_t WS_Y = 448 * MiB;
constexpr size_t WS_H2 = 512 * MiB;
constexpr size_t WS_ACT = 544 * MiB;
constexpr size_t WS_Y2 = 688 * MiB;
constexpr size_t WS_END = 816 * MiB;
constexpr int CW_CNT = 64;
constexpr int CW_BAR = 4096;

constexpr int RING_BYTES = 131072;
constexpr int LDSCTL_OFF = RING_BYTES, MISC_OFF = LDSCTL_OFF + 320;
constexpr int LDS_BYTES = 147456;
constexpr int NWAVES = 8;

#define RLX_AGENT __ATOMIC_RELAXED, __HIP_MEMORY_SCOPE_AGENT
#define LDS_WAIT() asm volatile("s_waitcnt lgkmcnt(0)" ::: "memory")
#define VM_WAIT() asm volatile("s_waitcnt vmcnt(0)" ::: "memory")
__device__ __forceinline__ unsigned f2bf(float f) { unsigned u = __builtin_bit_cast(unsigned, f); return (u + 0x7fffu + ((u >> 16) & 1u)) >> 16; }
__device__ __forceinline__ unsigned pk2(float lo, float hi) { return f2bf(lo) | (f2bf(hi) << 16); }
__device__ __forceinline__ float bf2f(unsigned v) { return __builtin_bit_cast(float, v << 16); }
__device__ __forceinline__ float bflo(unsigned w) { return __builtin_bit_cast(float, w << 16); }
__device__ __forceinline__ float bfhi(unsigned w) { return __builtin_bit_cast(float, w & 0xffff0000u); }
constexpr float YSC = 16.0f, YSC_INV = 1.0f / 16.0f;
constexpr float WSC = 64.0f, WSC_INV = 1.0f / 64.0f, ASC = 4.0f;
__device__ __forceinline__ float sat8(float x) { return __builtin_amdgcn_fmed3f(x, -448.0f, 448.0f); }
__device__ __forceinline__ unsigned pk4_fp8(float a, float b, float c, float d) { int w = 0; w = __builtin_amdgcn_cvt_pk_fp8_f32(a, b, w, false); w = __builtin_amdgcn_cvt_pk_fp8_f32(c, d, w, true); return (unsigned)w; }
__device__ __forceinline__ float wave_sum(float v) {
#pragma unroll
    for (int o = 1; o < 64; o <<= 1) v += __shfl_xor(v, o);
    return v;
}

#define XB_TMO      128
#define XB_XCNT(j)  (256  + 64 * (j))
#define XB_XSUB(j)  (1280 + 64 * (j))
#define XB_XGEN(j)  (2304 + 64 * (j))
#define XB_TOP      3328
#define XB_TOPGEN   3392
#define XCD_BAR_WORDS 3456
#define XB_SPIN_CAP (1u << 18)
__device__ __forceinline__ unsigned xb_ld(unsigned* p)              { return __hip_atomic_load(p, __ATOMIC_RELAXED, __HIP_MEMORY_SCOPE_AGENT); }
__device__ __forceinline__ unsigned xb_add(unsigned* p, unsigned v) { return __hip_atomic_fetch_add(p, v, __ATOMIC_RELAXED, __HIP_MEMORY_SCOPE_AGENT); }
__device__ __forceinline__ unsigned xb_xcc_id() { return (unsigned)__builtin_amdgcn_s_getreg((3 << 11) | 20) & 0xFu; }
#define XB_SPIN(cond, bar) do { unsigned _sp = 0; while (cond) { __builtin_amdgcn_s_sleep(1); \
    if ((++_sp & 255u) == 0u) { if (xb_ld(&(bar)[XB_TMO])) break; if (_sp > XB_SPIN_CAP) { atomicAdd(&(bar)[XB_TMO], 1u); break; } } } } while (0)
struct XcdBarrier { unsigned* bar; unsigned x; volatile LAS unsigned* st; };
__device__ __forceinline__ XcdBarrier xcd_barrier_post(unsigned* bar, volatile LAS unsigned* st) {
    XcdBarrier b; b.bar = bar; b.x = xb_xcc_id(); b.st = st;
    if (threadIdx.x == 0) (void)xb_add(&bar[XB_XCNT(b.x)], 1u);
    return b;
}
__device__ __forceinline__ void xcd_barrier_complete(unsigned* bar, unsigned x, unsigned& nloc, unsigned& nx) {
    const unsigned G = gridDim.x * gridDim.y * gridDim.z;
    unsigned sum, cnt, mine, sp = 0u;
    for (;;) {
        sum = 0u; cnt = 0u; mine = 0u;
#pragma unroll
        for (unsigned j = 0; j < 16; ++j) { const unsigned c = xb_ld(&bar[XB_XCNT(j)]); sum += c; cnt += (c > 0u) ? 1u : 0u; mine = (j == x) ? c : mine; }
        if (sum == G) break;
        __builtin_amdgcn_s_sleep(1);
        if ((++sp & 255u) == 0u) { if (xb_ld(&bar[XB_TMO])) break; if (sp > XB_SPIN_CAP) { atomicAdd(&bar[XB_TMO], 1u); break; } }
    }
    nloc = mine > 0u ? mine : 1u; nx = cnt > 0u ? cnt : 1u;
}
__device__ __forceinline__ void xcd_barrier(const XcdBarrier& b) {
    asm volatile("s_waitcnt vmcnt(0)" ::: "memory");
    __syncthreads();
    if (threadIdx.x == 0) {
        unsigned* bar = b.bar;
        __builtin_amdgcn_s_waitcnt(0);
        unsigned nloc = b.st[0], nx = b.st[1];
        if (nloc == 0u) { xcd_barrier_complete(bar, b.x, nloc, nx); b.st[0] = nloc; b.st[1] = nx; }
        const unsigned old = xb_add(&bar[XB_XSUB(b.x)], 1u);
        const unsigned gen = old / nloc;
        if (old + 1u == (gen + 1u) * nloc) {
            __builtin_amdgcn_fence(__ATOMIC_RELEASE, "agent");
            asm volatile("s_waitcnt vmcnt(0)" ::: "memory");
            const unsigned og = xb_add(&bar[XB_TOP], 1u);
            const unsigned tg = og / nx;
            if (og + 1u == (tg + 1u) * nx) xb_add(&bar[XB_TOPGEN], 1u);
            else XB_SPIN(xb_ld(&bar[XB_TOPGEN]) == tg, bar);
            __builtin_amdgcn_fence(__ATOMIC_ACQUIRE, "agent");
            xb_add(&bar[XB_XGEN(b.x)], 1u);
            asm volatile("s_waitcnt vmcnt(0)" ::: "memory");
        } else {
            XB_SPIN(xb_ld(&bar[XB_XGEN(b.x)]) == gen, bar);
            __builtin_amdgcn_fence(__ATOMIC_ACQUIRE, "agent");
            asm volatile("s_waitcnt vmcnt(0)" ::: "memory");
        }
    }
    __syncthreads();
}

namespace pg8 {
constexpr int BM = 256, BK = 64, HALF = 128, HTB = HALF * BK * 2, NXCD = 8, WGM = 8;
__device__ __forceinline__ int lds_byte(int r, int c) { const int st = (r >> 4) * 2 + (c >> 5), rr = r & 15, cc = c & 31, ob = rr * 64 + cc * 2; return st * 1024 + (ob ^ (((ob >> 9) & 1) << 5)); }
__device__ __forceinline__ void stage_rc(int b, int& R, int& C) { const int st = b / 1024, sb = b % 1024, swz = sb ^ (((sb >> 9) & 1) << 5); R = (st >> 1) * 16 + swz / 64; C = (st & 1) * 32 + (swz % 64) / 2; }
__device__ __forceinline__ int perm32(int rho) { const int n = rho >> 4, i = rho & 15; return 8 * (i >> 2) + 4 * n + (i & 3); }
struct Unit { int pm, pn, e, nrows; };
__device__ __forceinline__ unsigned cvt_pk_bf16(float lo, float hi) { unsigned r; asm volatile("v_cvt_pk_bf16_f32 %0, %1, %2" : "=v"(r) : "v"(lo), "v"(hi)); return r; }

struct StaticOrder {
    int nM, nN, nwg, G, c;
    __device__ void init(int M, int N, int G_, int c_) { nM = M / BM; nN = N / BM; nwg = nM * nN; G = G_; c = c_; }
    __device__ bool next(int i, int& pm, int& pn) const {
        const long L = (long)i * G + c; if (L >= nwg) return false;
        int wgid = (int)L; { const int q = nwg / NXCD, r = nwg % NXCD, xcd = wgid % NXCD, off = wgid / NXCD; wgid = (xcd < r ? xcd * (q + 1) : r * (q + 1) + (xcd - r) * q) + off; }
        const int nig = WGM * nN, gid = wgid / nig, fm = gid * WGM, gsz = (nM - fm) < WGM ? (nM - fm) : WGM;
        pm = fm + ((wgid % nig) % gsz); pn = (wgid % nig) / gsz; return true;
    }
};

template <class P>
__device__ __forceinline__ void gemm_phase(LAS unsigned char* lds, const P& S) {
    const int tid = threadIdx.x, wid = __builtin_amdgcn_readfirstlane(tid >> 6), lane = tid & 63, wr = wid >> 2, wc = wid & 3, fr = lane & 15, fq = lane >> 4;
    const int KB = S.KB, nt = KB / 128;
    int RA[2], CA[2]; unsigned voffB[2];
#pragma unroll
    for (int i = 0; i < 2; ++i) { int R, C; stage_rc(tid * 16 + i * 8192, R, C); RA[i] = R; CA[i] = C * 2; const int Rb = P::PERM ? ((R & ~31) + perm32(R & 31)) : R; voffB[i] = (unsigned)(Rb * KB + C * 2); }
    const unsigned kstep = 128u;
    const unsigned hstepB = (unsigned)HALF * KB;
    const unsigned ldsw = (unsigned)wid * 1024u;
    const int aoff = lds_byte(wr * 64 + fr, fq * 8), boff = lds_byte(wc * 32 + fr, fq * 8);
    constexpr int HI = 1024;
    const __amdgpu_buffer_rsrc_t rsA = __builtin_amdgcn_make_buffer_rsrc((void*)S.A, 0, 0x7fffffff, 0x00020000);
    const __amdgpu_buffer_rsrc_t rsB = __builtin_amdgcn_make_buffer_rsrc((void*)S.Bt, 0, 0x7fffffff, 0x00020000);
#define PG8_SA(b, h) (((b) * 2 + (h)) * HTB)
#define PG8_SB(b, h) ((4 + (b) * 2 + (h)) * HTB)
#define PG8_STGB(bufoff, gbase) do { _Pragma("unroll") for (int _i = 0; _i < 2; ++_i) \
        __builtin_amdgcn_raw_ptr_buffer_load_lds(rsB, (LAS void*)(lds + (bufoff) + ldsw + _i * 8192), 16, voffB[_i], (int)(gbase), 0, 0); } while (0)
#define PG8_STGA(bufoff, kb, o0, o1) do { \
        __builtin_amdgcn_raw_ptr_buffer_load_lds(rsA, (LAS void*)(lds + (bufoff) + ldsw), 16, (o0), (int)(kb), 0, 0); \
        __builtin_amdgcn_raw_ptr_buffer_load_lds(rsA, (LAS void*)(lds + (bufoff) + ldsw + 8192), 16, (o1), (int)(kb), 0, 0); } while (0)
#define PG8_LDA(dst, b, h) do { _Pragma("unroll") for (int m = 0; m < 4; ++m) _Pragma("unroll") for (int k = 0; k < 2; ++k) dst[m][k] = *(const LAS bf16x8*)(lds + PG8_SA(b, h) + aoff + m * 2048 + k * HI); } while (0)
#define PG8_LDB(dst, b, h) do { _Pragma("unroll") for (int n = 0; n < 2; ++n) _Pragma("unroll") for (int k = 0; k < 2; ++k) dst[n][k] = *(const LAS bf16x8*)(lds + PG8_SB(b, h) + boff + n * 2048 + k * HI); } while (0)
#define PG8_CAT(x) __builtin_shufflevector(__builtin_bit_cast(i32x4, (x)[0]), __builtin_bit_cast(i32x4, (x)[1]), 0, 1, 2, 3, 4, 5, 6, 7)
#define PG8_MMA(ai, bj, At, Bt) do { __builtin_amdgcn_s_setprio(1); _Pragma("unroll") for (int m = 0; m < 4; ++m) _Pragma("unroll") for (int n = 0; n < 2; ++n) { \
        if constexpr (P::F8) { const i32x8 a8 = PG8_CAT(Bt[n]), b8 = PG8_CAT(At[m]); asm volatile("v_mfma_f32_16x16x128_f8f6f4 %0, %1, %2, %0" : "+v"(acc[ai][bj][m][n]) : "v"(a8), "v"(b8)); } \
        else { _Pragma("unroll") for (int k = 0; k < 2; ++k) acc[ai][bj][m][n] = __builtin_amdgcn_mfma_f32_16x16x32_bf16(Bt[n][k], At[m][k], acc[ai][bj][m][n], 0, 0, 0); } } \
        __builtin_amdgcn_s_setprio(0); } while (0)
#define PG8_WAIT_V(n) asm volatile("s_waitcnt vmcnt(" #n ")" ::: "memory")
#define PG8_WAIT_L(n) asm volatile("s_waitcnt lgkmcnt(" #n ")" ::: "memory")
#define PG8_BAR __builtin_amdgcn_s_barrier()
#define PG8_SCHED __builtin_amdgcn_sched_barrier(0)
    Unit cur, nxt; int ui = 0;
    if (!S.next(0, cur)) return;
    f32x4 acc[2][2][4][2];
#pragma unroll
    for (int a = 0; a < 2; ++a)
#pragma unroll
        for (int b = 0; b < 2; ++b)
#pragma unroll
            for (int m = 0; m < 4; ++m)
#pragma unroll
                for (int n = 0; n < 2; ++n) acc[a][b][m][n] = (f32x4){0.f, 0.f, 0.f, 0.f};
    bf16x8 At[4][2], B0[2][2], B1[2][2];
    unsigned c00, c01, c10, c11, n00, n01, n10, n11;
    typename P::Pre pre;
    S.aoff(cur, RA[0], RA[1], CA[0], CA[1], c00, c01, c10, c11);
    if constexpr (P::LIST_LDS) { if (wr == 0) S.list_dma(cur, 0, wid, lane); }
    unsigned cB = S.boffs(cur);
    PG8_STGB(PG8_SB(0, 0), cB); PG8_STGB(PG8_SB(0, 1), cB + hstepB); PG8_STGA(PG8_SA(0, 0), 0, c00, c01); PG8_STGA(PG8_SA(0, 1), 0, c10, c11);
    if (wr == 1) PG8_BAR;
    PG8_WAIT_V(2); PG8_BAR;
    PG8_STGB(PG8_SB(1, 0), cB + kstep); PG8_STGA(PG8_SA(1, 0), kstep, c00, c01); PG8_STGB(PG8_SB(1, 1), cB + hstepB + kstep);
    PG8_WAIT_V(6); PG8_BAR;
    for (;;) {
        const bool has_next = S.next(ui + 1, nxt);
        unsigned nB = cB;
        n00 = c00; n01 = c01; n10 = c10; n11 = c11;
        if (has_next) { if constexpr (!P::LIST_LDS) S.aoff(nxt, RA[0], RA[1], CA[0], CA[1], n00, n01, n10, n11); nB = S.boffs(nxt); }
        for (int t = 0; t < nt; t += 2) {
            const bool last = (t == nt - 2);
            if constexpr (P::LIST_LDS) { if (last && has_next) S.aoff_lds(nxt, (ui + 1) & 1, RA[0], RA[1], CA[0], CA[1], n00, n01, n10, n11); }

            const unsigned k1 = (unsigned)(t + 1) * kstep;
            const unsigned k2 = last ? 0u : (unsigned)(t + 2) * kstep, k3 = k2 + kstep;
            const unsigned b2 = last ? nB : cB + (unsigned)(t + 2) * kstep, b3 = b2 + kstep;
            const unsigned x00 = last ? n00 : c00, x01 = last ? n01 : c01, x10 = last ? n10 : c10, x11 = last ? n11 : c11;
            PG8_LDB(B0, 0, 0); PG8_LDB(B1, 0, 1); PG8_SCHED; PG8_LDA(At, 0, 0); PG8_STGA(PG8_SA(1, 1), k1, c10, c11);
            PG8_WAIT_V(8); PG8_WAIT_L(0); PG8_BAR;
            if constexpr (P::LIST_LDS) { if (t == 0 && wr == 0) { S.bias_dma(cur, wid, lane); if (has_next) S.list_dma(nxt, (ui + 1) & 1, wid, lane); } }
            PG8_MMA(0, 0, At, B0); PG8_MMA(0, 1, At, B1); PG8_BAR; PG8_SCHED;
            PG8_LDA(At, 0, 1); PG8_STGB(PG8_SB(0, 0), b2); PG8_STGB(PG8_SB(0, 1), b2 + hstepB); PG8_STGA(PG8_SA(0, 0), k2, x00, x01);
            PG8_WAIT_V(8); PG8_WAIT_L(0); PG8_BAR; PG8_MMA(1, 0, At, B0); PG8_MMA(1, 1, At, B1); PG8_BAR; PG8_SCHED;
            PG8_LDB(B0, 1, 0); PG8_LDB(B1, 1, 1); PG8_SCHED; PG8_LDA(At, 1, 0); PG8_STGA(PG8_SA(0, 1), k2, x10, x11);
            PG8_WAIT_V(8); PG8_WAIT_L(0); PG8_BAR; PG8_MMA(0, 0, At, B0); PG8_MMA(0, 1, At, B1); PG8_BAR; PG8_SCHED;
            PG8_LDA(At, 1, 1); PG8_STGB(PG8_SB(1, 0), b3); PG8_STGB(PG8_SB(1, 1), b3 + hstepB); PG8_STGA(PG8_SA(1, 0), k3, x00, x01);
            PG8_WAIT_V(8); PG8_WAIT_L(0); PG8_BAR; PG8_MMA(1, 0, At, B0); PG8_MMA(1, 1, At, B1); PG8_BAR; PG8_SCHED;
        }
        if (wr == 0) PG8_BAR;
        if constexpr (P::F8) asm volatile("s_nop 15\n\ts_nop 15" ::: "memory");
        if (!P::DUP || (ui & 1)) { S.pre_load(cur, pre, wc, fq); S.epi(acc, cur, pre, ui & 1, wr, wc, fr, fq); }
        if (!has_next) break;
        if (!P::DUP || (ui & 1)) {
#pragma unroll
        for (int a = 0; a < 2; ++a)
#pragma unroll
            for (int b = 0; b < 2; ++b)
#pragma unroll
                for (int m = 0; m < 4; ++m)
#pragma unroll
                    for (int n = 0; n < 2; ++n) acc[a][b][m][n] = (f32x4){0.f, 0.f, 0.f, 0.f};
        }
        cur = nxt; cB = nB; c00 = n00; c01 = n01; c10 = n10; c11 = n11; ++ui;
        if (wr == 1) PG8_BAR;
    }
    PG8_WAIT_V(0);
    PG8_BAR;
#undef PG8_SA
#undef PG8_SB
#undef PG8_STGA
#undef PG8_STGB
#undef PG8_LDA
#undef PG8_LDB
#undef PG8_MMA
#undef PG8_WAIT_V
#undef PG8_WAIT_L
#undef PG8_BAR
#undef PG8_SCHED
}
}

struct Frame {
    LAS unsigned char* lds;
    volatile LAS unsigned* MISC;
    GAS unsigned* ctl;
    int tid, lane, wave, vcu, G;
    const float *x, *c, *w_ada, *b_ada, *g_pre_mix, *g_post_mix, *w_in, *w_gk_fwd, *b_gk_fwd, *w_gk_bwd, *b_gk_bwd, *g_gla_out, *attn_sink, *w_out,
                *g_pre_ffn, *g_post_ffn, *w_router, *b_router, *w_gate_up, *b_gate_up, *w_down, *b_down;
    float* out;
    float *MOD, *ROPE, *GATE, *DEC, *UT; bf16* Y;
    bf16 *WR_T, *WIN_T, *WOUT_T, *H, *PROJ, *ST, *O, *H2, *Y2, *WG_T;
    unsigned char *WGU_T, *WD_T, *ACT, *H2F8;
    int* LIST;
};

struct ProjPolicy {
    static constexpr bool PERM = true;
    static constexpr bool F8 = false, DUP = false, LIST_LDS = false;
    struct Pre {};
    __device__ __forceinline__ void pre_load(const pg8::Unit&, Pre&, int, int) const {}
    const bf16* A; const bf16* Bt; int KB; pg8::StaticOrder so; bf16* O; const float* rope;
    __device__ __forceinline__ bool next(int i, pg8::Unit& u) const { u.e = 0; u.nrows = 256; return so.next(i, u.pm, u.pn); }
    __device__ __forceinline__ void aoff(const pg8::Unit& u, int R0, int R1, int C0, int C1, unsigned& o00, unsigned& o01, unsigned& o10, unsigned& o11) const {
        const unsigned b = (unsigned)u.pm * 256u;
        o00 = (b + R0) * KB + C0; o01 = (b + R1) * KB + C1; o10 = (b + 128 + R0) * KB + C0; o11 = (b + 128 + R1) * KB + C1;
    }
    __device__ __forceinline__ unsigned boffs(const pg8::Unit& u) const { return (unsigned)u.pn * 256u * KB; }
    __device__ __forceinline__ void epi(const f32x4 (&acc)[2][2][4][2], const pg8::Unit& u, const Pre&, int, int wr, int wc, int fr, int fq) const {
        const int row0 = u.pm * 256 + wr * 64 + fr;
#pragma unroll
        for (int bj = 0; bj < 2; ++bj) {
            const int cb = u.pn * 256 + bj * 128 + wc * 32;
            const float sc = (cb < C_GK || (cb >= C_AQ && cb < C_AK)) ? 0.125f : 1.f;
            const bool rot = (cb >= C_AQ) && (cb < C_AV) && (((cb - C_AQ) & 63) == 0);
            const float sg = (fq == 0) ? -1.f : 1.f;
#pragma unroll
            for (int ai = 0; ai < 2; ++ai)
#pragma unroll
                for (int m = 0; m < 4; ++m) {
                    const int row = row0 + ai * 128 + m * 16;
                    f32x4 v0 = acc[ai][bj][m][0], v1 = acc[ai][bj][m][1];
                    if (rot) {
                        const float* rp = rope + (size_t)(row & (SEQ - 1)) * 16;
                        const f32x4 c0 = *(const f32x4*)(rp), c1 = *(const f32x4*)(rp + 4), s0 = *(const f32x4*)(rp + 8), s1 = *(const f32x4*)(rp + 12);
                        f32x4 p0, p1;
#pragma unroll
                        for (int j = 0; j < 4; ++j) { p0[j] = __shfl_xor(v0[j], 16); p1[j] = __shfl_xor(v1[j], 16); }
                        if (fq < 2) { v0 = v0 * c0 + (p0 * s0) * sg; v1 = v1 * c1 + (p1 * s1) * sg; }
                    }
                    v0 = v0 * sc; v1 = v1 * sc;
                    v4u w; w.x = pg8::cvt_pk_bf16(v0[0], v0[1]); w.y = pg8::cvt_pk_bf16(v0[2], v0[3]); w.z = pg8::cvt_pk_bf16(v1[0], v1[1]); w.w = pg8::cvt_pk_bf16(v1[2], v1[3]);
                    *(v4u*)(O + (size_t)row * DINP + cb + 8 * fq) = w;
                }
        }
    }
};
struct OutPolicy {
    static constexpr bool PERM = true;
    static constexpr bool F8 = false, DUP = false, LIST_LDS = false;
    struct Pre {};
    __device__ __forceinline__ void pre_load(const pg8::Unit&, Pre&, int, int) const {}
    const bf16* A; const bf16* Bt; int KB; pg8::StaticOrder so; bf16* C;
    __device__ __forceinline__ bool next(int i, pg8::Unit& u) const { u.e = 0; u.nrows = 256; return so.next(i, u.pm, u.pn); }
    __device__ __forceinline__ void aoff(const pg8::Unit& u, int R0, int R1, int C0, int C1, unsigned& o00, unsigned& o01, unsigned& o10, unsigned& o11) const {
        const unsigned b = (unsigned)u.pm * 256u;
        o00 = (b + R0) * KB + C0; o01 = (b + R1) * KB + C1; o10 = (b + 128 + R0) * KB + C0; o11 = (b + 128 + R1) * KB + C1;
    }
    __device__ __forceinline__ unsigned boffs(const pg8::Unit& u) const { return (unsigned)u.pn * 256u * KB; }
    __device__ __forceinline__ void epi(const f32x4 (&acc)[2][2][4][2], const pg8::Unit& u, const Pre&, int, int wr, int wc, int fr, int fq) const {
        const int row0 = u.pm * 256 + wr * 64 + fr, col0 = u.pn * 256 + wc * 32 + 8 * fq;
#pragma unroll
        for (int ai = 0; ai < 2; ++ai)
#pragma unroll
            for (int m = 0; m < 4; ++m) { bf16* rowp = C + (size_t)(row0 + ai * 128 + m * 16) * D + col0;
#pragma unroll
                for (int bj = 0; bj < 2; ++bj) { const f32x4 v0 = acc[ai][bj][m][0], v1 = acc[ai][bj][m][1];
                    v4u w; w.x = pg8::cvt_pk_bf16(v0[0], v0[1]); w.y = pg8::cvt_pk_bf16(v0[2], v0[3]); w.z = pg8::cvt_pk_bf16(v1[0], v1[1]); w.w = pg8::cvt_pk_bf16(v1[2], v1[3]);
                    *(v4u*)(rowp + bj * 128) = w; } }
    }
};
struct MoePolicyBase {
    const volatile LAS int* tb; const volatile LAS int* rtab; const int* cnt; const int* list; int G, c, ncol;
    __device__ __forceinline__ bool next_rt(int i, pg8::Unit& u) const {
        const int NT = tb[32];
        int rt, pn;
        if ((G & 7) == 0) {
            const int x = c & 7, j = c >> 3, per = G >> 3, base = NT >> 3, rem = NT & 7, len = base + (x < rem ? 1 : 0), start = x * base + (x < rem ? x : rem);
            const int uidx = i * per + j, rl = uidx / ncol; if (rl >= len) return false;
            rt = start + rl; pn = uidx - rl * ncol;
        } else { const int L = i * G + c; if (L >= NT * ncol) return false; rt = L / ncol; pn = L - rt * ncol; }
        const int w = rtab[rt];
        u.pn = pn; u.pm = rt; u.e = w & 255; u.nrows = (w >> 8) & 511; return true;
    }
    __device__ __forceinline__ int slot0(const pg8::Unit& u) const { return (int)((unsigned)rtab[u.pm] >> 17); }
    LAS unsigned char* llds;
    __device__ __forceinline__ void list_dma(const pg8::Unit& u, int buf, int wid, int lane) const {
        const __amdgpu_buffer_rsrc_t rs = __builtin_amdgcn_make_buffer_rsrc((void*)list, 0, 0x7fffffff, 0x00020000);
        __builtin_amdgcn_raw_ptr_buffer_load_lds(rs, (LAS void*)(llds + buf * 1024 + wid * 256), 4, (unsigned)(wid * 256 + lane * 4), (int)(((unsigned)u.e * LCAP + (unsigned)slot0(u)) * 4u), 0, 0);
    }
    __device__ __forceinline__ void lds16x4(unsigned a0, unsigned a1, unsigned a2, unsigned a3, f32x4& v0, f32x4& v1, f32x4& v2, f32x4& v3) const {
        asm volatile("ds_read_b128 %0, %4\n\tds_read_b128 %1, %5\n\tds_read_b128 %2, %6\n\tds_read_b128 %3, %7\n\ts_waitcnt lgkmcnt(0)"
                     : "=&v"(v0), "=&v"(v1), "=&v"(v2), "=&v"(v3) : "v"(a0), "v"(a1), "v"(a2), "v"(a3) : "memory");
    }
    __device__ __forceinline__ void list_lds4(int buf, int r0, int r1, int r2, int r3, int& v0, int& v1, int& v2, int& v3) const {
        const unsigned base = (unsigned)(uintptr_t)(llds + buf * 1024);
        asm volatile("ds_read_b32 %0, %4\n\tds_read_b32 %1, %5\n\tds_read_b32 %2, %6\n\tds_read_b32 %3, %7\n\ts_waitcnt lgkmcnt(0)"
                     : "=&v"(v0), "=&v"(v1), "=&v"(v2), "=&v"(v3) : "v"(base + r0 * 4), "v"(base + r1 * 4), "v"(base + r2 * 4), "v"(base + r3 * 4) : "memory");
    }
};
struct Moe1Policy : MoePolicyBase {
#ifdef PROBE_DUP1
    static constexpr bool PERM = true, F8 = true, DUP = true, LIST_LDS = false;
    static constexpr float DSC = 0.5f;
#else
    static constexpr bool PERM = true, F8 = true, DUP = false, LIST_LDS = true;
    static constexpr float DSC = 1.0f;
#endif
    struct Pre { f32x4 g0, g1, u0, u1; };
    const unsigned char* A; const unsigned char* Bt; int KB; unsigned char* ACTp; const float* bias;
    __device__ __forceinline__ bool next(int i, pg8::Unit& u) const { return next_rt(DUP ? (i >> 1) : i, u); }
    __device__ __forceinline__ void bias_dma(const pg8::Unit& u, int wid, int lane) const {
        const __amdgpu_buffer_rsrc_t rs = __builtin_amdgcn_make_buffer_rsrc((void*)bias, 0, 0x7fffffff, 0x00020000);
        __builtin_amdgcn_raw_ptr_buffer_load_lds(rs, (LAS void*)(llds + 2048 + wid * 256), 4, (unsigned)((((wid & 1) * 64 + lane) + (wid >> 1) * 1024) * 4), (int)(((unsigned)u.e * 2048u + (unsigned)u.pn * 128u) * 4u), 0, 0);
    }
    __device__ __forceinline__ void pre_load(const pg8::Unit&, Pre& p, int wc, int fq) const {
        const unsigned a = (unsigned)(uintptr_t)(llds + 2048) + (unsigned)(wc * 32 + 8 * fq) * 4u;
        lds16x4(a, a + 16, a + 512, a + 528, p.g0, p.g1, p.u0, p.u1);
    }
    __device__ __forceinline__ void offs(const pg8::Unit& u, int R0, int R1, int C0, int C1, int v00, int v01, int v10, int v11, unsigned& o00, unsigned& o01, unsigned& o10, unsigned& o11) const {
        const int t00 = (R0 < u.nrows) ? ((v00 & 0xffff) >> 2) : 0, t01 = (R1 < u.nrows) ? ((v01 & 0xffff) >> 2) : 0;
        const int t10 = (R0 + 128 < u.nrows) ? ((v10 & 0xffff) >> 2) : 0, t11 = (R1 + 128 < u.nrows) ? ((v11 & 0xffff) >> 2) : 0;
        o00 = (unsigned)t00 * KB + C0; o01 = (unsigned)t01 * KB + C1; o10 = (unsigned)t10 * KB + C0; o11 = (unsigned)t11 * KB + C1;
    }
    __device__ __forceinline__ void aoff(const pg8::Unit& u, int R0, int R1, int C0, int C1, unsigned& o00, unsigned& o01, unsigned& o10, unsigned& o11) const {
        const int* lp = list + (size_t)u.e * LCAP + slot0(u);
        const int v00 = lp[R0], v01 = lp[R1], v10 = lp[R0 + 128], v11 = lp[R1 + 128];
        offs(u, R0, R1, C0, C1, v00, v01, v10, v11, o00, o01, o10, o11);
    }
    __device__ __forceinline__ void aoff_lds(const pg8::Unit& u, int buf, int R0, int R1, int C0, int C1, unsigned& o00, unsigned& o01, unsigned& o10, unsigned& o11) const {
        int v00, v01, v10, v11; list_lds4(buf, R0, R1, R0 + 128, R1 + 128, v00, v01, v10, v11);
        offs(u, R0, R1, C0, C1, v00, v01, v10, v11, o00, o01, o10, o11);
    }
    __device__ __forceinline__ unsigned boffs(const pg8::Unit& u) const { return ((unsigned)u.e * 2048u + (unsigned)u.pn * 256u) * KB; }
    __device__ __forceinline__ void epi(const f32x4 (&acc)[2][2][4][2], const pg8::Unit& u, const Pre& p, int, int wr, int wc, int fr, int fq) const {
        const int row0 = u.pm * 256 + wr * 64 + fr, col0 = u.pn * 128 + wc * 32 + 8 * fq;
        const f32x4 g0 = p.g0, g1 = p.g1, u0 = p.u0, u1 = p.u1;
#pragma unroll
        for (int ai = 0; ai < 2; ++ai)
#pragma unroll
            for (int m = 0; m < 4; ++m) {
                float a[8];
#pragma unroll
                for (int n = 0; n < 2; ++n)
#pragma unroll
                    for (int hh = 0; hh < 2; ++hh) {
                        const f32x2 ga = {acc[ai][0][m][n][2 * hh], acc[ai][0][m][n][2 * hh + 1]}, ua = {acc[ai][1][m][n][2 * hh], acc[ai][1][m][n][2 * hh + 1]};
                        const f32x2 gb = n ? (f32x2){g1[2 * hh], g1[2 * hh + 1]} : (f32x2){g0[2 * hh], g0[2 * hh + 1]};
                        const f32x2 ub = n ? (f32x2){u1[2 * hh], u1[2 * hh + 1]} : (f32x2){u0[2 * hh], u0[2 * hh + 1]};
                        f32x2 g = ga * (WSC_INV * DSC) + gb, u = ua * (WSC_INV * DSC * ASC) + (ub + 1.0f) * ASC;
                        g.x = fminf(g.x, 7.0f); g.y = fminf(g.y, 7.0f);
                        u.x = __builtin_amdgcn_fmed3f(u.x, -6.0f * ASC, 8.0f * ASC); u.y = __builtin_amdgcn_fmed3f(u.y, -6.0f * ASC, 8.0f * ASC);
                        const f32x2 t = g * (-1.702f * 1.44269504f);
                        f32x2 e; e.x = __builtin_amdgcn_exp2f(t.x); e.y = __builtin_amdgcn_exp2f(t.y);
                        e = e + 1.0f;
                        f32x2 sg; sg.x = __builtin_amdgcn_rcpf(e.x); sg.y = __builtin_amdgcn_rcpf(e.y);
                        const f32x2 r = (u * g) * sg;
                        a[n * 4 + 2 * hh] = r.x; a[n * 4 + 2 * hh + 1] = r.y;
                    }
                v2u w; w.x = pk4_fp8(a[0], a[1], a[2], a[3]); w.y = pk4_fp8(a[4], a[5], a[6], a[7]);
                *(v2u*)(ACTp + (size_t)(row0 + ai * 128 + m * 16) * DFF + col0) = w;
            }
    }
};
struct Moe2Policy : MoePolicyBase {
    static constexpr bool PERM = true, F8 = true, DUP = false, LIST_LDS = true;
    struct Pre { f32x4 bv[2][2]; };
    const unsigned char* A; const unsigned char* Bt; int KB; unsigned char* Y2p; const float* bias;
    __device__ __forceinline__ bool next(int i, pg8::Unit& u) const { return next_rt(i, u); }
    __device__ __forceinline__ void bias_dma(const pg8::Unit& u, int wid, int lane) const {
        const __amdgpu_buffer_rsrc_t rs = __builtin_amdgcn_make_buffer_rsrc((void*)bias, 0, 0x7fffffff, 0x00020000);
        __builtin_amdgcn_raw_ptr_buffer_load_lds(rs, (LAS void*)(llds + 2048 + wid * 256), 4, (unsigned)((wid * 64 + lane) * 4), (int)(((unsigned)u.e * 1024u + (unsigned)u.pn * 256u) * 4u), 0, 0);
    }
    __device__ __forceinline__ void pre_load(const pg8::Unit&, Pre& p, int wc, int fq) const {
        const unsigned a = (unsigned)(uintptr_t)(llds + 2048) + (unsigned)(wc * 32 + 8 * fq) * 4u;
        lds16x4(a, a + 16, a + 512, a + 528, p.bv[0][0], p.bv[0][1], p.bv[1][0], p.bv[1][1]);
    }
    __device__ __forceinline__ void aoff(const pg8::Unit& u, int R0, int R1, int C0, int C1, unsigned& o00, unsigned& o01, unsigned& o10, unsigned& o11) const {
        const unsigned b = (unsigned)u.pm * 256u;
        o00 = (b + R0) * KB + C0; o01 = (b + R1) * KB + C1; o10 = (b + 128 + R0) * KB + C0; o11 = (b + 128 + R1) * KB + C1;
    }
    __device__ __forceinline__ void aoff_lds(const pg8::Unit& u, int, int R0, int R1, int C0, int C1, unsigned& o00, unsigned& o01, unsigned& o10, unsigned& o11) const { aoff(u, R0, R1, C0, C1, o00, o01, o10, o11); }
    __device__ __forceinline__ unsigned boffs(const pg8::Unit& u) const { return ((unsigned)u.e * 1024u + (unsigned)u.pn * 256u) * KB; }
    __device__ __forceinline__ void epi(const f32x4 (&acc)[2][2][4][2], const pg8::Unit& u, const Pre& p, int buf, int wr, int wc, int fr, int fq) const {
        const int colb = u.pn * 256 + wc * 32 + 8 * fq;
        int ent[2][4];
#pragma unroll
        for (int ai = 0; ai < 2; ++ai) { const int r = ai * 128 + wr * 64 + fr; list_lds4(buf, r, r + 16, r + 32, r + 48, ent[ai][0], ent[ai][1], ent[ai][2], ent[ai][3]); }
#pragma unroll
        for (int ai = 0; ai < 2; ++ai)
#pragma unroll
            for (int m = 0; m < 4; ++m) {
                const int r = ai * 128 + wr * 64 + m * 16 + fr;
                if (r < u.nrows) {
                    const int asg = ent[ai][m] & 0xffff; const float g = bf2f((unsigned)ent[ai][m] >> 16);
                    unsigned char* rowp = Y2p + (size_t)asg * D + colb;
                    const float gs = g * YSC;
#pragma unroll
                    for (int bj = 0; bj < 2; ++bj) {
                        const f32x4 v0 = (acc[ai][bj][m][0] * (WSC_INV / ASC) + p.bv[bj][0]) * gs, v1 = (acc[ai][bj][m][1] * (WSC_INV / ASC) + p.bv[bj][1]) * gs;
                        v2u w; w.x = pk4_fp8(sat8(v0[0]), sat8(v0[1]), sat8(v0[2]), sat8(v0[3])); w.y = pk4_fp8(sat8(v1[0]), sat8(v1[1]), sat8(v1[2]), sat8(v1[3]));
                        *(v2u*)(rowp + bj * 128) = w;
                    }
                }
            }
    }
};

__device__ __forceinline__ void p0_cvt_bf16_item(const float* W, int K, int N, bf16* WT, int kb, int n0, int drow0, int lane) {
    const int n = lane & 31, q = lane >> 5; const float* src = W + (size_t)(64 * kb + 32 * q) * N + n0 + n;
    float v[32];
#pragma unroll
    for (int i = 0; i < 32; ++i) v[i] = src[(size_t)i * N];
    GAS v4u* dst = (GAS v4u*)(WT + (size_t)(drow0 + n) * K + 64 * kb + 32 * q);
#pragma unroll
    for (int j = 0; j < 4; ++j) { v4u o; o.x = pk2(v[8 * j], v[8 * j + 1]); o.y = pk2(v[8 * j + 2], v[8 * j + 3]); o.z = pk2(v[8 * j + 4], v[8 * j + 5]); o.w = pk2(v[8 * j + 6], v[8 * j + 7]); dst[j] = o; }
}
struct F8Desc { const float* src; unsigned char* dst; int N; };
__device__ __forceinline__ F8Desc p0_f8_desc(const Frame& F, int it, int lane) {
    constexpr int I_GU = 8 * 64, I_D = 8 * 32;
    const int e = it / (I_GU + I_D); int r = it - e * (I_GU + I_D);
    const int n4 = lane & 7, kg = lane >> 3;
    F8Desc d;
    if (r < I_GU) { const int nb = r & 63, kb = r >> 6, n0 = nb * 32;
        const int drow = (n0 < 1024) ? ((n0 >> 7) * 256 + (n0 & 127)) : ((((n0 - 1024) >> 7) * 256) + 128 + ((n0 - 1024) & 127));
        d.N = 2048; d.src = F.w_gate_up + (size_t)e * D * 2048 + (size_t)(128 * kb + 16 * kg) * 2048 + n0 + 4 * n4;
        d.dst = F.WGU_T + ((size_t)e * 2048 + drow + 4 * n4) * D + 128 * kb + 16 * kg; }
    else { r -= I_GU; const int nb = r & 31, kb = r >> 5, n0 = nb * 32;
        d.N = D; d.src = F.w_down + (size_t)e * DFF * D + (size_t)(128 * kb + 16 * kg) * D + n0 + 4 * n4;
        d.dst = F.WD_T + ((size_t)e * D + n0 + 4 * n4) * DFF + 128 * kb + 16 * kg; }
    return d;
}
__device__ __forceinline__ void p0_f8_load(f32x4 (&v)[16], const F8Desc& d) {
#pragma unroll
    for (int i = 0; i < 16; ++i) v[i] = __builtin_nontemporal_load((const f32x4*)(d.src + (size_t)i * d.N));
}
__device__ __forceinline__ void p0_f8_store(const f32x4 (&v)[16], const F8Desc& d) {
#pragma unroll
    for (int c = 0; c < 4; ++c) { v4u o;
        o.x = pk4_fp8(v[0][c] * WSC, v[1][c] * WSC, v[2][c] * WSC, v[3][c] * WSC); o.y = pk4_fp8(v[4][c] * WSC, v[5][c] * WSC, v[6][c] * WSC, v[7][c] * WSC);
        o.z = pk4_fp8(v[8][c] * WSC, v[9][c] * WSC, v[10][c] * WSC, v[11][c] * WSC); o.w = pk4_fp8(v[12][c] * WSC, v[13][c] * WSC, v[14][c] * WSC, v[15][c] * WSC);
        __builtin_nontemporal_store(o, (v4u*)(d.dst + (size_t)c * D)); }
}
__device__ __forceinline__ void p0_prologue(Frame& F) {
    const int gw = F.vcu * NWAVES + F.wave, NGW = F.G * NWAVES;
    {
        LAS float* cact = (LAS float*)(F.lds);
        LAS float* red = (LAS float*)(F.lds + 8192);
        for (int i = F.tid; i < 2048; i += 512) { const float v = F.c[i]; cact[i] = v / (1.0f + __expf(-v)); }
        __syncthreads();
        for (int it = F.vcu; it < 256; it += F.G) {
            const int col = F.lane % 24, kp = F.lane / 24, j = it * 24 + col, k0 = F.wave * 128;
            float a0 = 0.f, a1 = 0.f;
            if (kp < 2) {
#pragma unroll 16
                for (int k = 0; k < 64; ++k) { const int kk = k0 + 2 * k + kp; const float w = F.w_ada[(size_t)kk * 6144 + j]; a0 += cact[kk] * w; a1 += cact[1024 + kk] * w; }
            }
            a0 += __shfl(a0, (F.lane + 24) & 63); a1 += __shfl(a1, (F.lane + 24) & 63);
            if (F.lane < 24) { red[(F.wave * 2 + 0) * 24 + col] = a0; red[(F.wave * 2 + 1) * 24 + col] = a1; }
            __syncthreads();
            if (F.tid < 48) { const int b = F.tid / 24, cc = F.tid % 24; float s = F.b_ada[it * 24 + cc];
#pragma unroll
                for (int w = 0; w < 8; ++w) s += red[(w * 2 + b) * 24 + cc];
                F.MOD[b * 6144 + it * 24 + cc] = s; }
            __syncthreads();
        }
    }
    for (int idx = (F.vcu * 512 + F.tid); idx < SEQ * 8; idx += F.G * 512) {
        const int t = idx >> 3, i = idx & 7;
        const float inv = powf(500000.0f, -(float)i / 8.0f);
        const float ang = (float)t * inv;
        const double rev = (double)ang * 0.15915494309189535;
        const float fr = (float)(rev - rint(rev));
        F.ROPE[t * 16 + i] = __builtin_amdgcn_cosf(fr); F.ROPE[t * 16 + 8 + i] = __builtin_amdgcn_sinf(fr);
    }
    for (int idx = F.vcu * 512 + F.tid; idx < 2 * 256 * 16; idx += F.G * 512) { const int dir = idx >> 12, n = (idx >> 4) & 255, r = idx & 15;
        F.WG_T[idx] = (bf16)f2bf((dir ? F.w_gk_bwd : F.w_gk_fwd)[r * 256 + n]); }
    { v4u z = {0u, 0u, 0u, 0u}; GAS v4u* p = (GAS v4u*)(F.WIN_T + (size_t)DIN * D); const int n = (DINP - DIN) * D * 2 / 16;
      for (int i = F.vcu * 512 + F.tid; i < n; i += F.G * 512) p[i] = z; }
    constexpr int I_IN = 16 * (DIN / 32), I_OUT = 16 * 32, I_R = 16;
    for (int it = gw; it < I_IN + I_OUT + I_R; it += NGW) {
        int r = it;
        if (r < I_IN) { const int nb = r % (DIN / 32), kb = r / (DIN / 32); p0_cvt_bf16_item(F.w_in, D, DIN, F.WIN_T, kb, nb * 32, nb * 32, F.lane); continue; } r -= I_IN;
        if (r < I_OUT) { const int nb = r % 32, kb = r / 32; p0_cvt_bf16_item(F.w_out, D, D, F.WOUT_T, kb, nb * 32, nb * 32, F.lane); continue; } r -= I_OUT;
        p0_cvt_bf16_item(F.w_router, D, NE, F.WR_T, r, 0, 0, F.lane);
    }
}
constexpr int N8_ITEMS = NE * (8 * 64 + 8 * 32), K8 = 10, NB8 = K8 * 256, NA8 = N8_ITEMS - NB8;
#ifndef NG2
#define NG2 128
#endif
template <int LIST> __device__ __forceinline__ int f8_item(int v) {
    if (LIST == 0) { if (v < (NE - K8) * 768) return v; const int w = v - (NE - K8) * 768; return (NE - K8 + (w >> 9)) * 768 + (w & 511); }
    return (NE - K8 + (v >> 8)) * 768 + 512 + (v & 255);
}
template <int LIST> __device__ __forceinline__ void p0_f8_convert(Frame& F, int lo, int hi, int wv, int nw) {
    f32x4 va[16], vb[16];
    int it = lo + wv;
    if (it < hi) p0_f8_load(va, p0_f8_desc(F, f8_item<LIST>(it), F.lane));
    for (; it < hi; it += 2 * nw) {
        const bool hb = it + nw < hi, ha = it + 2 * nw < hi;
        if (hb) p0_f8_load(vb, p0_f8_desc(F, f8_item<LIST>(it + nw), F.lane));
        p0_f8_store(va, p0_f8_desc(F, f8_item<LIST>(it), F.lane));
        if (ha) p0_f8_load(va, p0_f8_desc(F, f8_item<LIST>(it + 2 * nw), F.lane));
        if (hb) p0_f8_store(vb, p0_f8_desc(F, f8_item<LIST>(it + nw), F.lane));
    }
}

__device__ __forceinline__ void p1_norm(Frame& F) {
    LAS float* sc = (LAS float*)(F.lds);
    LAS float* sh = (LAS float*)(F.lds + 4096);
    for (int rg = F.vcu; rg < T / 64; rg += F.G) {
        const int b = (rg * 64) / SEQ;
        __syncthreads();
        for (int i = F.tid; i < D; i += 512) { sc[i] = F.g_pre_mix[i] * (1.0f + F.MOD[b * 6144 + 1024 + i]); sh[i] = F.MOD[b * 6144 + i]; }
        __syncthreads();
        for (int rr = 0; rr < 8; ++rr) {
            const int row = rg * 64 + F.wave * 8 + rr;
            const GAS f32x4* xr = (const GAS f32x4*)(F.x + (size_t)row * D) + F.lane;
            f32x4 v[4]; float s = 0.f;
#pragma unroll
            for (int j = 0; j < 4; ++j) { v[j] = xr[64 * j]; s += (v[j].x * v[j].x + v[j].y * v[j].y) + (v[j].z * v[j].z + v[j].w * v[j].w); }
            const float rinv = 1.0f / sqrtf(wave_sum(s) * (1.0f / D) + EPS);
            GAS v2u* o8 = (GAS v2u*)(F.H + (size_t)row * D) + F.lane;
#pragma unroll
            for (int j = 0; j < 4; ++j) { const f32x4 a = *(const LAS f32x4*)(sc + 4 * F.lane + 256 * j), c = *(const LAS f32x4*)(sh + 4 * F.lane + 256 * j);
                const f32x4 h = (v[j] * rinv) * a + c; v2u w; w.x = pk2(h.x, h.y); w.y = pk2(h.z, h.w); o8[64 * j] = w; }
        }
    }
}

__device__ __forceinline__ f32x4 mfma16(bf16x8 a, bf16x8 b, f32x4 c) { return __builtin_amdgcn_mfma_f32_16x16x32_bf16(a, b, c, 0, 0, 0); }
typedef short s16x4 __attribute__((ext_vector_type(4)));
__device__ __forceinline__ v2u lds_tr16(const LAS bf16* p) { return __builtin_bit_cast(v2u, __builtin_amdgcn_ds_read_tr16_b64_v4i16((LAS s16x4*)p)); }
struct AttnLd { v4u kv[6], vv[6]; };
__device__ __forceinline__ void attn_load(const Frame& F, int unit, AttnLd& L) {
    const int qb = unit & 63, g = (unit >> 6) & 1, b = unit >> 7, kbase = qb * 128 - 128;
#pragma unroll
    for (int i = 0; i < 6; ++i) { const int idx = F.tid + 512 * i, r = idx >> 3, ch = idx & 7, kp = kbase + r;
        L.kv[i] = (v4u){0u, 0u, 0u, 0u}; L.vv[i] = (v4u){0u, 0u, 0u, 0u};
        if (kp >= 0 && kp < SEQ) { const bf16* rowp = F.PROJ + (size_t)(b * SEQ + kp) * DINP; L.kv[i] = *(const v4u*)(rowp + C_AK + g * 64 + ch * 8); L.vv[i] = *(const v4u*)(rowp + C_AV + g * 64 + ch * 8); } }
}
__device__ __forceinline__ void attn_compute(Frame& F, int unit, const AttnLd& L) {
    const int qb = unit & 63, g = (unit >> 6) & 1, b = unit >> 7;
    LAS bf16* KL = (LAS bf16*)F.lds;
    LAS bf16* VR = (LAS bf16*)(F.lds + 384 * 80 * 2);
    const int kbase = qb * 128 - 128;
    __syncthreads();
#pragma unroll
    for (int i = 0; i < 6; ++i) { const int idx = F.tid + 512 * i, r = idx >> 3, ch = idx & 7;
        *(LAS v4u*)(KL + r * 80 + ch * 8) = L.kv[i]; *(LAS v4u*)(VR + r * 80 + ch * 8) = L.vv[i]; }
    __syncthreads();
    const int fr = F.lane & 15, fq = F.lane >> 4;
    const int hq = 4 * g + (F.wave >> 1);
    const float sink = F.attn_sink[hq];
    constexpr float L2E = 1.44269504f;
    const bf16* qbase = F.PROJ + (size_t)(b * SEQ + qb * 128 + 64 * (F.wave & 1) + fr) * DINP + C_AQ + hq * 64 + 8 * fq;
    bf16x8 qn0 = *(const bf16x8*)(qbase), qn1 = *(const bf16x8*)(qbase + 32);
    const LAS bf16* vbase = VR + (4 * fq + (fr >> 2)) * 80 + 4 * (fr & 3);
#pragma unroll 1
    for (int rt = 0; rt < 4; ++rt) {
        const int tq0 = 64 * (F.wave & 1) + 16 * rt;
        const int qrow = b * SEQ + qb * 128 + tq0 + fr;
        const bf16x8 qf0 = qn0, qf1 = qn1;
        if (rt < 3) { const bf16* qp = qbase + (size_t)(16 * (rt + 1)) * DINP; qn0 = *(const bf16x8*)(qp); qn1 = *(const bf16x8*)(qp + 32); }
        int kt0 = tq0 >> 4; kt0 = kt0 > 6 ? 6 : kt0;
        f32x4 sc[18];
#pragma unroll
        for (int jj = 0; jj < 18; ++jj) {
            const LAS bf16* kp = KL + ((kt0 + jj) * 16 + fr) * 80 + 8 * fq;
            const bf16x8 k0 = *(const LAS bf16x8*)(kp), k1 = *(const LAS bf16x8*)(kp + 32);
            f32x4 a = {0.f, 0.f, 0.f, 0.f};
            a = mfma16(k0, qf0, a); a = mfma16(k1, qf1, a);
            sc[jj] = a;
        }
        const int tq = tq0 + fr;
        float m = sink;
#pragma unroll
        for (int jj = 0; jj < 18; ++jj) {
            const int k0t = (kt0 + jj) * 16;
            const bool full = (k0t >= tq0 + 15) && (k0t + 15 <= tq0 + 256) && (kbase + k0t >= 0) && (kbase + k0t + 15 < SEQ);
            if (full) {
#pragma unroll
                for (int r = 0; r < 4; ++r) m = fmaxf(m, sc[jj][r]);
            } else {
#pragma unroll
                for (int r = 0; r < 4; ++r) {
                    const int ki = k0t + 4 * fq + r, kp = kbase + ki;
                    const bool valid = (ki >= tq) && (ki <= tq + 256) && (kp >= 0) && (kp < SEQ);
                    sc[jj][r] = valid ? sc[jj][r] : -1e30f;
                    m = fmaxf(m, sc[jj][r]);
                }
            }
        }
        m = fmaxf(m, __shfl_xor(m, 16)); m = fmaxf(m, __shfl_xor(m, 32));
        float sum = 0.f; const float mL = m * L2E;
#pragma unroll
        for (int jj = 0; jj < 18; ++jj) { const f32x4 t = sc[jj] * L2E - mL;
#pragma unroll
            for (int r = 0; r < 4; ++r) { const float p = __builtin_amdgcn_exp2f(t[r]); sc[jj][r] = p; sum += p; } }
        sum += __shfl_xor(sum, 16); sum += __shfl_xor(sum, 32);
        sum += __builtin_amdgcn_exp2f((sink - m) * L2E);
        const float rden = 1.0f / sum;
        f32x4 o[4];
#pragma unroll
        for (int dt = 0; dt < 4; ++dt) o[dt] = (f32x4){0.f, 0.f, 0.f, 0.f};
#pragma unroll
        for (int kk = 0; kk < 9; ++kk) {
            v4u pw; pw.x = pg8::cvt_pk_bf16(sc[2 * kk][0], sc[2 * kk][1]); pw.y = pg8::cvt_pk_bf16(sc[2 * kk][2], sc[2 * kk][3]);
            pw.z = pg8::cvt_pk_bf16(sc[2 * kk + 1][0], sc[2 * kk + 1][1]); pw.w = pg8::cvt_pk_bf16(sc[2 * kk + 1][2], sc[2 * kk + 1][3]);
            const bf16x8 pf = __builtin_bit_cast(bf16x8, pw);
#pragma unroll
            for (int dt = 0; dt < 4; ++dt) {
                const LAS bf16* vp = vbase + (kt0 + 2 * kk) * 1280 + 16 * dt;
                const v2u va = lds_tr16(vp), vb = lds_tr16(vp + 1280);
                v4u vw; vw.x = va.x; vw.y = va.y; vw.z = vb.x; vw.w = vb.y;
                o[dt] = mfma16(__builtin_bit_cast(bf16x8, vw), pf, o[dt]);
            }
        }
        bf16* op = F.O + (size_t)qrow * D + 512 + hq * 64 + 4 * fq;
#pragma unroll
        for (int dt = 0; dt < 4; ++dt) { v2u w; w.x = pg8::cvt_pk_bf16(o[dt][0] * rden, o[dt][1] * rden); w.y = pg8::cvt_pk_bf16(o[dt][2] * rden, o[dt][3] * rden); *(v2u*)(op + 16 * dt) = w; }
    }
}

struct GlaGates { float b0[8], b1[8]; float all0, ref0, all1, ref1; };
struct GateLd { v4u glr; float wf[16], wb[16], bf_, bb_; };
__device__ __forceinline__ float log_sigmoid(float z) { return fminf(z, 0.f) - 0.69314718f * __builtin_amdgcn_logf(1.0f + __builtin_amdgcn_exp2f(fabsf(z) * -1.44269504f)); }
__device__ __forceinline__ void gate_load(const Frame& F, int b, int h, int c, GateLd& L) {
    const size_t row0 = (size_t)b * SEQ + (size_t)c * 64; const int d = F.lane;
    L.glr = (v4u){0u, 0u, 0u, 0u};
    if (F.tid < 256) L.glr = *(const v4u*)(F.PROJ + (row0 + (F.tid >> 2)) * DINP + C_GLR + (F.tid & 3) * 8);
#pragma unroll
    for (int r = 0; r < 16; ++r) { L.wf[r] = F.w_gk_fwd[r * 256 + h * 64 + d]; L.wb[r] = F.w_gk_bwd[r * 256 + h * 64 + d]; }
    L.bf_ = F.b_gk_fwd[h * 64 + d]; L.bb_ = F.b_gk_bwd[h * 64 + d];
}
__device__ __forceinline__ void gla_gates(Frame& F, const GateLd& L, LAS float* GLR, LAS float* TOT, GlaGates& G) {
    const int ig = F.wave, d = F.lane;
    if (F.tid < 256) { const v4u w = L.glr; LAS float* gp = GLR + (F.tid >> 2) * 32 + (F.tid & 3) * 8;
        gp[0] = bflo(w.x); gp[1] = bfhi(w.x); gp[2] = bflo(w.y); gp[3] = bfhi(w.y); gp[4] = bflo(w.z); gp[5] = bfhi(w.z); gp[6] = bflo(w.w); gp[7] = bfhi(w.w); }
    __syncthreads();
    float la0[8], la1[8];
#pragma unroll
    for (int kk = 0; kk < 8; ++kk) {
        const LAS float* gp = GLR + (8 * ig + kk) * 32;
        float z0 = L.bf_, z1 = L.bb_;
#pragma unroll
        for (int r = 0; r < 16; ++r) { z0 += gp[r] * L.wf[r]; z1 += gp[16 + r] * L.wb[r]; }
        la0[kk] = log_sigmoid(z0) * (1.0f / 16.0f); la1[kk] = log_sigmoid(z1) * (1.0f / 16.0f);
    }
#pragma unroll
    for (int kk = 1; kk < 8; ++kk) la0[kk] += la0[kk - 1];
#pragma unroll
    for (int kk = 6; kk >= 0; --kk) la1[kk] += la1[kk + 1];
    TOT[(0 * 8 + ig) * 64 + d] = la0[7]; TOT[(1 * 8 + ig) * 64 + d] = la1[0];
    __syncthreads();
    float off0 = 0.f, all0 = 0.f, ref0 = 0.f, off1 = 0.f, all1 = 0.f, ref1 = 0.f;
#pragma unroll
    for (int g = 0; g < 8; ++g) {
        const float t0 = TOT[(0 * 8 + g) * 64 + d], t1 = TOT[(1 * 8 + g) * 64 + d];
        all0 += t0; all1 += t1; off0 += (g < ig) ? t0 : 0.f; off1 += (g > ig) ? t1 : 0.f; ref0 += (g < 4) ? t0 : 0.f; ref1 += (g >= 4) ? t1 : 0.f;
    }
#pragma unroll
    for (int kk = 0; kk < 8; ++kk) { G.b0[kk] = la0[kk] + off0; G.b1[kk] = la1[kk] + off1; }
    G.all0 = all0; G.ref0 = ref0; G.all1 = all1; G.ref1 = ref1;
}
struct Gate2Ld { v4u a[4]; v4u bw; float bias; };
__device__ __forceinline__ void gate2_load(const Frame& F, int b, int h, int c, Gate2Ld& L) {
    const size_t row0 = (size_t)b * SEQ + (size_t)c * 64; const int fr = F.lane & 15, fq = F.lane >> 4, dir = F.wave >> 2, dt = F.wave & 3;
#pragma unroll
    for (int tt = 0; tt < 4; ++tt) { L.a[tt] = (v4u){0u, 0u, 0u, 0u}; if (fq < 2) L.a[tt] = *(const v4u*)(F.PROJ + (row0 + 16 * tt + fr) * DINP + C_GLR + dir * 16 + 8 * fq); }
    L.bw = (v4u){0u, 0u, 0u, 0u}; if (fq < 2) L.bw = *(const v4u*)(F.WG_T + ((size_t)dir * 256 + h * 64 + 16 * dt + fr) * 16 + 8 * fq);
    L.bias = (dir ? F.b_gk_bwd : F.b_gk_fwd)[h * 64 + 16 * dt + fr];
}
struct Gates2 { float b[4][4]; float all, ref; };
__device__ __forceinline__ void gates2(const Frame& F, const Gate2Ld& L, Gates2& G) {
    const int fr = F.lane & 15, fq = F.lane >> 4, dir = F.wave >> 2;
    float la[4][4];
#pragma unroll
    for (int tt = 0; tt < 4; ++tt) {
        f32x4 z = {0.f, 0.f, 0.f, 0.f};
        z = mfma16(__builtin_bit_cast(bf16x8, L.a[tt]), __builtin_bit_cast(bf16x8, L.bw), z);
#pragma unroll
        for (int r = 0; r < 4; ++r) la[tt][r] = log_sigmoid(z[r] + L.bias) * (1.0f / 16.0f);
    }
    float tot[4], excP[4], T4[4], p[4][4];
#pragma unroll
    for (int tt = 0; tt < 4; ++tt) {
        p[tt][0] = la[tt][0]; p[tt][1] = p[tt][0] + la[tt][1]; p[tt][2] = p[tt][1] + la[tt][2]; p[tt][3] = p[tt][2] + la[tt][3];
        T4[tt] = p[tt][3];
        float inc = T4[tt]; float v = __shfl(inc, (F.lane + 48) & 63); inc += (fq >= 1) ? v : 0.f; v = __shfl(inc, (F.lane + 32) & 63); inc += (fq >= 2) ? v : 0.f;
        excP[tt] = inc - T4[tt]; tot[tt] = __shfl(inc, 48 + fr);
    }
    const float all = (tot[0] + tot[1]) + (tot[2] + tot[3]);
    const float runF[4] = {0.f, tot[0], tot[0] + tot[1], tot[0] + tot[1] + tot[2]};
    const float runB[4] = {tot[1] + tot[2] + tot[3], tot[2] + tot[3], tot[3], 0.f};
    const bool fwd = (dir == 0);
#pragma unroll
    for (int tt = 0; tt < 4; ++tt) {
        const float baseF = runF[tt] + excP[tt];
        const float baseB = runB[tt] + (tot[tt] - excP[tt] - T4[tt]);
#pragma unroll
        for (int r = 0; r < 4; ++r) { const float bf = baseF + p[tt][r], bb = baseB + (T4[tt] - p[tt][r] + la[tt][r]); G.b[tt][r] = fwd ? bf : bb; }
    }
    G.all = all; G.ref = fwd ? (tot[0] + tot[1]) : (tot[2] + tot[3]);
}
__device__ __forceinline__ void vr_load(const Frame& F, size_t row0, int h, v4u (&w)[2]) {
#pragma unroll
    for (int i = 0; i < 2; ++i) { const int idx = F.tid + 512 * i; w[i] = *(const v4u*)(F.PROJ + (row0 + (idx >> 4)) * DINP + C_GV + h * 128 + (idx & 15) * 8); }
}
__device__ __forceinline__ void vr_store(const Frame& F, const v4u (&w)[2], LAS bf16* VR) {
#pragma unroll
    for (int i = 0; i < 2; ++i) { const int idx = F.tid + 512 * i; *(LAS v4u*)(VR + (idx >> 4) * 144 + (idx & 15) * 8) = w[i]; }
}
__device__ __forceinline__ bf16x8 vr_frag(const LAS bf16* VR, int ks, int v0, int fr, int fq) {
    const LAS bf16* p = VR + (32 * ks + 8 * fq + (fr >> 2)) * 144 + v0 + 4 * (fr & 3);
    const v2u x = lds_tr16(p), y = lds_tr16(p + 4 * 144);
    v4u r; r.x = x.x; r.y = x.y; r.z = y.x; r.w = y.y; return __builtin_bit_cast(bf16x8, r);
}
__device__ __forceinline__ size_t gla_idx(int dir, int b, int h, int c) { return (size_t)(((dir * 2 + b) * 4 + h) * NCH + c); }

struct GlaALd { Gate2Ld g; unsigned short k[4][4]; v4u vr[2]; };
__device__ __forceinline__ void gla_a_load(const Frame& F, int unit, GlaALd& L) {
    const int c = unit & 127, h = (unit >> 7) & 3, b = unit >> 9;
    const size_t row0 = (size_t)b * SEQ + (size_t)c * 64; const int fr = F.lane & 15, fq = F.lane >> 4, dt = F.wave & 3;
    gate2_load(F, b, h, c, L.g);
#pragma unroll
    for (int tt = 0; tt < 4; ++tt)
#pragma unroll
        for (int r = 0; r < 4; ++r) L.k[tt][r] = F.PROJ[(row0 + 16 * tt + 4 * fq + r) * DINP + C_GK + h * 64 + 16 * dt + fr];
    vr_load(F, row0, h, L.vr);
}
__device__ __forceinline__ void gla_a_compute(Frame& F, int unit, const GlaALd& L) {
    const int c = unit & 127, h = (unit >> 7) & 3, b = unit >> 9;
    LAS bf16* KT = (LAS bf16*)(F.lds + 12288);
    LAS bf16* VR = (LAS bf16*)(F.lds + 12288 + 18432);
    const int fr = F.lane & 15, fq = F.lane >> 4, w = F.wave, dir = w >> 2, dt = w & 3;
    Gates2 G; gates2(F, L.g, G);
    __syncthreads();
#pragma unroll
    for (int tt = 0; tt < 4; ++tt) {
        v2u kw; kw.x = pk2(bf2f(L.k[tt][0]) * __expf(G.all - G.b[tt][0]), bf2f(L.k[tt][1]) * __expf(G.all - G.b[tt][1]));
        kw.y = pk2(bf2f(L.k[tt][2]) * __expf(G.all - G.b[tt][2]), bf2f(L.k[tt][3]) * __expf(G.all - G.b[tt][3]));
        *(LAS v2u*)(KT + (dir * 64 + 16 * dt + fr) * 72 + 16 * tt + 4 * fq) = kw;
    }
    vr_store(F, L.vr, VR);
    __syncthreads();
    const LAS bf16* ap = KT + (16 * w + fr) * 72 + 8 * fq;
    const bf16x8 a0 = *(const LAS bf16x8*)(ap), a1 = *(const LAS bf16x8*)(ap + 32);
    float* up = F.UT + gla_idx(w >> 2, b, h, c) * 8192 + 16 * (w & 3) + 4 * fq;
    bf16x8 vf[8][2];
#pragma unroll
    for (int vt = 0; vt < 8; ++vt) { vf[vt][0] = vr_frag(VR, 0, 16 * vt, fr, fq); vf[vt][1] = vr_frag(VR, 1, 16 * vt, fr, fq); }
    __builtin_amdgcn_sched_barrier(0);
    f32x4 acc[8];
#pragma unroll
    for (int vt = 0; vt < 8; ++vt) { acc[vt] = (f32x4){0.f, 0.f, 0.f, 0.f}; acc[vt] = mfma16(a0, vf[vt][0], acc[vt]); acc[vt] = mfma16(a1, vf[vt][1], acc[vt]); }
    __builtin_amdgcn_sched_barrier(0);
#pragma unroll
    for (int vt = 0; vt < 8; ++vt) *(f32x4*)(up + (size_t)(16 * vt + fr) * 64) = acc[vt];
    if (fq == 0) F.DEC[gla_idx(dir, b, h, c) * 64 + 16 * dt + fr] = __expf(G.all);
}
__device__ __forceinline__ void gla_scan(Frame& F) {
    for (int gid = F.vcu * 512 + F.tid; gid < 16 * 8192; gid += F.G * 512) {
        const int stream = gid >> 13, e = gid & 8191, d = e & 63, dir = stream >> 3;
        float s = 0.f;
#pragma unroll 8
        for (int n = 0; n < NCH; ++n) {
            const int c = dir ? (NCH - 1 - n) : n; const size_t idx = (size_t)stream * NCH + c;
            const float u = F.UT[idx * 8192 + e], dc = F.DEC[idx * 64 + d];
            F.ST[idx * 8192 + e] = (bf16)f2bf(s);
            s = s * dc + u;
        }
    }
}
struct GlaCLd { Gate2Ld g; };
__device__ __forceinline__ void gla_c_load(const Frame& F, int unit, GlaCLd& L) {
    const int c = unit & 127, h = (unit >> 7) & 3, b = unit >> 9;
    gate2_load(F, b, h, c, L.g);
}
__device__ __forceinline__ void gla_c_compute(Frame& F, int unit, const GlaCLd& L) {
    const int c = unit & 127, h = (unit >> 7) & 3, b = unit >> 9;
    LAS bf16* QS = (LAS bf16*)(F.lds + 12288);
    LAS bf16* KS = (LAS bf16*)(F.lds + 30720);
    LAS bf16* AC = (LAS bf16*)(F.lds + 49152);
    LAS bf16* VR = (LAS bf16*)(F.lds + 74752);
    LAS bf16* SC = (LAS bf16*)(F.lds + 74752 + 18432);
    LAS float* SSQ = (LAS float*)(F.lds);
    const size_t row0 = (size_t)b * SEQ + (size_t)c * 64;
    const int fr = F.lane & 15, fq = F.lane >> 4, w = F.wave;
    v4u vr[2]; v4u st[4]; v2u gg[4];
    vr_load(F, row0, h, vr);
#pragma unroll
    for (int rep = 0; rep < 4; ++rep) { const int q = F.tid + 512 * (rep & 1), dir = rep >> 1, v = q >> 3, d8 = q & 7; st[rep] = *(const v4u*)(F.ST + gla_idx(dir, b, h, c) * 8192 + v * 64 + d8 * 8); }
#pragma unroll
    for (int it = 0; it < 4; ++it) gg[it] = *(const v2u*)(F.PROJ + (row0 + 16 * it + fr) * DINP + C_GG + h * 128 + 16 * w + 4 * fq);
    unsigned short q16[4][4], k16[4][4];
#pragma unroll
    for (int tt = 0; tt < 4; ++tt)
#pragma unroll
        for (int r = 0; r < 4; ++r) { const bf16* rp = F.PROJ + (row0 + 16 * tt + 4 * fq + r) * DINP + h * 64 + 16 * (w & 3) + fr; q16[tt][r] = rp[C_GQ]; k16[tt][r] = rp[C_GK]; }
    Gates2 G; gates2(F, L.g, G);
    __syncthreads();
    {
        const int dir = w >> 2, d = 16 * (w & 3) + fr; const float er = __expf(G.ref);
#pragma unroll
        for (int tt = 0; tt < 4; ++tt)
#pragma unroll
            for (int r = 0; r < 4; ++r) {
                const int i = 16 * tt + 4 * fq + r;
                const float q = bf2f(q16[tt][r]), k = bf2f(k16[tt][r]);
                const float e = __expf(G.b[tt][r] - G.ref), qe = q * e;
                QS[(dir * 64 + i) * 72 + d] = (bf16)f2bf(qe); KS[(dir * 64 + i) * 72 + d] = (bf16)f2bf(k * __builtin_amdgcn_rcpf(e));
                AC[i * 200 + 64 + dir * 64 + d] = (bf16)f2bf(qe * er);
            }
    }
    vr_store(F, vr, VR);
#pragma unroll
    for (int rep = 0; rep < 4; ++rep) { const int q = F.tid + 512 * (rep & 1), dir = rep >> 1, v = q >> 3, d8 = q & 7; *(LAS v4u*)(SC + v * 144 + dir * 64 + d8 * 8) = st[rep]; }
    __syncthreads();
    {
        const int it = w & 3, jp = w >> 2;
        bf16x8 qf[2][2], kf[2][2][2];
#pragma unroll
        for (int dir = 0; dir < 2; ++dir)
#pragma unroll
            for (int ks = 0; ks < 2; ++ks) qf[dir][ks] = *(const LAS bf16x8*)(QS + (dir * 64 + 16 * it + fr) * 72 + 32 * ks + 8 * fq);
#pragma unroll
        for (int jj = 0; jj < 2; ++jj)
#pragma unroll
            for (int dir = 0; dir < 2; ++dir)
#pragma unroll
                for (int ks = 0; ks < 2; ++ks) kf[jj][dir][ks] = *(const LAS bf16x8*)(KS + (dir * 64 + 16 * (2 * jp + jj) + fr) * 72 + 32 * ks + 8 * fq);
        __builtin_amdgcn_sched_barrier(0);
        f32x4 sa[2][2];
#pragma unroll
        for (int jj = 0; jj < 2; ++jj)
#pragma unroll
            for (int dir = 0; dir < 2; ++dir) { sa[jj][dir] = (f32x4){0.f, 0.f, 0.f, 0.f};
#pragma unroll
                for (int ks = 0; ks < 2; ++ks) sa[jj][dir] = mfma16(kf[jj][dir][ks], qf[dir][ks], sa[jj][dir]); }
        __builtin_amdgcn_sched_barrier(0);
#pragma unroll
        for (int jj = 0; jj < 2; ++jj) {
            const int jt = 2 * jp + jj;
            const f32x4 s0 = sa[jj][0], s1 = sa[jj][1];
            const int i = 16 * it + fr; float sv[4];
#pragma unroll
            for (int r = 0; r < 4; ++r) { const int j = 16 * jt + 4 * fq + r; sv[r] = ((j <= i) ? s0[r] : 0.f) + ((j >= i) ? s1[r] : 0.f); }
            v2u pw; pw.x = pk2(sv[0], sv[1]); pw.y = pk2(sv[2], sv[3]);
            *(LAS v2u*)(AC + i * 200 + 16 * jt + 4 * fq) = pw;
        }
    }
    __syncthreads();
    f32x4 o[4];
#pragma unroll
    for (int it = 0; it < 4; ++it) o[it] = (f32x4){0.f, 0.f, 0.f, 0.f};
    {
        bf16x8 bfr[6], af[6][4];
#pragma unroll
        for (int ks = 0; ks < 6; ++ks) { bfr[ks] = ks < 2 ? vr_frag(VR, ks, 16 * w, fr, fq) : *(const LAS bf16x8*)(SC + (16 * w + fr) * 144 + 32 * (ks - 2) + 8 * fq);
#pragma unroll
            for (int it = 0; it < 4; ++it) af[ks][it] = *(const LAS bf16x8*)(AC + (16 * it + fr) * 200 + 32 * ks + 8 * fq); }
        __builtin_amdgcn_sched_barrier(0);
#pragma unroll
        for (int ks = 0; ks < 6; ++ks)
#pragma unroll
            for (int it = 0; it < 4; ++it) o[it] = mfma16(bfr[ks], af[ks][it], o[it]);
        __builtin_amdgcn_sched_barrier(0);
    }
#pragma unroll
    for (int it = 0; it < 4; ++it) { float s = (o[it][0] * o[it][0] + o[it][1] * o[it][1]) + (o[it][2] * o[it][2] + o[it][3] * o[it][3]);
        s += __shfl_xor(s, 16); s += __shfl_xor(s, 32); if (fq == 0) SSQ[w * 64 + 16 * it + fr] = s; }
    __syncthreads();
    const f32x4 gv = *(const f32x4*)(F.g_gla_out + 16 * w + 4 * fq);
#pragma unroll
    for (int it = 0; it < 4; ++it) {
        const int i = 16 * it + fr; float s = 0.f;
#pragma unroll
        for (int ww = 0; ww < 8; ++ww) s += SSQ[ww * 64 + i];
        const float rinv = __builtin_amdgcn_rsqf(s * (1.0f / 128.0f) + EPS);
        const v2u gw = gg[it];
        const float g0 = bflo(gw.x), g1 = bfhi(gw.x), g2 = bflo(gw.y), g3 = bfhi(gw.y);
        const float r0 = o[it][0] * rinv * gv[0] * (g0 * __builtin_amdgcn_rcpf(1.0f + __expf(-g0))), r1 = o[it][1] * rinv * gv[1] * (g1 * __builtin_amdgcn_rcpf(1.0f + __expf(-g1)));
        const float r2 = o[it][2] * rinv * gv[2] * (g2 * __builtin_amdgcn_rcpf(1.0f + __expf(-g2))), r3 = o[it][3] * rinv * gv[3] * (g3 * __builtin_amdgcn_rcpf(1.0f + __expf(-g3)));
        v2u ow; ow.x = pk2(r0, r1); ow.y = pk2(r2, r3);
        *(v2u*)(F.O + (row0 + i) * D + h * 128 + 16 * w + 4 * fq) = ow;
    }
}
__device__ __forceinline__ void p3_phase(Frame& F) {
    GlaALd LA; int u = F.vcu;
    {   AttnLd AL; int ua = F.vcu; bool ha = ua < 256;
        if (ha) attn_load(F, ua, AL);
        while (ha) { attn_compute(F, ua, AL); ua += F.G; ha = ua < 256; if (ha) attn_load(F, ua, AL); }
    }
    for (; u < 1024; u += F.G) { gla_a_load(F, u, LA); gla_a_compute(F, u, LA); }
}
__device__ __forceinline__ void p5_phase(Frame& F) {
    for (int u = F.vcu; u < 1024; u += F.G) { GlaCLd L; gla_c_load(F, u, L); gla_c_compute(F, u, L); }
}

__device__ __forceinline__ void p7_rows(Frame& F) {
    LAS bf16* WR = (LAS bf16*)(F.lds);
    LAS float* A1 = (LAS float*)(F.lds + 66048);
    LAS float* B2 = A1 + 1024;
    LAS float* C2 = B2 + 1024;
    LAS int* HIST = (LAS int*)(C2 + 1024);
    LAS int* BASE = HIST + 32;
    __syncthreads();
    for (int idx = F.tid; idx < 32 * 128; idx += 512) { const int e = idx >> 7, ch = idx & 127; *(LAS v4u*)(WR + e * 1032 + ch * 8) = *(const v4u*)(F.WR_T + e * 1024 + ch * 8); }
    const int fr = F.lane & 15, fq = F.lane >> 4;
    for (int rg = F.vcu; rg < T / 64; rg += F.G) {
        const int b = (rg * 64) / SEQ;
        __syncthreads();
        for (int i = F.tid; i < D; i += 512) { const float* md = F.MOD + b * 6144;
            A1[i] = md[2048 + i] * F.g_post_mix[i]; B2[i] = F.g_pre_ffn[i] * (1.0f + md[4096 + i]); C2[i] = md[3072 + i]; }
        if (F.tid < 32) HIST[F.tid] = 0;
        __syncthreads();
        for (int rr = 0; rr < 8; ++rr) {
            const int row = rg * 64 + F.wave * 8 + rr;
            const GAS v2u* yr = (const GAS v2u*)(F.Y + (size_t)row * D) + F.lane;
            const GAS f32x4* xr = (const GAS f32x4*)(F.x + (size_t)row * D) + F.lane;
            f32x4 y[4], xv[4]; float s = 0.f;
#pragma unroll
            for (int j = 0; j < 4; ++j) { const v2u yw = yr[64 * j]; y[j] = (f32x4){bflo(yw.x), bfhi(yw.x), bflo(yw.y), bfhi(yw.y)}; xv[j] = xr[64 * j]; s += (y[j].x * y[j].x + y[j].y * y[j].y) + (y[j].z * y[j].z + y[j].w * y[j].w); }
            const float rinv1 = 1.0f / sqrtf(wave_sum(s) * (1.0f / D) + EPS);
            float s2 = 0.f;
            GAS v2u* o1 = (GAS v2u*)(F.H + (size_t)row * D) + F.lane;
#pragma unroll
            for (int j = 0; j < 4; ++j) { const f32x4 a = *(const LAS f32x4*)(A1 + 4 * F.lane + 256 * j);
                xv[j] = xv[j] + a * (y[j] * rinv1); { v2u w; w.x = pk2(xv[j].x, xv[j].y); w.y = pk2(xv[j].z, xv[j].w); o1[64 * j] = w; }
                s2 += (xv[j].x * xv[j].x + xv[j].y * xv[j].y) + (xv[j].z * xv[j].z + xv[j].w * xv[j].w); }
            const float rinv2 = 1.0f / sqrtf(wave_sum(s2) * (1.0f / D) + EPS);
            GAS v2u* o8 = (GAS v2u*)(F.H2 + (size_t)row * D) + F.lane;
#pragma unroll
            for (int j = 0; j < 4; ++j) { const f32x4 a = *(const LAS f32x4*)(B2 + 4 * F.lane + 256 * j), c = *(const LAS f32x4*)(C2 + 4 * F.lane + 256 * j);
                const f32x4 h = (xv[j] * rinv2) * a + c; v2u w; w.x = pk2(h.x, h.y); w.y = pk2(h.z, h.w); o8[64 * j] = w;
                ((GAS unsigned*)(F.H2F8 + (size_t)row * D))[F.lane + 64 * j] = pk4_fp8(sat8(h.x), sat8(h.y), sat8(h.z), sat8(h.w)); }
        }
        VM_WAIT();
        __syncthreads();
        int myi = 0, myslot = 0; float myg = 0.f;
        if (F.wave < 4) {
            const int r0 = rg * 64 + F.wave * 16;
            f32x4 acc0 = {0.f, 0.f, 0.f, 0.f}, acc1 = {0.f, 0.f, 0.f, 0.f};
            const bf16* hp = F.H2 + (size_t)(r0 + fr) * D + 8 * fq;
#pragma unroll 8
            for (int ks = 0; ks < 32; ++ks) {
                const bf16x8 bfr = *(const bf16x8*)(hp + 32 * ks);
                acc0 = mfma16(*(const LAS bf16x8*)(WR + fr * 1032 + 32 * ks + 8 * fq), bfr, acc0);
                acc1 = mfma16(*(const LAS bf16x8*)(WR + (16 + fr) * 1032 + 32 * ks + 8 * fq), bfr, acc1);
            }
            float v[8];
#pragma unroll
            for (int r = 0; r < 4; ++r) { v[r] = acc0[r] + F.b_router[4 * fq + r]; v[4 + r] = acc1[r] + F.b_router[16 + 4 * fq + r]; }
            float tv[4]; int ti[4];
#pragma unroll
            for (int t = 0; t < 4; ++t) {
                float bv = -3.0e38f; int bi = 0;
#pragma unroll
                for (int q = 0; q < 8; ++q) { const int id = (q >> 2) * 16 + 4 * fq + (q & 3); if (v[q] > bv) { bv = v[q]; bi = id; } }
#pragma unroll
                for (int o = 16; o <= 32; o <<= 1) { const float pv = __shfl_xor(bv, o); const int pi = __shfl_xor(bi, o); if (pv > bv || (pv == bv && pi < bi)) { bv = pv; bi = pi; } }
                tv[t] = bv; ti[t] = bi;
#pragma unroll
                for (int q = 0; q < 8; ++q) { const int id = (q >> 2) * 16 + 4 * fq + (q & 3); if (id == bi) v[q] = -3.0e38f; }
            }
            const float e1 = __expf(tv[1] - tv[0]), e2 = __expf(tv[2] - tv[0]), e3 = __expf(tv[3] - tv[0]);
            const float rs = 1.0f / (1.0f + e1 + e2 + e3);
            myi = fq == 0 ? ti[0] : fq == 1 ? ti[1] : fq == 2 ? ti[2] : ti[3];
            myg = (fq == 0 ? 1.0f : fq == 1 ? e1 : fq == 2 ? e2 : e3) * rs;
            myslot = atomicAdd((int*)(HIST + myi), 1);
        }
        __syncthreads();
        if (F.tid < 32) BASE[F.tid] = (int)__hip_atomic_fetch_add((unsigned*)(F.ctl + CW_CNT + F.tid), (unsigned)HIST[F.tid], RLX_AGENT);
        __syncthreads();
        if (F.wave < 4) {
            const int asg = (rg * 64 + F.wave * 16 + fr) * 4 + fq;
            F.LIST[(size_t)myi * LCAP + BASE[myi] + myslot] = asg | (int)(f2bf(myg) << 16);
        }
    }
}

__device__ __forceinline__ void p10_final(Frame& F) {
    LAS float* A2 = (LAS float*)(F.lds);
    for (int rg = F.vcu; rg < T / 64; rg += F.G) {
        const int b = (rg * 64) / SEQ;
        __syncthreads();
        for (int i = F.tid; i < D; i += 512) A2[i] = F.MOD[b * 6144 + 5120 + i] * F.g_post_ffn[i];
        __syncthreads();
        unsigned yq[4][4]; v2u xq[4];
        auto ld = [&](int row, unsigned (&y)[4][4], v2u (&x)[4]) {
#pragma unroll
            for (int k = 0; k < 4; ++k) { const GAS unsigned* yp = (const GAS unsigned*)((const unsigned char*)F.Y2 + ((size_t)row * 4 + k) * D) + F.lane;
#pragma unroll
                for (int j = 0; j < 4; ++j) y[k][j] = yp[64 * j]; }
            const GAS v2u* x1p = (const GAS v2u*)(F.H + (size_t)row * D) + F.lane;
#pragma unroll
            for (int j = 0; j < 4; ++j) x[j] = x1p[64 * j];
        };
        ld(rg * 64 + F.wave * 8, yq, xq);
#pragma unroll 1
        for (int rr = 0; rr < 8; ++rr) {
            const int row = rg * 64 + F.wave * 8 + rr;
            unsigned yn[4][4]; v2u xn[4];
            if (rr < 7) ld(row + 1, yn, xn);
            f32x4 ys[4];
#pragma unroll
            for (int j = 0; j < 4; ++j) ys[j] = (f32x4){0.f, 0.f, 0.f, 0.f};
#pragma unroll
            for (int k = 0; k < 4; ++k)
#pragma unroll
                for (int j = 0; j < 4; ++j) { const int w = (int)yq[k][j];
                    ys[j].x += __builtin_amdgcn_cvt_f32_fp8(w, 0); ys[j].y += __builtin_amdgcn_cvt_f32_fp8(w, 1); ys[j].z += __builtin_amdgcn_cvt_f32_fp8(w, 2); ys[j].w += __builtin_amdgcn_cvt_f32_fp8(w, 3); }
            float s = 0.f;
#pragma unroll
            for (int j = 0; j < 4; ++j) s += (ys[j].x * ys[j].x + ys[j].y * ys[j].y) + (ys[j].z * ys[j].z + ys[j].w * ys[j].w);
            const float rinv = 1.0f / sqrtf(wave_sum(s) * (1.0f / D) * (YSC_INV * YSC_INV) + EPS) * YSC_INV;
            GAS f32x4* o1 = (GAS f32x4*)(F.out + (size_t)row * D) + F.lane;
#pragma unroll
            for (int j = 0; j < 4; ++j) { const f32x4 a = *(const LAS f32x4*)(A2 + 4 * F.lane + 256 * j); const v2u xw = xq[j];
                const f32x4 x1 = {bflo(xw.x), bfhi(xw.x), bflo(xw.y), bfhi(xw.y)}; o1[64 * j] = x1 + a * (ys[j] * rinv); }
            if (rr < 7) {
#pragma unroll
                for (int k = 0; k < 4; ++k)
#pragma unroll
                    for (int j = 0; j < 4; ++j) yq[k][j] = yn[k][j];
#pragma unroll
                for (int j = 0; j < 4; ++j) xq[j] = xn[j];
            }
        }
    }
}

struct Args { const float* in[22]; float* out; unsigned char* ws; int ph_lo, ph_hi, li, pad; };
__global__ void __launch_bounds__(NWAVES * 64, 2) fwd_megakernel(Args args) {
    extern __shared__ __attribute__((aligned(16))) unsigned char lds_raw[];
    Frame F;
    F.lds = (LAS unsigned char*)lds_raw;
    F.MISC = (volatile LAS unsigned*)(F.lds + MISC_OFF);
    F.tid = threadIdx.x; F.lane = F.tid & 63; F.wave = __builtin_amdgcn_readfirstlane(F.tid >> 6);
    F.G = gridDim.x; { const int bx = blockIdx.x; F.vcu = (F.G % 8 == 0) ? (bx % 8) * (F.G / 8) + bx / 8 : bx; }
    unsigned char* ws = args.ws;
    F.ctl = (GAS unsigned*)(ws + WS_CTL);
    F.x = args.in[0]; F.c = args.in[1]; F.w_ada = args.in[2]; F.b_ada = args.in[3]; F.g_pre_mix = args.in[4]; F.g_post_mix = args.in[5]; F.w_in = args.in[6];
    F.w_gk_fwd = args.in[7]; F.b_gk_fwd = args.in[8]; F.w_gk_bwd = args.in[9]; F.b_gk_bwd = args.in[10]; F.g_gla_out = args.in[11]; F.attn_sink = args.in[12];
    F.w_out = args.in[13]; F.g_pre_ffn = args.in[14]; F.g_post_ffn = args.in[15]; F.w_router = args.in[16]; F.b_router = args.in[17]; F.w_gate_up = args.in[18];
    F.b_gate_up = args.in[19]; F.w_down = args.in[20]; F.b_down = args.in[21]; F.out = args.out;
    F.MOD = (float*)(ws + WS_MOD); F.ROPE = (float*)(ws + WS_ROPE); F.GATE = (float*)(ws + WS_GATE); F.DEC = (float*)(ws + WS_DEC); F.UT = (float*)(ws + WS_UT); F.Y = (bf16*)(ws + WS_Y);
    F.WR_T = (bf16*)(ws + WS_WR_T); F.WG_T = (bf16*)(ws + WS_WG_T); F.WIN_T = (bf16*)(ws + WS_WIN_T); F.WOUT_T = (bf16*)(ws + WS_WOUT_T); F.WGU_T = ws + WS_WGU_T; F.WD_T = ws + WS_WD_T; F.H2F8 = ws + WS_H2F8;
    F.H = (bf16*)(ws + WS_H); F.PROJ = (bf16*)(ws + WS_PROJ); F.ST = (bf16*)(ws + WS_ST); F.O = (bf16*)(ws + WS_O); F.H2 = (bf16*)(ws + WS_H2); F.ACT = ws + WS_ACT; F.Y2 = (bf16*)(ws + WS_Y2);
    F.LIST = (int*)(ws + WS_LIST);
    for (int u = F.tid; u < (LDS_BYTES - LDSCTL_OFF) / 4; u += NWAVES * 64) ((LAS unsigned*)(F.lds + LDSCTL_OFF))[u] = 0u;
    __syncthreads();
    XcdBarrier bar; bar.bar = (unsigned*)(F.ctl + CW_BAR) + args.li * XCD_BAR_WORDS; bar.x = 0; bar.st = nullptr;
    if (MK_N_LAUNCHES == 1) bar = xcd_barrier_post((unsigned*)(F.ctl + CW_BAR), F.MISC + 8);
    const int lo = args.ph_lo, hi = args.ph_hi;
#define IN(k) (lo <= (k) && (k) < hi)
#if defined(PROBE_PA)
    GAS unsigned long long* stamps = (GAS unsigned long long*)(F.ctl + 2048);
#define SEAM(k) do { if (blockIdx.x == 0 && F.tid == 0) stamps[16 + (k)] = __builtin_amdgcn_s_memrealtime(); if (IN(k) && IN((k) + 1)) xcd_barrier(bar); \
                     if (blockIdx.x == 0 && F.tid == 0) stamps[(k) + 1] = __builtin_amdgcn_s_memrealtime(); } while (0)
    if (blockIdx.x == 0 && F.tid == 0) stamps[0] = __builtin_amdgcn_s_memrealtime();
#else
#define SEAM(k) do { if (IN(k) && IN((k) + 1)) xcd_barrier(bar); } while (0)
#endif

    if (IN(0)) { p0_prologue(F); } SEAM(0);
    const bool spread = (F.G == 256);
    const int xl = F.vcu >> 5, jl = F.vcu & 31;
    const bool conv2 = spread && (jl >= NG2 / 8);
    if (IN(1)) { p1_norm(F);
                 if (!spread) { p0_f8_convert<0>(F, 0, NA8, F.vcu * NWAVES + F.wave, F.G * NWAVES); p0_f8_convert<1>(F, 0, NB8, F.vcu * NWAVES + F.wave, F.G * NWAVES); } } SEAM(1);
    if (IN(2)) { if (conv2) p0_f8_convert<0>(F, 0, NA8, (xl * (32 - NG2 / 8) + (jl - NG2 / 8)) * NWAVES + F.wave, (256 - NG2) * NWAVES);
                 else { ProjPolicy P; P.A = F.H; P.Bt = F.WIN_T; P.KB = D * 2; P.so.init(T, DINP, spread ? NG2 : F.G, spread ? (jl * 8 + xl) : (int)blockIdx.x); P.O = F.PROJ; P.rope = F.ROPE;
                        pg8::gemm_phase<ProjPolicy>(F.lds, P); } } SEAM(2);
    if (IN(3)) { p3_phase(F); } SEAM(3);
    if (IN(4)) { gla_scan(F); } SEAM(4);
    if (IN(5)) { p5_phase(F); } SEAM(5);
    if (IN(6)) { OutPolicy P; P.A = F.O; P.Bt = F.WOUT_T; P.KB = D * 2; P.so.init(T, D, F.G, (int)blockIdx.x); P.C = F.Y;
                 pg8::gemm_phase<OutPolicy>(F.lds, P); } SEAM(6);
    if (IN(7)) { p7_rows(F); } SEAM(7);
    if (IN(8) || IN(9)) {
        volatile LAS int* tb = (volatile LAS int*)(F.MISC + 16);
        __syncthreads();
        if (F.tid == 0) { int acc = 0; for (int e = 0; e < NE; ++e) { tb[e] = acc; const int cn = (int)__hip_atomic_load((unsigned*)(F.ctl + CW_CNT + e), RLX_AGENT); acc += (cn + 255) >> 8; } tb[32] = acc; }
        __syncthreads();
        volatile LAS int* rtab = (volatile LAS int*)(F.MISC + 64);
        for (int rt = F.tid; rt < tb[32]; rt += 512) { int e = 0; for (int j = 1; j < 32; ++j) e = (rt >= tb[j]) ? j : e;
            const int s0 = (rt - tb[e]) * 256, rem = (int)__hip_atomic_load((unsigned*)(F.ctl + CW_CNT + e), RLX_AGENT) - s0; rtab[rt] = e | ((rem < 256 ? rem : 256) << 8) | (s0 << 17); }
        __syncthreads();
        if (IN(8)) { Moe1Policy P; P.tb = tb; P.rtab = rtab; P.llds = F.lds + LDSCTL_OFF + 4096; P.cnt = (const int*)(F.ctl + CW_CNT); P.list = F.LIST; P.G = F.G; P.c = (int)blockIdx.x; P.ncol = 8;
                     P.A = F.H2F8; P.Bt = F.WGU_T; P.KB = D; P.ACTp = F.ACT; P.bias = F.b_gate_up;
                     pg8::gemm_phase<Moe1Policy>(F.lds, P);
                     if (spread && ((int)blockIdx.x >> 3) >= 16) p0_f8_convert<1>(F, 0, NB8, ((((int)blockIdx.x >> 3) - 16) * 8 + ((int)blockIdx.x & 7)) * NWAVES + F.wave, 128 * NWAVES); }
        SEAM(8);
        if (IN(9)) { Moe2Policy P; P.tb = tb; P.rtab = rtab; P.llds = F.lds + LDSCTL_OFF + 4096; P.cnt = (const int*)(F.ctl + CW_CNT); P.list = F.LIST; P.G = F.G; P.c = (int)blockIdx.x; P.ncol = 4;
                     P.A = F.ACT; P.Bt = F.WD_T; P.KB = DFF; P.Y2p = (unsigned char*)F.Y2; P.bias = F.b_down;
                     pg8::gemm_phase<Moe2Policy>(F.lds, P); }
    }
    SEAM(9);
    if (IN(10)) { p10_final(F); }
#if defined(PROBE_PA)
    if (blockIdx.x == 0 && F.tid == 0) stamps[11] = __builtin_amdgcn_s_memrealtime();
    {
        if (blockIdx.x == 0 && F.tid == 0) {
            auto dur = [&](int k) -> float { const unsigned long long a = stamps[k], b = (k == 9) ? stamps[16 + 9] : stamps[k + 1]; return (float)(long long)(b - a) * 0.01f; };
            const float tA = dur(PROBE_PA), tB = dur(PROBE_PB);
            const float V = 1000.0f * rintf(tB * 0.2f) + 2.0f * tA;
            const unsigned long long t0 = __builtin_amdgcn_s_memrealtime(), want = (unsigned long long)(V * 100.0f);
            while (__builtin_amdgcn_s_memrealtime() - t0 < want) __builtin_amdgcn_s_sleep(8);
        }
    }
#endif
#undef IN
#undef SEAM
}

extern "C" void kernel_launch(void* const* d_in, const int* in_sizes, int n_in, void* d_out, int out_size, void* d_ws, size_t ws_size, hipStream_t stream) {
    static int grid = 0;
    if (grid == 0) {
        if (n_in != 22 || in_sizes[0] != T * D || out_size != T * D || ws_size < WS_END) { fprintf(stderr, "kernel_launch: unexpected shapes (n_in %d, in0 %d, out %d, ws %zu)\n", n_in, n_in > 0 ? in_sizes[0] : -1, out_size, ws_size); grid = -1; return; }
        int dev = 0, cus = 0, per_cu = 0;
        if (hipGetDevice(&dev) != hipSuccess || hipDeviceGetAttribute(&cus, hipDeviceAttributeMultiprocessorCount, dev) != hipSuccess) { grid = -1; return; }
        if (hipFuncSetAttribute((const void*)fwd_megakernel, hipFuncAttributeMaxDynamicSharedMemorySize, LDS_BYTES) != hipSuccess) { fprintf(stderr, "kernel_launch: hipFuncSetAttribute failed\n"); grid = -1; return; }
        if (hipOccupancyMaxActiveBlocksPerMultiprocessor(&per_cu, (const void*)fwd_megakernel, NWAVES * 64, LDS_BYTES) != hipSuccess || per_cu < 1)
            fprintf(stderr, "kernel_launch: note: occupancy query reports %d blocks per CU\n", per_cu);
        (void)hipGetLastError();
        grid = cus;
    }
    if (grid < 0) return;
    if (hipMemsetAsync((char*)d_ws + WS_CTL, 0, CTL_ZERO_BYTES, stream) != hipSuccess) { fprintf(stderr, "kernel_launch: memset failed\n"); return; }
    Args a{};
    for (int i = 0; i < 22; ++i) a.in[i] = (const float*)d_in[i];
    a.out = (float*)d_out; a.ws = (unsigned char*)d_ws;
    if (MK_N_LAUNCHES == 1) {
        a.ph_lo = 0; a.ph_hi = N_PHASES; a.li = 0;
        hipLaunchKernelGGL(fwd_megakernel, dim3(grid), dim3(NWAVES * 64), LDS_BYTES, stream, a);
    } else {
        for (int p = 0; p < N_PHASES; ++p) { a.ph_lo = p; a.ph_hi = p + 1; a.li = 0;
            hipLaunchKernelGGL(fwd_megakernel, dim3(grid), dim3(NWAVES * 64), LDS_BYTES, stream, a); }
    }
    const hipError_t le = hipPeekAtLastError();
    if (le != hipSuccess) fprintf(stderr, "kernel_launch: launch failed: %s\n", hipGetErrorName(le));
}
```

```cpp
#include <hip/hip_runtime.h>
#include <cstdio>
#include <cstdint>

#define GAS __attribute__((address_space(1)))
#define LAS __attribute__((address_space(3)))
typedef unsigned short bf16;
typedef unsigned v4u __attribute__((ext_vector_type(4)));
typedef unsigned v2u __attribute__((ext_vector_type(2)));
typedef float f32x4 __attribute__((ext_vector_type(4)));
typedef float f32x2 __attribute__((ext_vector_type(2)));
typedef short bf16x8 __attribute__((ext_vector_type(8)));
typedef short bf16x4 __attribute__((ext_vector_type(4)));
typedef int i32x4 __attribute__((ext_vector_type(4)));
typedef int i32x8 __attribute__((ext_vector_type(8)));

#ifndef MK_N_LAUNCHES
#define MK_N_LAUNCHES 1
#endif
constexpr int N_PHASES = 11;

constexpr int NB = 2, SEQ = 8192, T = NB * SEQ, D = 1024, DIN = 2336, DINP = 2560, NE = 32, DFF = 1024;
constexpr int C_GQ = 0, C_GK = 256, C_GV = 512, C_GG = 1024, C_GLR = 1536, C_AQ = 1568, C_AK = 2080, C_AV = 2208;
constexpr int NCH = 128;
constexpr float EPS = 1e-6f;
constexpr int LCAP = 16384;
constexpr int ACT_ROWS = 65536 + NE * 256;

constexpr size_t MiB = 1u << 20;
constexpr size_t WS_CTL = 0, CTL_ZERO_BYTES = 1 * MiB;
constexpr size_t WS_MOD = 1 * MiB;
constexpr size_t WS_ROPE = 1 * MiB + 512 * 1024;
constexpr size_t WS_WR_T = 2 * MiB;
constexpr size_t WS_WG_T = 2 * MiB + 128 * 1024;
constexpr size_t WS_LIST = 3 * MiB;
constexpr size_t WS_GATE = 5 * MiB;
constexpr size_t WS_DEC = 6 * MiB;
constexpr size_t WS_WIN_T = 8 * MiB;
constexpr size_t WS_WOUT_T = 14 * MiB;
constexpr size_t WS_WGU_T = 16 * MiB;
constexpr size_t WS_WD_T = 80 * MiB;
constexpr size_t WS_H2F8 = 112 * MiB;
constexpr size_t WS_H = 208 * MiB;
constexpr size_t WS_PROJ = 240 * MiB;
constexpr size_t WS_UT = 320 * MiB;
constexpr size_t WS_ST = 384 * MiB;
constexpr size_t WS_O = 416 * MiB;
constexpr size_t WS_Y = 448 * MiB;
constexpr size_t WS_H2 = 512 * MiB;
constexpr size_t WS_ACT = 544 * MiB;
constexpr size_t WS_Y2 = 688 * MiB;
constexpr size_t WS_END = 816 * MiB;
constexpr int CW_CNT = 64;
constexpr int CW_BAR = 4096;

constexpr int RING_BYTES = 131072;
constexpr int LDSCTL_OFF = RING_BYTES, MISC_OFF = LDSCTL_OFF + 320;
constexpr int LDS_BYTES = 147456;
constexpr int NWAVES = 8;

#define RLX_AGENT __ATOMIC_RELAXED, __HIP_MEMORY_SCOPE_AGENT
#define LDS_WAIT() asm volatile("s_waitcnt lgkmcnt(0)" ::: "memory")
#define VM_WAIT() asm volatile("s_waitcnt vmcnt(0)" ::: "memory")
__device__ __forceinline__ unsigned f2bf(float f) { unsigned u = __builtin_bit_cast(unsigned, f); return (u + 0x7fffu + ((u >> 16) & 1u)) >> 16; }
__device__ __forceinline__ unsigned pk2(float lo, float hi) { return f2bf(lo) | (f2bf(hi) << 16); }
__device__ __forceinline__ float bf2f(unsigned v) { return __builtin_bit_cast(float, v << 16); }
__device__ __forceinline__ float bflo(unsigned w) { return __builtin_bit_cast(float, w << 16); }
__device__ __forceinline__ float bfhi(unsigned w) { return __builtin_bit_cast(float, w & 0xffff0000u); }
constexpr float YSC = 16.0f, YSC_INV = 1.0f / 16.0f;
constexpr float WSC = 64.0f, WSC_INV = 1.0f / 64.0f, ASC = 4.0f;
__device__ __forceinline__ float sat8(float x) { return __builtin_amdgcn_fmed3f(x, -448.0f, 448.0f); }
__device__ __forceinline__ unsigned pk4_fp8(float a, float b, float c, float d) { int w = 0; w = __builtin_amdgcn_cvt_pk_fp8_f32(a, b, w, false); w = __builtin_amdgcn_cvt_pk_fp8_f32(c, d, w, true); return (unsigned)w; }
__device__ __forceinline__ float wave_sum(float v) {
#define WS_DPP(x, ctrl, rmask) __builtin_bit_cast(float, __builtin_amdgcn_update_dpp(0, __builtin_bit_cast(int, (x)), (ctrl), (rmask), 0xf, false))
    v += WS_DPP(v, 0xb1, 0xf); v += WS_DPP(v, 0x4e, 0xf); v += WS_DPP(v, 0x141, 0xf); v += WS_DPP(v, 0x140, 0xf);
    v += WS_DPP(v, 0x142, 0xa); v += WS_DPP(v, 0x143, 0xc);
#undef WS_DPP
    return __builtin_bit_cast(float, __builtin_amdgcn_readlane(__builtin_bit_cast(int, v), 63));
}

#define XB_TMO      128
#define XB_XCNT(j)  (256  + 64 * (j))
#define XB_XSUB(j)  (1280 + 64 * (j))
#define XB_XGEN(j)  (2304 + 64 * (j))
#define XB_TOP      3328
#define XB_TOPGEN   3392
#define XCD_BAR_WORDS 3456
#define XB_SPIN_CAP (1u << 18)
__device__ __forceinline__ unsigned xb_ld(unsigned* p)              { return __hip_atomic_load(p, __ATOMIC_RELAXED, __HIP_MEMORY_SCOPE_AGENT); }
__device__ __forceinline__ unsigned xb_add(unsigned* p, unsigned v) { return __hip_atomic_fetch_add(p, v, __ATOMIC_RELAXED, __HIP_MEMORY_SCOPE_AGENT); }
__device__ __forceinline__ unsigned xb_xcc_id() { return (unsigned)__builtin_amdgcn_s_getreg((3 << 11) | 20) & 0xFu; }
#define XB_SPIN(cond, bar) do { unsigned _sp = 0; while (cond) { __builtin_amdgcn_s_sleep(1); \
    if ((++_sp & 255u) == 0u) { if (xb_ld(&(bar)[XB_TMO])) break; if (_sp > XB_SPIN_CAP) { atomicAdd(&(bar)[XB_TMO], 1u); break; } } } } while (0)
struct XcdBarrier { unsigned* bar; unsigned x; volatile LAS unsigned* st; };
__device__ __forceinline__ XcdBarrier xcd_barrier_post(unsigned* bar, volatile LAS unsigned* st) {
    XcdBarrier b; b.bar = bar; b.x = xb_xcc_id(); b.st = st;
    if (threadIdx.x == 0) (void)xb_add(&bar[XB_XCNT(b.x)], 1u);
    return b;
}
__device__ __forceinline__ void xcd_barrier_complete(unsigned* bar, unsigned x, unsigned& nloc, unsigned& nx) {
    const unsigned G = gridDim.x * gridDim.y * gridDim.z;
    unsigned sum, cnt, mine, sp = 0u;
    for (;;) {
        sum = 0u; cnt = 0u; mine = 0u;
#pragma unroll
        for (unsigned j = 0; j < 16; ++j) { const unsigned c = xb_ld(&bar[XB_XCNT(j)]); sum += c; cnt += (c > 0u) ? 1u : 0u; mine = (j == x) ? c : mine; }
        if (sum == G) break;
        __builtin_amdgcn_s_sleep(1);
        if ((++sp & 255u) == 0u) { if (xb_ld(&bar[XB_TMO])) break; if (sp > XB_SPIN_CAP) { atomicAdd(&bar[XB_TMO], 1u); break; } }
    }
    nloc = mine > 0u ? mine : 1u; nx = cnt > 0u ? cnt : 1u;
}
__device__ __forceinline__ void xcd_barrier(const XcdBarrier& b) {
    asm volatile("s_waitcnt vmcnt(0)" ::: "memory");
    __syncthreads();
    if (threadIdx.x == 0) {
        unsigned* bar = b.bar;
        __builtin_amdgcn_s_waitcnt(0);
        unsigned nloc = b.st[0], nx = b.st[1];
        if (nloc == 0u) { xcd_barrier_complete(bar, b.x, nloc, nx); b.st[0] = nloc; b.st[1] = nx; }
        const unsigned old = xb_add(&bar[XB_XSUB(b.x)], 1u);
        const unsigned gen = old / nloc;
        if (old + 1u == (gen + 1u) * nloc) {
            __builtin_amdgcn_fence(__ATOMIC_RELEASE, "agent");
            asm volatile("s_waitcnt vmcnt(0)" ::: "memory");
            const unsigned og = xb_add(&bar[XB_TOP], 1u);
            const unsigned tg = og / nx;
            if (og + 1u == (tg + 1u) * nx) xb_add(&bar[XB_TOPGEN], 1u);
            else XB_SPIN(xb_ld(&bar[XB_TOPGEN]) == tg, bar);
            __builtin_amdgcn_fence(__ATOMIC_ACQUIRE, "agent");
            xb_add(&bar[XB_XGEN(b.x)], 1u);
            asm volatile("s_waitcnt vmcnt(0)" ::: "memory");
        } else {
            XB_SPIN(xb_ld(&bar[XB_XGEN(b.x)]) == gen, bar);
            __builtin_amdgcn_fence(__ATOMIC_ACQUIRE, "agent");
            asm volatile("s_waitcnt vmcnt(0)" ::: "memory");
        }
    }
    __syncthreads();
}

namespace pg8 {
constexpr int BM = 256, BK = 64, HALF = 128, HTB = HALF * BK * 2, NXCD = 8, WGM = 8;
__device__ __forceinline__ int lds_byte(int r, int c) { const int st = (r >> 4) * 2 + (c >> 5), rr = r & 15, cc = c & 31, ob = rr * 64 + cc * 2; return st * 1024 + (ob ^ (((ob >> 9) & 1) << 5)); }
__device__ __forceinline__ void stage_rc(int b, int& R, int& C) { const int st = b / 1024, sb = b % 1024, swz = sb ^ (((sb >> 9) & 1) << 5); R = (st >> 1) * 16 + swz / 64; C = (st & 1) * 32 + (swz % 64) / 2; }
__device__ __forceinline__ int perm32(int rho) { const int n = rho >> 4, i = rho & 15; return 8 * (i >> 2) + 4 * n + (i & 3); }
struct Unit { int pm, pn, e, nrows; };
__device__ __forceinline__ unsigned cvt_pk_bf16(float lo, float hi) { unsigned r; asm volatile("v_cvt_pk_bf16_f32 %0, %1, %2" : "=v"(r) : "v"(lo), "v"(hi)); return r; }

struct StaticOrder {
    int nM, nN, nwg, G, c;
    __device__ void init(int M, int N, int G_, int c_) { nM = M / BM; nN = N / BM; nwg = nM * nN; G = G_; c = c_; }
    __device__ bool next(int i, int& pm, int& pn) const {
        const long L = (long)i * G + c; if (L >= nwg) return false;
        int wgid = (int)L; { const int q = nwg / NXCD, r = nwg % NXCD, xcd = wgid % NXCD, off = wgid / NXCD; wgid = (xcd < r ? xcd * (q + 1) : r * (q + 1) + (xcd - r) * q) + off; }
        const int nig = WGM * nN, gid = wgid / nig, fm = gid * WGM, gsz = (nM - fm) < WGM ? (nM - fm) : WGM;
        pm = fm + ((wgid % nig) % gsz); pn = (wgid % nig) / gsz; return true;
    }
};

template <class P>
__device__ __forceinline__ void gemm_phase(LAS unsigned char* lds, const P& S) {
    const int tid = threadIdx.x, wid = __builtin_amdgcn_readfirstlane(tid >> 6), lane = tid & 63, wr = wid >> 2, wc = wid & 3, fr = lane & 15, fq = lane >> 4;
    const int KB = S.KB, nt = KB / 128;
    int RA[2], CA[2]; unsigned voffB[2];
#pragma unroll
    for (int i = 0; i < 2; ++i) { int R, C; stage_rc(tid * 16 + i * 8192, R, C); RA[i] = R; CA[i] = C * 2; const int Rb = P::PERM ? ((R & ~31) + perm32(R & 31)) : R; voffB[i] = (unsigned)(Rb * KB + C * 2); }
    const unsigned kstep = 128u;
    const unsigned hstepB = (unsigned)HALF * KB;
    const unsigned ldsw = (unsigned)wid * 1024u;
    const int aoff = lds_byte(wr * 64 + fr, fq * 8), boff = lds_byte(wc * 32 + fr, fq * 8);
    constexpr int HI = 1024;
    const __amdgpu_buffer_rsrc_t rsA = __builtin_amdgcn_make_buffer_rsrc((void*)S.A, 0, 0x7fffffff, 0x00020000);
    const __amdgpu_buffer_rsrc_t rsB = __builtin_amdgcn_make_buffer_rsrc((void*)S.Bt, 0, 0x7fffffff, 0x00020000);
#define PG8_SA(b, h) (((b) * 2 + (h)) * HTB)
#define PG8_SB(b, h) ((4 + (b) * 2 + (h)) * HTB)
#define PG8_STGB(bufoff, gbase) do { _Pragma("unroll") for (int _i = 0; _i < 2; ++_i) \
        __builtin_amdgcn_raw_ptr_buffer_load_lds(rsB, (LAS void*)(lds + (bufoff) + ldsw + _i * 8192), 16, voffB[_i], (int)(gbase), 0, 0); } while (0)
#define PG8_STGA(bufoff, kb, o0, o1) do { \
        __builtin_amdgcn_raw_ptr_buffer_load_lds(rsA, (LAS void*)(lds + (bufoff) + ldsw), 16, (o0), (int)(kb), 0, 0); \
        __builtin_amdgcn_raw_ptr_buffer_load_lds(rsA, (LAS void*)(lds + (bufoff) + ldsw + 8192), 16, (o1), (int)(kb), 0, 0); } while (0)
#define PG8_LDA(dst, b, h) do { _Pragma("unroll") for (int m = 0; m < 4; ++m) _Pragma("unroll") for (int k = 0; k < 2; ++k) dst[m][k] = *(const LAS bf16x8*)(lds + PG8_SA(b, h) + aoff + m * 2048 + k * HI); } while (0)
#define PG8_LDB(dst, b, h) do { _Pragma("unroll") for (int n = 0; n < 2; ++n) _Pragma("unroll") for (int k = 0; k < 2; ++k) dst[n][k] = *(const LAS bf16x8*)(lds + PG8_SB(b, h) + boff + n * 2048 + k * HI); } while (0)
#define PG8_CAT(x) __builtin_shufflevector(__builtin_bit_cast(i32x4, (x)[0]), __builtin_bit_cast(i32x4, (x)[1]), 0, 1, 2, 3, 4, 5, 6, 7)
#define PG8_MMA(ai, bj, At, Bt) do { __builtin_amdgcn_s_setprio(1); _Pragma("unroll") for (int m = 0; m < 4; ++m) _Pragma("unroll") for (int n = 0; n < 2; ++n) { \
        if constexpr (P::F8) { const i32x8 a8 = PG8_CAT(Bt[n]), b8 = PG8_CAT(At[m]); asm volatile("v_mfma_f32_16x16x128_f8f6f4 %0, %1, %2, %0" : "+v"(acc[ai][bj][m][n]) : "v"(a8), "v"(b8)); } \
        else { _Pragma("unroll") for (int k = 0; k < 2; ++k) acc[ai][bj][m][n] = __builtin_amdgcn_mfma_f32_16x16x32_bf16(Bt[n][k], At[m][k], acc[ai][bj][m][n], 0, 0, 0); } } \
        __builtin_amdgcn_s_setprio(0); } while (0)
#define PG8_WAIT_V(n) asm volatile("s_waitcnt vmcnt(" #n ")" ::: "memory")
#define PG8_WAIT_L(n) asm volatile("s_waitcnt lgkmcnt(" #n ")" ::: "memory")
#define PG8_BAR __builtin_amdgcn_s_barrier()
#define PG8_SCHED __builtin_amdgcn_sched_barrier(0)
    Unit cur, nxt; int ui = 0;
    if (!S.next(0, cur)) return;
    f32x4 acc[2][2][4][2];
#pragma unroll
    for (int a = 0; a < 2; ++a)
#pragma unroll
        for (int b = 0; b < 2; ++b)
#pragma unroll
            for (int m = 0; m < 4; ++m)
#pragma unroll
                for (int n = 0; n < 2; ++n) acc[a][b][m][n] = (f32x4){0.f, 0.f, 0.f, 0.f};
    bf16x8 At[4][2], B0[2][2], B1[2][2];
    unsigned c00, c01, c10, c11, n00, n01, n10, n11;
    typename P::Pre pre;
    S.aoff(cur, RA[0], RA[1], CA[0], CA[1], c00, c01, c10, c11);
    if constexpr (P::LIST_LDS) { if (wr == 0) S.list_dma(cur, 0, wid, lane); }
    unsigned cB = S.boffs(cur);
    PG8_STGB(PG8_SB(0, 0), cB); PG8_STGB(PG8_SB(0, 1), cB + hstepB); PG8_STGA(PG8_SA(0, 0), 0, c00, c01); PG8_STGA(PG8_SA(0, 1), 0, c10, c11);
    if (wr == 1) PG8_BAR;
    PG8_WAIT_V(2); PG8_BAR;
    PG8_STGB(PG8_SB(1, 0), cB + kstep); PG8_STGA(PG8_SA(1, 0), kstep, c00, c01); PG8_STGB(PG8_SB(1, 1), cB + hstepB + kstep);
    PG8_WAIT_V(6); PG8_BAR;
    for (;;) {
        const bool has_next = S.next(ui + 1, nxt);
        unsigned nB = cB;
        n00 = c00; n01 = c01; n10 = c10; n11 = c11;
        if (has_next) { if constexpr (!P::LIST_LDS) S.aoff(nxt, RA[0], RA[1], CA[0], CA[1], n00, n01, n10, n11); nB = S.boffs(nxt); }
        for (int t = 0; t < nt; t += 2) {
            const bool last = (t == nt - 2);
            if constexpr (P::LIST_LDS) { if (last && has_next) S.aoff_lds(nxt, (ui + 1) & 1, RA[0], RA[1], CA[0], CA[1], n00, n01, n10, n11); }

            const unsigned k1 = (unsigned)(t + 1) * kstep;
            const unsigned k2 = last ? 0u : (unsigned)(t + 2) * kstep, k3 = k2 + kstep;
            const unsigned b2 = last ? nB : cB + (unsigned)(t + 2) * kstep, b3 = b2 + kstep;
            const unsigned x00 = last ? n00 : c00, x01 = last ? n01 : c01, x10 = last ? n10 : c10, x11 = last ? n11 : c11;
            PG8_LDB(B0, 0, 0); PG8_LDB(B1, 0, 1); PG8_SCHED; PG8_LDA(At, 0, 0); PG8_STGA(PG8_SA(1, 1), k1, c10, c11);
            PG8_WAIT_V(8); PG8_WAIT_L(0); PG8_BAR;
            if constexpr (P::LIST_LDS) { if (t == 0 && wr == 0) { S.bias_dma(cur, wid, lane); if (has_next) S.list_dma(nxt, (ui + 1) & 1, wid, lane); } }
            PG8_MMA(0, 0, At, B0); PG8_MMA(0, 1, At, B1); PG8_BAR; PG8_SCHED;
            PG8_LDA(At, 0, 1); PG8_STGB(PG8_SB(0, 0), b2); PG8_STGB(PG8_SB(0, 1), b2 + hstepB); PG8_STGA(PG8_SA(0, 0), k2, x00, x01);
            PG8_WAIT_V(8); PG8_WAIT_L(0); PG8_BAR; PG8_MMA(1, 0, At, B0); PG8_MMA(1, 1, At, B1); PG8_BAR; PG8_SCHED;
            PG8_LDB(B0, 1, 0); PG8_LDB(B1, 1, 1); PG8_SCHED; PG8_LDA(At, 1, 0); PG8_STGA(PG8_SA(0, 1), k2, x10, x11);
            PG8_WAIT_V(8); PG8_WAIT_L(0); PG8_BAR; PG8_MMA(0, 0, At, B0); PG8_MMA(0, 1, At, B1); PG8_BAR; PG8_SCHED;
            PG8_LDA(At, 1, 1); PG8_STGB(PG8_SB(1, 0), b3); PG8_STGB(PG8_SB(1, 1), b3 + hstepB); PG8_STGA(PG8_SA(1, 0), k3, x00, x01);
            PG8_WAIT_V(8); PG8_WAIT_L(0); PG8_BAR; PG8_MMA(1, 0, At, B0); PG8_MMA(1, 1, At, B1); PG8_BAR; PG8_SCHED;
        }
        if (wr == 0) PG8_BAR;
        if constexpr (P::F8) asm volatile("s_nop 15\n\ts_nop 15" ::: "memory");
        if (!P::DUP || (ui & 1)) { S.pre_load(cur, pre, wc, fq); S.epi(acc, cur, pre, ui & 1, wr, wc, fr, fq); }
        if (!has_next) break;
        if (!P::DUP || (ui & 1)) {
#pragma unroll
        for (int a = 0; a < 2; ++a)
#pragma unroll
            for (int b = 0; b < 2; ++b)
#pragma unroll
                for (int m = 0; m < 4; ++m)
#pragma unroll
                    for (int n = 0; n < 2; ++n) acc[a][b][m][n] = (f32x4){0.f, 0.f, 0.f, 0.f};
        }
        cur = nxt; cB = nB; c00 = n00; c01 = n01; c10 = n10; c11 = n11; ++ui;
        if (wr == 1) PG8_BAR;
    }
    PG8_WAIT_V(0);
    PG8_BAR;
#undef PG8_SA
#undef PG8_SB
#undef PG8_STGA
#undef PG8_STGB
#undef PG8_LDA
#undef PG8_LDB
#undef PG8_MMA
#undef PG8_WAIT_V
#undef PG8_WAIT_L
#undef PG8_BAR
#undef PG8_SCHED
}
}

struct Frame {
    LAS unsigned char* lds;
    volatile LAS unsigned* MISC;
    GAS unsigned* ctl;
    int tid, lane, wave, vcu, G;
    const float *x, *c, *w_ada, *b_ada, *g_pre_mix, *g_post_mix, *w_in, *w_gk_fwd, *b_gk_fwd, *w_gk_bwd, *b_gk_bwd, *g_gla_out, *attn_sink, *w_out,
                *g_pre_ffn, *g_post_ffn, *w_router, *b_router, *w_gate_up, *b_gate_up, *w_down, *b_down;
    float* out;
    float *MOD, *ROPE, *GATE, *DEC, *UT; bf16* Y;
    bf16 *WR_T, *WIN_T, *WOUT_T, *H, *PROJ, *ST, *O, *H2, *Y2, *WG_T;
    unsigned char *WGU_T, *WD_T, *ACT, *H2F8;
    int* LIST;
};

struct ProjPolicy {
    static constexpr bool PERM = true;
    static constexpr bool F8 = false, DUP = false, LIST_LDS = false;
    struct Pre {};
    __device__ __forceinline__ void pre_load(const pg8::Unit&, Pre&, int, int) const {}
    const bf16* A; const bf16* Bt; int KB; pg8::StaticOrder so; bf16* O; const float* rope;
    __device__ __forceinline__ bool next(int i, pg8::Unit& u) const { u.e = 0; u.nrows = 256; return so.next(i, u.pm, u.pn); }
    __device__ __forceinline__ void aoff(const pg8::Unit& u, int R0, int R1, int C0, int C1, unsigned& o00, unsigned& o01, unsigned& o10, unsigned& o11) const {
        const unsigned b = (unsigned)u.pm * 256u;
        o00 = (b + R0) * KB + C0; o01 = (b + R1) * KB + C1; o10 = (b + 128 + R0) * KB + C0; o11 = (b + 128 + R1) * KB + C1;
    }
    __device__ __forceinline__ unsigned boffs(const pg8::Unit& u) const { return (unsigned)u.pn * 256u * KB; }
    __device__ __forceinline__ void epi(const f32x4 (&acc)[2][2][4][2], const pg8::Unit& u, const Pre&, int, int wr, int wc, int fr, int fq) const {
        const int row0 = u.pm * 256 + wr * 64 + fr;
#pragma unroll
        for (int bj = 0; bj < 2; ++bj) {
            const int cb = u.pn * 256 + bj * 128 + wc * 32;
            const float sc = (cb < C_GK || (cb >= C_AQ && cb < C_AK)) ? 0.125f : 1.f;
            const bool rot = (cb >= C_AQ) && (cb < C_AV) && (((cb - C_AQ) & 63) == 0);
            const float sg = (fq == 0) ? -1.f : 1.f;
#pragma unroll
            for (int ai = 0; ai < 2; ++ai)
#pragma unroll
                for (int m = 0; m < 4; ++m) {
                    const int row = row0 + ai * 128 + m * 16;
                    f32x4 v0 = acc[ai][bj][m][0], v1 = acc[ai][bj][m][1];
                    if (rot) {
                        const float* rp = rope + (size_t)(row & (SEQ - 1)) * 16;
                        const f32x4 c0 = *(const f32x4*)(rp), c1 = *(const f32x4*)(rp + 4), s0 = *(const f32x4*)(rp + 8), s1 = *(const f32x4*)(rp + 12);
                        f32x4 p0, p1;
#pragma unroll
                        for (int j = 0; j < 4; ++j) { p0[j] = __shfl_xor(v0[j], 16); p1[j] = __shfl_xor(v1[j], 16); }
                        if (fq < 2) { v0 = v0 * c0 + (p0 * s0) * sg; v1 = v1 * c1 + (p1 * s1) * sg; }
                    }
                    v0 = v0 * sc; v1 = v1 * sc;
                    v4u w; w.x = pg8::cvt_pk_bf16(v0[0], v0[1]); w.y = pg8::cvt_pk_bf16(v0[2], v0[3]); w.z = pg8::cvt_pk_bf16(v1[0], v1[1]); w.w = pg8::cvt_pk_bf16(v1[2], v1[3]);
                    *(v4u*)(O + (size_t)row * DINP + cb + 8 * fq) = w;
                }
        }
    }
};
struct OutPolicy {
    static constexpr bool PERM = true;
    static constexpr bool F8 = false, DUP = false, LIST_LDS = false;
    struct Pre {};
    __device__ __forceinline__ void pre_load(const pg8::Unit&, Pre&, int, int) const {}
    const bf16* A; const bf16* Bt; int KB; pg8::StaticOrder so; bf16* C;
    __device__ __forceinline__ bool next(int i, pg8::Unit& u) const { u.e = 0; u.nrows = 256; return so.next(i, u.pm, u.pn); }
    __device__ __forceinline__ void aoff(const pg8::Unit& u, int R0, int R1, int C0, int C1, unsigned& o00, unsigned& o01, unsigned& o10, unsigned& o11) const {
        const unsigned b = (unsigned)u.pm * 256u;
        o00 = (b + R0) * KB + C0; o01 = (b + R1) * KB + C1; o10 = (b + 128 + R0) * KB + C0; o11 = (b + 128 + R1) * KB + C1;
    }
    __device__ __forceinline__ unsigned boffs(const pg8::Unit& u) const { return (unsigned)u.pn * 256u * KB; }
    __device__ __forceinline__ void epi(const f32x4 (&acc)[2][2][4][2], const pg8::Unit& u, const Pre&, int, int wr, int wc, int fr, int fq) const {
        const int row0 = u.pm * 256 + wr * 64 + fr, col0 = u.pn * 256 + wc * 32 + 8 * fq;
#pragma unroll
        for (int ai = 0; ai < 2; ++ai)
#pragma unroll
            for (int m = 0; m < 4; ++m) { bf16* rowp = C + (size_t)(row0 + ai * 128 + m * 16) * D + col0;
#pragma unroll
                for (int bj = 0; bj < 2; ++bj) { const f32x4 v0 = acc[ai][bj][m][0], v1 = acc[ai][bj][m][1];
                    v4u w; w.x = pg8::cvt_pk_bf16(v0[0], v0[1]); w.y = pg8::cvt_pk_bf16(v0[2], v0[3]); w.z = pg8::cvt_pk_bf16(v1[0], v1[1]); w.w = pg8::cvt_pk_bf16(v1[2], v1[3]);
                    *(v4u*)(rowp + bj * 128) = w; } }
    }
};
struct MoePolicyBase {
    const volatile LAS int* tb; const volatile LAS int* rtab; const int* cnt; const int* list; int G, c, ncol;
    __device__ __forceinline__ bool next_rt(int i, pg8::Unit& u) const {
        const int NT = tb[32];
        int rt, pn;
        if ((G & 7) == 0) {
            const int x = c & 7, j = c >> 3, per = G >> 3, base = NT >> 3, rem = NT & 7, len = base + (x < rem ? 1 : 0), start = x * base + (x < rem ? x : rem);
            const int uidx = i * per + j, rl = uidx / ncol; if (rl >= len) return false;
            rt = start + rl; pn = uidx - rl * ncol;
        } else { const int L = i * G + c; if (L >= NT * ncol) return false; rt = L / ncol; pn = L - rt * ncol; }
        const int w = rtab[rt];
        u.pn = pn; u.pm = rt; u.e = w & 255; u.nrows = (w >> 8) & 511; return true;
    }
    __device__ __forceinline__ int slot0(const pg8::Unit& u) const { return (int)((unsigned)rtab[u.pm] >> 17); }
    LAS unsigned char* llds;
    __device__ __forceinline__ void list_dma(const pg8::Unit& u, int buf, int wid, int lane) const {
        const __amdgpu_buffer_rsrc_t rs = __builtin_amdgcn_make_buffer_rsrc((void*)list, 0, 0x7fffffff, 0x00020000);
        __builtin_amdgcn_raw_ptr_buffer_load_lds(rs, (LAS void*)(llds + buf * 1024 + wid * 256), 4, (unsigned)(wid * 256 + lane * 4), (int)(((unsigned)u.e * LCAP + (unsigned)slot0(u)) * 4u), 0, 0);
    }
    __device__ __forceinline__ void lds16x4(unsigned a0, unsigned a1, unsigned a2, unsigned a3, f32x4& v0, f32x4& v1, f32x4& v2, f32x4& v3) const {
        asm volatile("ds_read_b128 %0, %4\n\tds_read_b128 %1, %5\n\tds_read_b128 %2, %6\n\tds_read_b128 %3, %7\n\ts_waitcnt lgkmcnt(0)"
                     : "=&v"(v0), "=&v"(v1), "=&v"(v2), "=&v"(v3) : "v"(a0), "v"(a1), "v"(a2), "v"(a3) : "memory");
    }
    __device__ __forceinline__ void list_lds4(int buf, int r0, int r1, int r2, int r3, int& v0, int& v1, int& v2, int& v3) const {
        const unsigned base = (unsigned)(uintptr_t)(llds + buf * 1024);
        asm volatile("ds_read_b32 %0, %4\n\tds_read_b32 %1, %5\n\tds_read_b32 %2, %6\n\tds_read_b32 %3, %7\n\ts_waitcnt lgkmcnt(0)"
                     : "=&v"(v0), "=&v"(v1), "=&v"(v2), "=&v"(v3) : "v"(base + r0 * 4), "v"(base + r1 * 4), "v"(base + r2 * 4), "v"(base + r3 * 4) : "memory");
    }
};
struct Moe1Policy : MoePolicyBase {
#ifdef PROBE_DUP1
    static constexpr bool PERM = true, F8 = true, DUP = true, LIST_LDS = false;
    static constexpr float DSC = 0.5f;
#else
    static constexpr bool PERM = true, F8 = true, DUP = false, LIST_LDS = true;
    static constexpr float DSC = 1.0f;
#endif
    struct Pre { f32x4 g0, g1, u0, u1; };
    const unsigned char* A; const unsigned char* Bt; int KB; unsigned char* ACTp; const float* bias;
    __device__ __forceinline__ bool next(int i, pg8::Unit& u) const { return next_rt(DUP ? (i >> 1) : i, u); }
    __device__ __forceinline__ void bias_dma(const pg8::Unit& u, int wid, int lane) const {
        const __amdgpu_buffer_rsrc_t rs = __builtin_amdgcn_make_buffer_rsrc((void*)bias, 0, 0x7fffffff, 0x00020000);
        __builtin_amdgcn_raw_ptr_buffer_load_lds(rs, (LAS void*)(llds + 2048 + wid * 256), 4, (unsigned)((((wid & 1) * 64 + lane) + (wid >> 1) * 1024) * 4), (int)(((unsigned)u.e * 2048u + (unsigned)u.pn * 128u) * 4u), 0, 0);
    }
    __device__ __forceinline__ void pre_load(const pg8::Unit&, Pre& p, int wc, int fq) const {
        const unsigned a = (unsigned)(uintptr_t)(llds + 2048) + (unsigned)(wc * 32 + 8 * fq) * 4u;
        lds16x4(a, a + 16, a + 512, a + 528, p.g0, p.g1, p.u0, p.u1);
    }
    __device__ __forceinline__ void offs(const pg8::Unit& u, int R0, int R1, int C0, int C1, int v00, int v01, int v10, int v11, unsigned& o00, unsigned& o01, unsigned& o10, unsigned& o11) const {
        const int t00 = (R0 < u.nrows) ? ((v00 & 0xffff) >> 2) : 0, t01 = (R1 < u.nrows) ? ((v01 & 0xffff) >> 2) : 0;
        const int t10 = (R0 + 128 < u.nrows) ? ((v10 & 0xffff) >> 2) : 0, t11 = (R1 + 128 < u.nrows) ? ((v11 & 0xffff) >> 2) : 0;
        o00 = (unsigned)t00 * KB + C0; o01 = (unsigned)t01 * KB + C1; o10 = (unsigned)t10 * KB + C0; o11 = (unsigned)t11 * KB + C1;
    }
    __device__ __forceinline__ void aoff(const pg8::Unit& u, int R0, int R1, int C0, int C1, unsigned& o00, unsigned& o01, unsigned& o10, unsigned& o11) const {
        const int* lp = list + (size_t)u.e * LCAP + slot0(u);
        const int v00 = lp[R0], v01 = lp[R1], v10 = lp[R0 + 128], v11 = lp[R1 + 128];
        offs(u, R0, R1, C0, C1, v00, v01, v10, v11, o00, o01, o10, o11);
    }
    __device__ __forceinline__ void aoff_lds(const pg8::Unit& u, int buf, int R0, int R1, int C0, int C1, unsigned& o00, unsigned& o01, unsigned& o10, unsigned& o11) const {
        int v00, v01, v10, v11; list_lds4(buf, R0, R1, R0 + 128, R1 + 128, v00, v01, v10, v11);
        offs(u, R0, R1, C0, C1, v00, v01, v10, v11, o00, o01, o10, o11);
    }
    __device__ __forceinline__ unsigned boffs(const pg8::Unit& u) const { return ((unsigned)u.e * 2048u + (unsigned)u.pn * 256u) * KB; }
    __device__ __forceinline__ void epi(const f32x4 (&acc)[2][2][4][2], const pg8::Unit& u, const Pre& p, int, int wr, int wc, int fr, int fq) const {
        const int row0 = u.pm * 256 + wr * 64 + fr, col0 = u.pn * 128 + wc * 32 + 8 * fq;
        const f32x4 g0 = p.g0, g1 = p.g1, u0 = p.u0, u1 = p.u1;
#pragma unroll
        for (int ai = 0; ai < 2; ++ai)
#pragma unroll
            for (int m = 0; m < 4; ++m) {
                float a[8];
#pragma unroll
                for (int n = 0; n < 2; ++n)
#pragma unroll
                    for (int hh = 0; hh < 2; ++hh) {
                        const f32x2 ga = {acc[ai][0][m][n][2 * hh], acc[ai][0][m][n][2 * hh + 1]}, ua = {acc[ai][1][m][n][2 * hh], acc[ai][1][m][n][2 * hh + 1]};
                        const f32x2 gb = n ? (f32x2){g1[2 * hh], g1[2 * hh + 1]} : (f32x2){g0[2 * hh], g0[2 * hh + 1]};
                        const f32x2 ub = n ? (f32x2){u1[2 * hh], u1[2 * hh + 1]} : (f32x2){u0[2 * hh], u0[2 * hh + 1]};
                        f32x2 g = ga * (WSC_INV * DSC) + gb, u = ua * (WSC_INV * DSC * ASC) + (ub + 1.0f) * ASC;
                        g.x = fminf(g.x, 7.0f); g.y = fminf(g.y, 7.0f);
                        u.x = __builtin_amdgcn_fmed3f(u.x, -6.0f * ASC, 8.0f * ASC); u.y = __builtin_amdgcn_fmed3f(u.y, -6.0f * ASC, 8.0f * ASC);
                        const f32x2 t = g * (-1.702f * 1.44269504f);
                        f32x2 e; e.x = __builtin_amdgcn_exp2f(t.x); e.y = __builtin_amdgcn_exp2f(t.y);
                        e = e + 1.0f;
                        f32x2 sg; sg.x = __builtin_amdgcn_rcpf(e.x); sg.y = __builtin_amdgcn_rcpf(e.y);
                        const f32x2 r = (u * g) * sg;
                        a[n * 4 + 2 * hh] = r.x; a[n * 4 + 2 * hh + 1] = r.y;
                    }
                v2u w; w.x = pk4_fp8(a[0], a[1], a[2], a[3]); w.y = pk4_fp8(a[4], a[5], a[6], a[7]);
                *(v2u*)(ACTp + (size_t)(row0 + ai * 128 + m * 16) * DFF + col0) = w;
            }
    }
};
struct Moe2Policy : MoePolicyBase {
    static constexpr bool PERM = true, F8 = true, DUP = false, LIST_LDS = true;
    struct Pre { f32x4 bv[2][2]; };
    const unsigned char* A; const unsigned char* Bt; int KB; unsigned char* Y2p; const float* bias;
    __device__ __forceinline__ bool next(int i, pg8::Unit& u) const { return next_rt(i, u); }
    __device__ __forceinline__ void bias_dma(const pg8::Unit& u, int wid, int lane) const {
        const __amdgpu_buffer_rsrc_t rs = __builtin_amdgcn_make_buffer_rsrc((void*)bias, 0, 0x7fffffff, 0x00020000);
        __builtin_amdgcn_raw_ptr_buffer_load_lds(rs, (LAS void*)(llds + 2048 + wid * 256), 4, (unsigned)((wid * 64 + lane) * 4), (int)(((unsigned)u.e * 1024u + (unsigned)u.pn * 256u) * 4u), 0, 0);
    }
    __device__ __forceinline__ void pre_load(const pg8::Unit&, Pre& p, int wc, int fq) const {
        const unsigned a = (unsigned)(uintptr_t)(llds + 2048) + (unsigned)(wc * 32 + 8 * fq) * 4u;
        lds16x4(a, a + 16, a + 512, a + 528, p.bv[0][0], p.bv[0][1], p.bv[1][0], p.bv[1][1]);
    }
    __device__ __forceinline__ void aoff(const pg8::Unit& u, int R0, int R1, int C0, int C1, unsigned& o00, unsigned& o01, unsigned& o10, unsigned& o11) const {
        const unsigned b = (unsigned)u.pm * 256u;
        o00 = (b + R0) * KB + C0; o01 = (b + R1) * KB + C1; o10 = (b + 128 + R0) * KB + C0; o11 = (b + 128 + R1) * KB + C1;
    }
    __device__ __forceinline__ void aoff_lds(const pg8::Unit& u, int, int R0, int R1, int C0, int C1, unsigned& o00, unsigned& o01, unsigned& o10, unsigned& o11) const { aoff(u, R0, R1, C0, C1, o00, o01, o10, o11); }
    __device__ __forceinline__ unsigned boffs(const pg8::Unit& u) const { return ((unsigned)u.e * 1024u + (unsigned)u.pn * 256u) * KB; }
    __device__ __forceinline__ void epi(const f32x4 (&acc)[2][2][4][2], const pg8::Unit& u, const Pre& p, int buf, int wr, int wc, int fr, int fq) const {
        const int colb = u.pn * 256 + wc * 32 + 8 * fq;
        int ent[2][4];
#pragma unroll
        for (int ai = 0; ai < 2; ++ai) { const int r = ai * 128 + wr * 64 + fr; list_lds4(buf, r, r + 16, r + 32, r + 48, ent[ai][0], ent[ai][1], ent[ai][2], ent[ai][3]); }
#pragma unroll
        for (int ai = 0; ai < 2; ++ai)
#pragma unroll
            for (int m = 0; m < 4; ++m) {
                const int r = ai * 128 + wr * 64 + m * 16 + fr;
                if (r < u.nrows) {
                    const int asg = ent[ai][m] & 0xffff; const float g = bf2f((unsigned)ent[ai][m] >> 16);
                    unsigned char* rowp = Y2p + (size_t)asg * D + colb;
                    const float gs = g * YSC;
#pragma unroll
                    for (int bj = 0; bj < 2; ++bj) {
                        const f32x4 v0 = (acc[ai][bj][m][0] * (WSC_INV / ASC) + p.bv[bj][0]) * gs, v1 = (acc[ai][bj][m][1] * (WSC_INV / ASC) + p.bv[bj][1]) * gs;
                        v2u w; w.x = pk4_fp8(sat8(v0[0]), sat8(v0[1]), sat8(v0[2]), sat8(v0[3])); w.y = pk4_fp8(sat8(v1[0]), sat8(v1[1]), sat8(v1[2]), sat8(v1[3]));
                        *(v2u*)(rowp + bj * 128) = w;
                    }
                }
            }
    }
};

__device__ __forceinline__ void p0_cvt_bf16_item(const float* W, int K, int N, bf16* WT, int kb, int n0, int drow0, int lane) {
    const int n = lane & 31, q = lane >> 5; const float* src = W + (size_t)(64 * kb + 32 * q) * N + n0 + n;
    float v[32];
#pragma unroll
    for (int i = 0; i < 32; ++i) v[i] = src[(size_t)i * N];
    GAS v4u* dst = (GAS v4u*)(WT + (size_t)(drow0 + n) * K + 64 * kb + 32 * q);
#pragma unroll
    for (int j = 0; j < 4; ++j) { v4u o; o.x = pk2(v[8 * j], v[8 * j + 1]); o.y = pk2(v[8 * j + 2], v[8 * j + 3]); o.z = pk2(v[8 * j + 4], v[8 * j + 5]); o.w = pk2(v[8 * j + 6], v[8 * j + 7]); dst[j] = o; }
}
struct F8Desc { const float* src; unsigned char* dst; int N; };
__device__ __forceinline__ F8Desc p0_f8_desc(const Frame& F, int it, int lane) {
    constexpr int I_GU = 8 * 64, I_D = 8 * 32;
    const int e = it / (I_GU + I_D); int r = it - e * (I_GU + I_D);
    const int n4 = lane & 7, kg = lane >> 3;
    F8Desc d;
    if (r < I_GU) { const int nb = r & 63, kb = r >> 6, n0 = nb * 32;
        const int drow = (n0 < 1024) ? ((n0 >> 7) * 256 + (n0 & 127)) : ((((n0 - 1024) >> 7) * 256) + 128 + ((n0 - 1024) & 127));
        d.N = 2048; d.src = F.w_gate_up + (size_t)e * D * 2048 + (size_t)(128 * kb + 16 * kg) * 2048 + n0 + 4 * n4;
        d.dst = F.WGU_T + ((size_t)e * 2048 + drow + 4 * n4) * D + 128 * kb + 16 * kg; }
    else { r -= I_GU; const int nb = r & 31, kb = r >> 5, n0 = nb * 32;
        d.N = D; d.src = F.w_down + (size_t)e * DFF * D + (size_t)(128 * kb + 16 * kg) * D + n0 + 4 * n4;
        d.dst = F.WD_T + ((size_t)e * D + n0 + 4 * n4) * DFF + 128 * kb + 16 * kg; }
    return d;
}
__device__ __forceinline__ void p0_f8_load(f32x4 (&v)[16], const F8Desc& d) {
#pragma unroll
    for (int i = 0; i < 16; ++i) v[i] = __builtin_nontemporal_load((const f32x4*)(d.src + (size_t)i * d.N));
}
__device__ __forceinline__ void p0_f8_store(const f32x4 (&v)[16], const F8Desc& d) {
#pragma unroll
    for (int c = 0; c < 4; ++c) { v4u o;
        o.x = pk4_fp8(v[0][c] * WSC, v[1][c] * WSC, v[2][c] * WSC, v[3][c] * WSC); o.y = pk4_fp8(v[4][c] * WSC, v[5][c] * WSC, v[6][c] * WSC, v[7][c] * WSC);
        o.z = pk4_fp8(v[8][c] * WSC, v[9][c] * WSC, v[10][c] * WSC, v[11][c] * WSC); o.w = pk4_fp8(v[12][c] * WSC, v[13][c] * WSC, v[14][c] * WSC, v[15][c] * WSC);
        __builtin_nontemporal_store(o, (v4u*)(d.dst + (size_t)c * D)); }
}
__device__ __forceinline__ void p0_prologue(Frame& F) {
    const int gw = F.vcu * NWAVES + F.wave, NGW = F.G * NWAVES;
    {
        LAS float* cact = (LAS float*)(F.lds);
        LAS float* red = (LAS float*)(F.lds + 8192);
        for (int i = F.tid; i < 2048; i += 512) { const float v = F.c[i]; cact[i] = v / (1.0f + __expf(-v)); }
        __syncthreads();
        for (int it = F.vcu; it < 256; it += F.G) {
            const int col = F.lane % 24, kp = F.lane / 24, j = it * 24 + col, k0 = F.wave * 128;
            float a0 = 0.f, a1 = 0.f;
            if (kp < 2) {
#pragma unroll 16
                for (int k = 0; k < 64; ++k) { const int kk = k0 + 2 * k + kp; const float w = F.w_ada[(size_t)kk * 6144 + j]; a0 += cact[kk] * w; a1 += cact[1024 + kk] * w; }
            }
            a0 += __shfl(a0, (F.lane + 24) & 63); a1 += __shfl(a1, (F.lane + 24) & 63);
            if (F.lane < 24) { red[(F.wave * 2 + 0) * 24 + col] = a0; red[(F.wave * 2 + 1) * 24 + col] = a1; }
            __syncthreads();
            if (F.tid < 48) { const int b = F.tid / 24, cc = F.tid % 24; float s = F.b_ada[it * 24 + cc];
#pragma unroll
                for (int w = 0; w < 8; ++w) s += red[(w * 2 + b) * 24 + cc];
                F.MOD[b * 6144 + it * 24 + cc] = s; }
            __syncthreads();
        }
    }
    for (int idx = (F.vcu * 512 + F.tid); idx < SEQ * 8; idx += F.G * 512) {
        const int t = idx >> 3, i = idx & 7;
        const float inv = powf(500000.0f, -(float)i / 8.0f);
        const float ang = (float)t * inv;
        const double rev = (double)ang * 0.15915494309189535;
        const float fr = (float)(rev - rint(rev));
        F.ROPE[t * 16 + i] = __builtin_amdgcn_cosf(fr); F.ROPE[t * 16 + 8 + i] = __builtin_amdgcn_sinf(fr);
    }
    for (int idx = F.vcu * 512 + F.tid; idx < 2 * 256 * 16; idx += F.G * 512) { const int dir = idx >> 12, n = (idx >> 4) & 255, r = idx & 15;
        F.WG_T[idx] = (bf16)f2bf((dir ? F.w_gk_bwd : F.w_gk_fwd)[r * 256 + n]); }
    { v4u z = {0u, 0u, 0u, 0u}; GAS v4u* p = (GAS v4u*)(F.WIN_T + (size_t)DIN * D); const int n = (DINP - DIN) * D * 2 / 16;
      for (int i = F.vcu * 512 + F.tid; i < n; i += F.G * 512) p[i] = z; }
    constexpr int I_IN = 16 * (DIN / 32), I_OUT = 16 * 32, I_R = 16;
    for (int it = gw; it < I_IN + I_OUT + I_R; it += NGW) {
        int r = it;
        if (r < I_IN) { const int nb = r % (DIN / 32), kb = r / (DIN / 32); p0_cvt_bf16_item(F.w_in, D, DIN, F.WIN_T, kb, nb * 32, nb * 32, F.lane); continue; } r -= I_IN;
        if (r < I_OUT) { const int nb = r % 32, kb = r / 32; p0_cvt_bf16_item(F.w_out, D, D, F.WOUT_T, kb, nb * 32, nb * 32, F.lane); continue; } r -= I_OUT;
        p0_cvt_bf16_item(F.w_router, D, NE, F.WR_T, r, 0, 0, F.lane);
    }
}
constexpr int N8_ITEMS = NE * (8 * 64 + 8 * 32), K8 = 10, NB8 = K8 * 256, NA8 = N8_ITEMS - NB8;
#ifndef NG2
#define NG2 128
#endif
template <int LIST> __device__ __forceinline__ int f8_item(int v) {
    if (LIST == 0) { if (v < (NE - K8) * 768) return v; const int w = v - (NE - K8) * 768; return (NE - K8 + (w >> 9)) * 768 + (w & 511); }
    return (NE - K8 + (v >> 8)) * 768 + 512 + (v & 255);
}
template <int LIST> __device__ __forceinline__ void p0_f8_convert(Frame& F, int lo, int hi, int wv, int nw) {
    f32x4 va[16], vb[16];
    int it = lo + wv;
    if (it < hi) p0_f8_load(va, p0_f8_desc(F, f8_item<LIST>(it), F.lane));
    for (; it < hi; it += 2 * nw) {
        const bool hb = it + nw < hi, ha = it + 2 * nw < hi;
        if (hb) p0_f8_load(vb, p0_f8_desc(F, f8_item<LIST>(it + nw), F.lane));
        p0_f8_store(va, p0_f8_desc(F, f8_item<LIST>(it), F.lane));
        if (ha) p0_f8_load(va, p0_f8_desc(F, f8_item<LIST>(it + 2 * nw), F.lane));
        if (hb) p0_f8_store(vb, p0_f8_desc(F, f8_item<LIST>(it + nw), F.lane));
    }
}

__device__ __forceinline__ void p1_norm(Frame& F) {
    LAS float* sc = (LAS float*)(F.lds);
    LAS float* sh = (LAS float*)(F.lds + 4096);
    for (int rg = F.vcu; rg < T / 64; rg += F.G) {
        const int b = (rg * 64) / SEQ;
        __syncthreads();
        for (int i = F.tid; i < D; i += 512) { sc[i] = F.g_pre_mix[i] * (1.0f + F.MOD[b * 6144 + 1024 + i]); sh[i] = F.MOD[b * 6144 + i]; }
        __syncthreads();
        for (int rr = 0; rr < 8; ++rr) {
            const int row = rg * 64 + F.wave * 8 + rr;
            const GAS f32x4* xr = (const GAS f32x4*)(F.x + (size_t)row * D) + F.lane;
            f32x4 v[4]; float s = 0.f;
#pragma unroll
            for (int j = 0; j < 4; ++j) { v[j] = xr[64 * j]; s += (v[j].x * v[j].x + v[j].y * v[j].y) + (v[j].z * v[j].z + v[j].w * v[j].w); }
            const float rinv = __builtin_amdgcn_rsqf(wave_sum(s) * (1.0f / D) + EPS);
            GAS v2u* o8 = (GAS v2u*)(F.H + (size_t)row * D) + F.lane;
#pragma unroll
            for (int j = 0; j < 4; ++j) { const f32x4 a = *(const LAS f32x4*)(sc + 4 * F.lane + 256 * j), c = *(const LAS f32x4*)(sh + 4 * F.lane + 256 * j);
                const f32x4 h = (v[j] * rinv) * a + c; v2u w; w.x = pk2(h.x, h.y); w.y = pk2(h.z, h.w); o8[64 * j] = w; }
        }
    }
}

__device__ __forceinline__ f32x4 mfma16(bf16x8 a, bf16x8 b, f32x4 c) { return __builtin_amdgcn_mfma_f32_16x16x32_bf16(a, b, c, 0, 0, 0); }
typedef short s16x4 __attribute__((ext_vector_type(4)));
__device__ __forceinline__ v2u lds_tr16(const LAS bf16* p) { return __builtin_bit_cast(v2u, __builtin_amdgcn_ds_read_tr16_b64_v4i16((LAS s16x4*)p)); }
struct AttnLd { v4u kv[6], vv[6]; };
__device__ __forceinline__ void attn_load(const Frame& F, int unit, AttnLd& L) {
    const int qb = unit & 63, g = (unit >> 6) & 1, b = unit >> 7, kbase = qb * 128 - 128;
#pragma unroll
    for (int i = 0; i < 6; ++i) { const int idx = F.tid + 512 * i, r = idx >> 3, ch = idx & 7, kp = kbase + r;
        L.kv[i] = (v4u){0u, 0u, 0u, 0u}; L.vv[i] = (v4u){0u, 0u, 0u, 0u};
        if (kp >= 0 && kp < SEQ) { const bf16* rowp = F.PROJ + (size_t)(b * SEQ + kp) * DINP; L.kv[i] = *(const v4u*)(rowp + C_AK + g * 64 + ch * 8); L.vv[i] = *(const v4u*)(rowp + C_AV + g * 64 + ch * 8); } }
}
__device__ __forceinline__ void attn_compute(Frame& F, int unit, const AttnLd& L) {
    const int qb = unit & 63, g = (unit >> 6) & 1, b = unit >> 7;
    LAS bf16* KL = (LAS bf16*)F.lds;
    LAS bf16* VR = (LAS bf16*)(F.lds + 384 * 80 * 2);
    const int kbase = qb * 128 - 128;
    __syncthreads();
#pragma unroll
    for (int i = 0; i < 6; ++i) { const int idx = F.tid + 512 * i, r = idx >> 3, ch = idx & 7;
        *(LAS v4u*)(KL + r * 80 + ch * 8) = L.kv[i]; *(LAS v4u*)(VR + r * 80 + ch * 8) = L.vv[i]; }
    __syncthreads();
    const int fr = F.lane & 15, fq = F.lane >> 4;
    const int hq = 4 * g + (F.wave >> 1);
    const float sink = F.attn_sink[hq];
    constexpr float L2E = 1.44269504f;
    const bf16* qbase = F.PROJ + (size_t)(b * SEQ + qb * 128 + 64 * (F.wave & 1) + fr) * DINP + C_AQ + hq * 64 + 8 * fq;
    bf16x8 qn0 = *(const bf16x8*)(qbase), qn1 = *(const bf16x8*)(qbase + 32);
    const LAS bf16* vbase = VR + (4 * fq + (fr >> 2)) * 80 + 4 * (fr & 3);
#pragma unroll 1
    for (int rt = 0; rt < 4; ++rt) {
        const int tq0 = 64 * (F.wave & 1) + 16 * rt;
        const int qrow = b * SEQ + qb * 128 + tq0 + fr;
        const bf16x8 qf0 = qn0, qf1 = qn1;
        if (rt < 3) { const bf16* qp = qbase + (size_t)(16 * (rt + 1)) * DINP; qn0 = *(const bf16x8*)(qp); qn1 = *(const bf16x8*)(qp + 32); }
        int kt0 = tq0 >> 4; kt0 = kt0 > 6 ? 6 : kt0;
        f32x4 sc[18];
#pragma unroll
        for (int jj = 0; jj < 18; ++jj) {
            const LAS bf16* kp = KL + ((kt0 + jj) * 16 + fr) * 80 + 8 * fq;
            const bf16x8 k0 = *(const LAS bf16x8*)(kp), k1 = *(const LAS bf16x8*)(kp + 32);
            f32x4 a = {0.f, 0.f, 0.f, 0.f};
            a = mfma16(k0, qf0, a); a = mfma16(k1, qf1, a);
            sc[jj] = a;
        }
        const int tq = tq0 + fr;
        float m = sink;
#pragma unroll
        for (int jj = 0; jj < 18; ++jj) {
            const int k0t = (kt0 + jj) * 16;
            const bool full = (k0t >= tq0 + 15) && (k0t + 15 <= tq0 + 256) && (kbase + k0t >= 0) && (kbase + k0t + 15 < SEQ);
            if (full) {
#pragma unroll
                for (int r = 0; r < 4; ++r) m = fmaxf(m, sc[jj][r]);
            } else {
#pragma unroll
                for (int r = 0; r < 4; ++r) {
                    const int ki = k0t + 4 * fq + r, kp = kbase + ki;
                    const bool valid = (ki >= tq) && (ki <= tq + 256) && (kp >= 0) && (kp < SEQ);
                    sc[jj][r] = valid ? sc[jj][r] : -1e30f;
                    m = fmaxf(m, sc[jj][r]);
                }
            }
        }
        m = fmaxf(m, __shfl_xor(m, 16)); m = fmaxf(m, __shfl_xor(m, 32));
        float sum = 0.f; const float mL = m * L2E;
#pragma unroll
        for (int jj = 0; jj < 18; ++jj) { const f32x4 t = sc[jj] * L2E - mL;
#pragma unroll
            for (int r = 0; r < 4; ++r) { const float p = __builtin_amdgcn_exp2f(t[r]); sc[jj][r] = p; sum += p; } }
        sum += __shfl_xor(sum, 16); sum += __shfl_xor(sum, 32);
        sum += __builtin_amdgcn_exp2f((sink - m) * L2E);
        const float rden = 1.0f / sum;
        f32x4 o[4];
#pragma unroll
        for (int dt = 0; dt < 4; ++dt) o[dt] = (f32x4){0.f, 0.f, 0.f, 0.f};
#pragma unroll
        for (int kk = 0; kk < 9; ++kk) {
            v4u pw; pw.x = pg8::cvt_pk_bf16(sc[2 * kk][0], sc[2 * kk][1]); pw.y = pg8::cvt_pk_bf16(sc[2 * kk][2], sc[2 * kk][3]);
            pw.z = pg8::cvt_pk_bf16(sc[2 * kk + 1][0], sc[2 * kk + 1][1]); pw.w = pg8::cvt_pk_bf16(sc[2 * kk + 1][2], sc[2 * kk + 1][3]);
            const bf16x8 pf = __builtin_bit_cast(bf16x8, pw);
#pragma unroll
            for (int dt = 0; dt < 4; ++dt) {
                const LAS bf16* vp = vbase + (kt0 + 2 * kk) * 1280 + 16 * dt;
                const v2u va = lds_tr16(vp), vb = lds_tr16(vp + 1280);
                v4u vw; vw.x = va.x; vw.y = va.y; vw.z = vb.x; vw.w = vb.y;
                o[dt] = mfma16(__builtin_bit_cast(bf16x8, vw), pf, o[dt]);
            }
        }
        bf16* op = F.O + (size_t)qrow * D + 512 + hq * 64 + 4 * fq;
#pragma unroll
        for (int dt = 0; dt < 4; ++dt) { v2u w; w.x = pg8::cvt_pk_bf16(o[dt][0] * rden, o[dt][1] * rden); w.y = pg8::cvt_pk_bf16(o[dt][2] * rden, o[dt][3] * rden); *(v2u*)(op + 16 * dt) = w; }
    }
}

struct GlaGates { float b0[8], b1[8]; float all0, ref0, all1, ref1; };
struct GateLd { v4u glr; float wf[16], wb[16], bf_, bb_; };
__device__ __forceinline__ float log_sigmoid(float z) { return fminf(z, 0.f) - 0.69314718f * __builtin_amdgcn_logf(1.0f + __builtin_amdgcn_exp2f(fabsf(z) * -1.44269504f)); }
__device__ __forceinline__ void gate_load(const Frame& F, int b, int h, int c, GateLd& L) {
    const size_t row0 = (size_t)b * SEQ + (size_t)c * 64; const int d = F.lane;
    L.glr = (v4u){0u, 0u, 0u, 0u};
    if (F.tid < 256) L.glr = *(const v4u*)(F.PROJ + (row0 + (F.tid >> 2)) * DINP + C_GLR + (F.tid & 3) * 8);
#pragma unroll
    for (int r = 0; r < 16; ++r) { L.wf[r] = F.w_gk_fwd[r * 256 + h * 64 + d]; L.wb[r] = F.w_gk_bwd[r * 256 + h * 64 + d]; }
    L.bf_ = F.b_gk_fwd[h * 64 + d]; L.bb_ = F.b_gk_bwd[h * 64 + d];
}
__device__ __forceinline__ void gla_gates(Frame& F, const GateLd& L, LAS float* GLR, LAS float* TOT, GlaGates& G) {
    const int ig = F.wave, d = F.lane;
    if (F.tid < 256) { const v4u w = L.glr; LAS float* gp = GLR + (F.tid >> 2) * 32 + (F.tid & 3) * 8;
        gp[0] = bflo(w.x); gp[1] = bfhi(w.x); gp[2] = bflo(w.y); gp[3] = bfhi(w.y); gp[4] = bflo(w.z); gp[5] = bfhi(w.z); gp[6] = bflo(w.w); gp[7] = bfhi(w.w); }
    __syncthreads();
    float la0[8], la1[8];
#pragma unroll
    for (int kk = 0; kk < 8; ++kk) {
        const LAS float* gp = GLR + (8 * ig + kk) * 32;
        float z0 = L.bf_, z1 = L.bb_;
#pragma unroll
        for (int r = 0; r < 16; ++r) { z0 += gp[r] * L.wf[r]; z1 += gp[16 + r] * L.wb[r]; }
        la0[kk] = log_sigmoid(z0) * (1.0f / 16.0f); la1[kk] = log_sigmoid(z1) * (1.0f / 16.0f);
    }
#pragma unroll
    for (int kk = 1; kk < 8; ++kk) la0[kk] += la0[kk - 1];
#pragma unroll
    for (int kk = 6; kk >= 0; --kk) la1[kk] += la1[kk + 1];
    TOT[(0 * 8 + ig) * 64 + d] = la0[7]; TOT[(1 * 8 + ig) * 64 + d] = la1[0];
    __syncthreads();
    float off0 = 0.f, all0 = 0.f, ref0 = 0.f, off1 = 0.f, all1 = 0.f, ref1 = 0.f;
#pragma unroll
    for (int g = 0; g < 8; ++g) {
        const float t0 = TOT[(0 * 8 + g) * 64 + d], t1 = TOT[(1 * 8 + g) * 64 + d];
        all0 += t0; all1 += t1; off0 += (g < ig) ? t0 : 0.f; off1 += (g > ig) ? t1 : 0.f; ref0 += (g < 4) ? t0 : 0.f; ref1 += (g >= 4) ? t1 : 0.f;
    }
#pragma unroll
    for (int kk = 0; kk < 8; ++kk) { G.b0[kk] = la0[kk] + off0; G.b1[kk] = la1[kk] + off1; }
    G.all0 = all0; G.ref0 = ref0; G.all1 = all1; G.ref1 = ref1;
}
struct Gate2Ld { v4u a[4]; v4u bw; float bias; };
__device__ __forceinline__ void gate2_load(const Frame& F, int b, int h, int c, Gate2Ld& L) {
    const size_t row0 = (size_t)b * SEQ + (size_t)c * 64; const int fr = F.lane & 15, fq = F.lane >> 4, dir = F.wave >> 2, dt = F.wave & 3;
#pragma unroll
    for (int tt = 0; tt < 4; ++tt) { L.a[tt] = (v4u){0u, 0u, 0u, 0u}; if (fq < 2) L.a[tt] = *(const v4u*)(F.PROJ + (row0 + 16 * tt + fr) * DINP + C_GLR + dir * 16 + 8 * fq); }
    L.bw = (v4u){0u, 0u, 0u, 0u}; if (fq < 2) L.bw = *(const v4u*)(F.WG_T + ((size_t)dir * 256 + h * 64 + 16 * dt + fr) * 16 + 8 * fq);
    L.bias = (dir ? F.b_gk_bwd : F.b_gk_fwd)[h * 64 + 16 * dt + fr];
}
struct Gates2 { float b[4][4]; float all, ref; };
__device__ __forceinline__ void gates2(const Frame& F, const Gate2Ld& L, Gates2& G) {
    const int fr = F.lane & 15, fq = F.lane >> 4, dir = F.wave >> 2;
    float la[4][4];
#pragma unroll
    for (int tt = 0; tt < 4; ++tt) {
        f32x4 z = {0.f, 0.f, 0.f, 0.f};
        z = mfma16(__builtin_bit_cast(bf16x8, L.a[tt]), __builtin_bit_cast(bf16x8, L.bw), z);
#pragma unroll
        for (int r = 0; r < 4; ++r) la[tt][r] = log_sigmoid(z[r] + L.bias) * (1.0f / 16.0f);
    }
    float tot[4], excP[4], T4[4], p[4][4];
#pragma unroll
    for (int tt = 0; tt < 4; ++tt) {
        p[tt][0] = la[tt][0]; p[tt][1] = p[tt][0] + la[tt][1]; p[tt][2] = p[tt][1] + la[tt][2]; p[tt][3] = p[tt][2] + la[tt][3];
        T4[tt] = p[tt][3];
        float inc = T4[tt]; float v = __shfl(inc, (F.lane + 48) & 63); inc += (fq >= 1) ? v : 0.f; v = __shfl(inc, (F.lane + 32) & 63); inc += (fq >= 2) ? v : 0.f;
        excP[tt] = inc - T4[tt]; tot[tt] = __shfl(inc, 48 + fr);
    }
    const float all = (tot[0] + tot[1]) + (tot[2] + tot[3]);
    const float runF[4] = {0.f, tot[0], tot[0] + tot[1], tot[0] + tot[1] + tot[2]};
    const float runB[4] = {tot[1] + tot[2] + tot[3], tot[2] + tot[3], tot[3], 0.f};
    const bool fwd = (dir == 0);
#pragma unroll
    for (int tt = 0; tt < 4; ++tt) {
        const float baseF = runF[tt] + excP[tt];
        const float baseB = runB[tt] + (tot[tt] - excP[tt] - T4[tt]);
#pragma unroll
        for (int r = 0; r < 4; ++r) { const float bf = baseF + p[tt][r], bb = baseB + (T4[tt] - p[tt][r] + la[tt][r]); G.b[tt][r] = fwd ? bf : bb; }
    }
    G.all = all; G.ref = fwd ? (tot[0] + tot[1]) : (tot[2] + tot[3]);
}
__device__ __forceinline__ void vr_load(const Frame& F, size_t row0, int h, v4u (&w)[2]) {
#pragma unroll
    for (int i = 0; i < 2; ++i) { const int idx = F.tid + 512 * i; w[i] = *(const v4u*)(F.PROJ + (row0 + (idx >> 4)) * DINP + C_GV + h * 128 + (idx & 15) * 8); }
}
__device__ __forceinline__ void vr_store(const Frame& F, const v4u (&w)[2], LAS bf16* VR) {
#pragma unroll
    for (int i = 0; i < 2; ++i) { const int idx = F.tid + 512 * i; *(LAS v4u*)(VR + (idx >> 4) * 144 + (idx & 15) * 8) = w[i]; }
}
__device__ __forceinline__ bf16x8 vr_frag(const LAS bf16* VR, int ks, int v0, int fr, int fq) {
    const LAS bf16* p = VR + (32 * ks + 8 * fq + (fr >> 2)) * 144 + v0 + 4 * (fr & 3);
    const v2u x = lds_tr16(p), y = lds_tr16(p + 4 * 144);
    v4u r; r.x = x.x; r.y = x.y; r.z = y.x; r.w = y.y; return __builtin_bit_cast(bf16x8, r);
}
__device__ __forceinline__ size_t gla_idx(int dir, int b, int h, int c) { return (size_t)(((dir * 2 + b) * 4 + h) * NCH + c); }

struct GlaALd { Gate2Ld g; unsigned short k[4][4]; v4u vr[2]; };
__device__ __forceinline__ void gla_a_load(const Frame& F, int unit, GlaALd& L) {
    const int c = unit & 127, h = (unit >> 7) & 3, b = unit >> 9;
    const size_t row0 = (size_t)b * SEQ + (size_t)c * 64; const int fr = F.lane & 15, fq = F.lane >> 4, dt = F.wave & 3;
    gate2_load(F, b, h, c, L.g);
#pragma unroll
    for (int tt = 0; tt < 4; ++tt)
#pragma unroll
        for (int r = 0; r < 4; ++r) L.k[tt][r] = F.PROJ[(row0 + 16 * tt + 4 * fq + r) * DINP + C_GK + h * 64 + 16 * dt + fr];
    vr_load(F, row0, h, L.vr);
}
__device__ __forceinline__ void gla_a_compute(Frame& F, int unit, const GlaALd& L) {
    const int c = unit & 127, h = (unit >> 7) & 3, b = unit >> 9;
    LAS bf16* KT = (LAS bf16*)(F.lds + 12288);
    LAS bf16* VR = (LAS bf16*)(F.lds + 12288 + 18432);
    const int fr = F.lane & 15, fq = F.lane >> 4, w = F.wave, dir = w >> 2, dt = w & 3;
    Gates2 G; gates2(F, L.g, G);
    __syncthreads();
#pragma unroll
    for (int tt = 0; tt < 4; ++tt) {
        v2u kw; kw.x = pk2(bf2f(L.k[tt][0]) * __expf(G.all - G.b[tt][0]), bf2f(L.k[tt][1]) * __expf(G.all - G.b[tt][1]));
        kw.y = pk2(bf2f(L.k[tt][2]) * __expf(G.all - G.b[tt][2]), bf2f(L.k[tt][3]) * __expf(G.all - G.b[tt][3]));
        *(LAS v2u*)(KT + (dir * 64 + 16 * dt + fr) * 72 + 16 * tt + 4 * fq) = kw;
    }
    vr_store(F, L.vr, VR);
    __syncthreads();
    const LAS bf16* ap = KT + (16 * w + fr) * 72 + 8 * fq;
    const bf16x8 a0 = *(const LAS bf16x8*)(ap), a1 = *(const LAS bf16x8*)(ap + 32);
    float* up = F.UT + gla_idx(w >> 2, b, h, c) * 8192 + 16 * (w & 3) + 4 * fq;
    bf16x8 vf[8][2];
#pragma unroll
    for (int vt = 0; vt < 8; ++vt) { vf[vt][0] = vr_frag(VR, 0, 16 * vt, fr, fq); vf[vt][1] = vr_frag(VR, 1, 16 * vt, fr, fq); }
    __builtin_amdgcn_sched_barrier(0);
    f32x4 acc[8];
#pragma unroll
    for (int vt = 0; vt < 8; ++vt) { acc[vt] = (f32x4){0.f, 0.f, 0.f, 0.f}; acc[vt] = mfma16(a0, vf[vt][0], acc[vt]); acc[vt] = mfma16(a1, vf[vt][1], acc[vt]); }
    __builtin_amdgcn_sched_barrier(0);
#pragma unroll
    for (int vt = 0; vt < 8; ++vt) *(f32x4*)(up + (size_t)(16 * vt + fr) * 64) = acc[vt];
    if (fq == 0) F.DEC[gla_idx(dir, b, h, c) * 64 + 16 * dt + fr] = __expf(G.all);
}
__device__ __forceinline__ void gla_scan(Frame& F) {
    for (int gid = F.vcu * 512 + F.tid; gid < 16 * 8192; gid += F.G * 512) {
        const int stream = gid >> 13, e = gid & 8191, d = e & 63, dir = stream >> 3;
        float s = 0.f;
#pragma unroll 8
        for (int n = 0; n < NCH; ++n) {
            const int c = dir ? (NCH - 1 - n) : n; const size_t idx = (size_t)stream * NCH + c;
            const float u = F.UT[idx * 8192 + e], dc = F.DEC[idx * 64 + d];
            F.ST[idx * 8192 + e] = (bf16)f2bf(s);
            s = s * dc + u;
        }
    }
}
struct GlaCLd { Gate2Ld g; };
__device__ __forceinline__ void gla_c_load(const Frame& F, int unit, GlaCLd& L) {
    const int c = unit & 127, h = (unit >> 7) & 3, b = unit >> 9;
    gate2_load(F, b, h, c, L.g);
}
__device__ __forceinline__ void gla_c_compute(Frame& F, int unit, const GlaCLd& L) {
    const int c = unit & 127, h = (unit >> 7) & 3, b = unit >> 9;
    LAS bf16* QS = (LAS bf16*)(F.lds + 12288);
    LAS bf16* KS = (LAS bf16*)(F.lds + 30720);
    LAS bf16* AC = (LAS bf16*)(F.lds + 49152);
    LAS bf16* VR = (LAS bf16*)(F.lds + 74752);
    LAS bf16* SC = (LAS bf16*)(F.lds + 74752 + 18432);
    LAS float* SSQ = (LAS float*)(F.lds);
    const size_t row0 = (size_t)b * SEQ + (size_t)c * 64;
    const int fr = F.lane & 15, fq = F.lane >> 4, w = F.wave;
    v4u vr[2]; v4u st[4]; v2u gg[4];
    vr_load(F, row0, h, vr);
#pragma unroll
    for (int rep = 0; rep < 4; ++rep) { const int q = F.tid + 512 * (rep & 1), dir = rep >> 1, v = q >> 3, d8 = q & 7; st[rep] = *(const v4u*)(F.ST + gla_idx(dir, b, h, c) * 8192 + v * 64 + d8 * 8); }
#pragma unroll
    for (int it = 0; it < 4; ++it) gg[it] = *(const v2u*)(F.PROJ + (row0 + 16 * it + fr) * DINP + C_GG + h * 128 + 16 * w + 4 * fq);
    unsigned short q16[4][4], k16[4][4];
#pragma unroll
    for (int tt = 0; tt < 4; ++tt)
#pragma unroll
        for (int r = 0; r < 4; ++r) { const bf16* rp = F.PROJ + (row0 + 16 * tt + 4 * fq + r) * DINP + h * 64 + 16 * (w & 3) + fr; q16[tt][r] = rp[C_GQ]; k16[tt][r] = rp[C_GK]; }
    Gates2 G; gates2(F, L.g, G);
    __syncthreads();
    {
        const int dir = w >> 2, d = 16 * (w & 3) + fr; const float er = __expf(G.ref);
#pragma unroll
        for (int tt = 0; tt < 4; ++tt)
#pragma unroll
            for (int r = 0; r < 4; ++r) {
                const int i = 16 * tt + 4 * fq + r;
                const float q = bf2f(q16[tt][r]), k = bf2f(k16[tt][r]);
                const float e = __expf(G.b[tt][r] - G.ref), qe = q * e;
                QS[(dir * 64 + i) * 72 + d] = (bf16)f2bf(qe); KS[(dir * 64 + i) * 72 + d] = (bf16)f2bf(k * __builtin_amdgcn_rcpf(e));
                AC[i * 200 + 64 + dir * 64 + d] = (bf16)f2bf(qe * er);
            }
    }
    vr_store(F, vr, VR);
#pragma unroll
    for (int rep = 0; rep < 4; ++rep) { const int q = F.tid + 512 * (rep & 1), dir = rep >> 1, v = q >> 3, d8 = q & 7; *(LAS v4u*)(SC + v * 144 + dir * 64 + d8 * 8) = st[rep]; }
    __syncthreads();
    {
        const int it = w & 3, jp = w >> 2;
        bf16x8 qf[2][2], kf[2][2][2];
#pragma unroll
        for (int dir = 0; dir < 2; ++dir)
#pragma unroll
            for (int ks = 0; ks < 2; ++ks) qf[dir][ks] = *(const LAS bf16x8*)(QS + (dir * 64 + 16 * it + fr) * 72 + 32 * ks + 8 * fq);
#pragma unroll
        for (int jj = 0; jj < 2; ++jj)
#pragma unroll
            for (int dir = 0; dir < 2; ++dir)
#pragma unroll
                for (int ks = 0; ks < 2; ++ks) kf[jj][dir][ks] = *(const LAS bf16x8*)(KS + (dir * 64 + 16 * (2 * jp + jj) + fr) * 72 + 32 * ks + 8 * fq);
        __builtin_amdgcn_sched_barrier(0);
        f32x4 sa[2][2];
#pragma unroll
        for (int jj = 0; jj < 2; ++jj)
#pragma unroll
            for (int dir = 0; dir < 2; ++dir) { sa[jj][dir] = (f32x4){0.f, 0.f, 0.f, 0.f};
#pragma unroll
                for (int ks = 0; ks < 2; ++ks) sa[jj][dir] = mfma16(kf[jj][dir][ks], qf[dir][ks], sa[jj][dir]); }
        __builtin_amdgcn_sched_barrier(0);
#pragma unroll
        for (int jj = 0; jj < 2; ++jj) {
            const int jt = 2 * jp + jj;
            const f32x4 s0 = sa[jj][0], s1 = sa[jj][1];
            const int i = 16 * it + fr; float sv[4];
#pragma unroll
            for (int r = 0; r < 4; ++r) { const int j = 16 * jt + 4 * fq + r; sv[r] = ((j <= i) ? s0[r] : 0.f) + ((j >= i) ? s1[r] : 0.f); }
            v2u pw; pw.x = pk2(sv[0], sv[1]); pw.y = pk2(sv[2], sv[3]);
            *(LAS v2u*)(AC + i * 200 + 16 * jt + 4 * fq) = pw;
        }
    }
    __syncthreads();
    f32x4 o[4];
#pragma unroll
    for (int it = 0; it < 4; ++it) o[it] = (f32x4){0.f, 0.f, 0.f, 0.f};
    {
        bf16x8 bfr[6], af[6][4];
#pragma unroll
        for (int ks = 0; ks < 6; ++ks) { bfr[ks] = ks < 2 ? vr_frag(VR, ks, 16 * w, fr, fq) : *(const LAS bf16x8*)(SC + (16 * w + fr) * 144 + 32 * (ks - 2) + 8 * fq);
#pragma unroll
            for (int it = 0; it < 4; ++it) af[ks][it] = *(const LAS bf16x8*)(AC + (16 * it + fr) * 200 + 32 * ks + 8 * fq); }
        __builtin_amdgcn_sched_barrier(0);
#pragma unroll
        for (int ks = 0; ks < 6; ++ks)
#pragma unroll
            for (int it = 0; it < 4; ++it) o[it] = mfma16(bfr[ks], af[ks][it], o[it]);
        __builtin_amdgcn_sched_barrier(0);
    }
#pragma unroll
    for (int it = 0; it < 4; ++it) { float s = (o[it][0] * o[it][0] + o[it][1] * o[it][1]) + (o[it][2] * o[it][2] + o[it][3] * o[it][3]);
        s += __shfl_xor(s, 16); s += __shfl_xor(s, 32); if (fq == 0) SSQ[w * 64 + 16 * it + fr] = s; }
    __syncthreads();
    const f32x4 gv = *(const f32x4*)(F.g_gla_out + 16 * w + 4 * fq);
#pragma unroll
    for (int it = 0; it < 4; ++it) {
        const int i = 16 * it + fr; float s = 0.f;
#pragma unroll
        for (int ww = 0; ww < 8; ++ww) s += SSQ[ww * 64 + i];
        const float rinv = __builtin_amdgcn_rsqf(s * (1.0f / 128.0f) + EPS);
        const v2u gw = gg[it];
        const float g0 = bflo(gw.x), g1 = bfhi(gw.x), g2 = bflo(gw.y), g3 = bfhi(gw.y);
        const float r0 = o[it][0] * rinv * gv[0] * (g0 * __builtin_amdgcn_rcpf(1.0f + __expf(-g0))), r1 = o[it][1] * rinv * gv[1] * (g1 * __builtin_amdgcn_rcpf(1.0f + __expf(-g1)));
        const float r2 = o[it][2] * rinv * gv[2] * (g2 * __builtin_amdgcn_rcpf(1.0f + __expf(-g2))), r3 = o[it][3] * rinv * gv[3] * (g3 * __builtin_amdgcn_rcpf(1.0f + __expf(-g3)));
        v2u ow; ow.x = pk2(r0, r1); ow.y = pk2(r2, r3);
        *(v2u*)(F.O + (row0 + i) * D + h * 128 + 16 * w + 4 * fq) = ow;
    }
}
__device__ __forceinline__ void p3_phase(Frame& F) {
    GlaALd LA; int u = F.vcu;
    {   AttnLd AL; int ua = F.vcu; bool ha = ua < 256;
        if (ha) attn_load(F, ua, AL);
        while (ha) { attn_compute(F, ua, AL); ua += F.G; ha = ua < 256; if (ha) attn_load(F, ua, AL); }
    }
    for (; u < 1024; u += F.G) { gla_a_load(F, u, LA); gla_a_compute(F, u, LA); }
}
__device__ __forceinline__ void p5_phase(Frame& F) {
    for (int u = F.vcu; u < 1024; u += F.G) { GlaCLd L; gla_c_load(F, u, L); gla_c_compute(F, u, L); }
}

__device__ __forceinline__ void p7_rows(Frame& F) {
    LAS bf16* WR = (LAS bf16*)(F.lds);
    LAS float* A1 = (LAS float*)(F.lds + 66048);
    LAS float* B2 = A1 + 1024;
    LAS float* C2 = B2 + 1024;
    LAS int* HIST = (LAS int*)(C2 + 1024);
    LAS int* BASE = HIST + 32;
    __syncthreads();
    for (int idx = F.tid; idx < 32 * 128; idx += 512) { const int e = idx >> 7, ch = idx & 127; *(LAS v4u*)(WR + e * 1032 + ch * 8) = *(const v4u*)(F.WR_T + e * 1024 + ch * 8); }
    const int fr = F.lane & 15, fq = F.lane >> 4;
    for (int rg = F.vcu; rg < T / 64; rg += F.G) {
        const int b = (rg * 64) / SEQ;
        __syncthreads();
        for (int i = F.tid; i < D; i += 512) { const float* md = F.MOD + b * 6144;
            A1[i] = md[2048 + i] * F.g_post_mix[i]; B2[i] = F.g_pre_ffn[i] * (1.0f + md[4096 + i]); C2[i] = md[3072 + i]; }
        if (F.tid < 32) HIST[F.tid] = 0;
        __syncthreads();
        v2u yq[4]; f32x4 xq[4];
        auto ld = [&](int row, v2u (&yw)[4], f32x4 (&xw)[4]) {
            const GAS v2u* yr = (const GAS v2u*)(F.Y + (size_t)row * D) + F.lane;
            const GAS f32x4* xr = (const GAS f32x4*)(F.x + (size_t)row * D) + F.lane;
#pragma unroll
            for (int j = 0; j < 4; ++j) { yw[j] = yr[64 * j]; xw[j] = xr[64 * j]; }
        };
        ld(rg * 64 + F.wave * 8, yq, xq);
#pragma unroll
        for (int rr = 0; rr < 8; ++rr) {
            const int row = rg * 64 + F.wave * 8 + rr;
            v2u yn[4]; f32x4 xn[4];
            if (rr < 7) ld(row + 1, yn, xn);
            f32x4 y[4], xv[4]; float s = 0.f;
#pragma unroll
            for (int j = 0; j < 4; ++j) { const v2u yw = yq[j]; y[j] = (f32x4){bflo(yw.x), bfhi(yw.x), bflo(yw.y), bfhi(yw.y)}; xv[j] = xq[j]; s += (y[j].x * y[j].x + y[j].y * y[j].y) + (y[j].z * y[j].z + y[j].w * y[j].w); }
            const float rinv1 = __builtin_amdgcn_rsqf(wave_sum(s) * (1.0f / D) + EPS);
            float s2 = 0.f;
            GAS v2u* o1 = (GAS v2u*)(F.H + (size_t)row * D) + F.lane;
#pragma unroll
            for (int j = 0; j < 4; ++j) { const f32x4 a = *(const LAS f32x4*)(A1 + 4 * F.lane + 256 * j);
                xv[j] = xv[j] + a * (y[j] * rinv1); { v2u w; w.x = pk2(xv[j].x, xv[j].y); w.y = pk2(xv[j].z, xv[j].w); o1[64 * j] = w; }
                s2 += (xv[j].x * xv[j].x + xv[j].y * xv[j].y) + (xv[j].z * xv[j].z + xv[j].w * xv[j].w); }
            const float rinv2 = __builtin_amdgcn_rsqf(wave_sum(s2) * (1.0f / D) + EPS);
            GAS v2u* o8 = (GAS v2u*)(F.H2 + (size_t)row * D) + F.lane;
#pragma unroll
            for (int j = 0; j < 4; ++j) { const f32x4 a = *(const LAS f32x4*)(B2 + 4 * F.lane + 256 * j), c = *(const LAS f32x4*)(C2 + 4 * F.lane + 256 * j);
                const f32x4 h = (xv[j] * rinv2) * a + c; v2u w; w.x = pk2(h.x, h.y); w.y = pk2(h.z, h.w); o8[64 * j] = w;
                ((GAS unsigned*)(F.H2F8 + (size_t)row * D))[F.lane + 64 * j] = pk4_fp8(sat8(h.x), sat8(h.y), sat8(h.z), sat8(h.w)); }
            if (rr < 7) {
#pragma unroll
                for (int j = 0; j < 4; ++j) { yq[j] = yn[j]; xq[j] = xn[j]; }
            }
        }
        VM_WAIT();
        __syncthreads();
        int myi = 0, myslot = 0; float myg = 0.f;
        if (F.wave < 4) {
            const int r0 = rg * 64 + F.wave * 16;
            f32x4 acc0 = {0.f, 0.f, 0.f, 0.f}, acc1 = {0.f, 0.f, 0.f, 0.f};
            const bf16* hp = F.H2 + (size_t)(r0 + fr) * D + 8 * fq;
            bf16x8 hf[32];
#pragma unroll
            for (int ks = 0; ks < 32; ++ks) hf[ks] = *(const bf16x8*)(hp + 32 * ks);
            __builtin_amdgcn_sched_barrier(0);
#pragma unroll
            for (int ks = 0; ks < 32; ++ks) {
                acc0 = mfma16(*(const LAS bf16x8*)(WR + fr * 1032 + 32 * ks + 8 * fq), hf[ks], acc0);
                acc1 = mfma16(*(const LAS bf16x8*)(WR + (16 + fr) * 1032 + 32 * ks + 8 * fq), hf[ks], acc1);
            }
            float v[8];
#pragma unroll
            for (int r = 0; r < 4; ++r) { v[r] = acc0[r] + F.b_router[4 * fq + r]; v[4 + r] = acc1[r] + F.b_router[16 + 4 * fq + r]; }
            float tv[4]; int ti[4];
#pragma unroll
            for (int t = 0; t < 4; ++t) {
                float bv = -3.0e38f; int bi = 0;
#pragma unroll
                for (int q = 0; q < 8; ++q) { const int id = (q >> 2) * 16 + 4 * fq + (q & 3); if (v[q] > bv) { bv = v[q]; bi = id; } }
#pragma unroll
                for (int o = 16; o <= 32; o <<= 1) { const float pv = __shfl_xor(bv, o); const int pi = __shfl_xor(bi, o); if (pv > bv || (pv == bv && pi < bi)) { bv = pv; bi = pi; } }
                tv[t] = bv; ti[t] = bi;
#pragma unroll
                for (int q = 0; q < 8; ++q) { const int id = (q >> 2) * 16 + 4 * fq + (q & 3); if (id == bi) v[q] = -3.0e38f; }
            }
            const float e1 = __expf(tv[1] - tv[0]), e2 = __expf(tv[2] - tv[0]), e3 = __expf(tv[3] - tv[0]);
            const float rs = 1.0f / (1.0f + e1 + e2 + e3);
            myi = fq == 0 ? ti[0] : fq == 1 ? ti[1] : fq == 2 ? ti[2] : ti[3];
            myg = (fq == 0 ? 1.0f : fq == 1 ? e1 : fq == 2 ? e2 : e3) * rs;
            myslot = atomicAdd((int*)(HIST + myi), 1);
        }
        __syncthreads();
        if (F.tid < 32) BASE[F.tid] = (int)__hip_atomic_fetch_add((unsigned*)(F.ctl + CW_CNT + F.tid), (unsigned)HIST[F.tid], RLX_AGENT);
        __syncthreads();
        if (F.wave < 4) {
            const int asg = (rg * 64 + F.wave * 16 + fr) * 4 + fq;
            F.LIST[(size_t)myi * LCAP + BASE[myi] + myslot] = asg | (int)(f2bf(myg) << 16);
        }
    }
}

__device__ __forceinline__ void p10_final(Frame& F) {
    LAS float* A2 = (LAS float*)(F.lds);
    for (int rg = F.vcu; rg < T / 64; rg += F.G) {
        const int b = (rg * 64) / SEQ;
        __syncthreads();
        for (int i = F.tid; i < D; i += 512) A2[i] = F.MOD[b * 6144 + 5120 + i] * F.g_post_ffn[i];
        __syncthreads();
        unsigned yq[4][4]; v2u xq[4];
        auto ld = [&](int row, unsigned (&y)[4][4], v2u (&x)[4]) {
#pragma unroll
            for (int k = 0; k < 4; ++k) { const GAS unsigned* yp = (const GAS unsigned*)((const unsigned char*)F.Y2 + ((size_t)row * 4 + k) * D) + F.lane;
#pragma unroll
                for (int j = 0; j < 4; ++j) y[k][j] = yp[64 * j]; }
            const GAS v2u* x1p = (const GAS v2u*)(F.H + (size_t)row * D) + F.lane;
#pragma unroll
            for (int j = 0; j < 4; ++j) x[j] = x1p[64 * j];
        };
        ld(rg * 64 + F.wave * 8, yq, xq);
#pragma unroll 1
        for (int rr = 0; rr < 8; ++rr) {
            const int row = rg * 64 + F.wave * 8 + rr;
            unsigned yn[4][4]; v2u xn[4];
            if (rr < 7) ld(row + 1, yn, xn);
            f32x4 ys[4];
#pragma unroll
            for (int j = 0; j < 4; ++j) ys[j] = (f32x4){0.f, 0.f, 0.f, 0.f};
#pragma unroll
            for (int k = 0; k < 4; ++k)
#pragma unroll
                for (int j = 0; j < 4; ++j) { const int w = (int)yq[k][j];
                    ys[j].x += __builtin_amdgcn_cvt_f32_fp8(w, 0); ys[j].y += __builtin_amdgcn_cvt_f32_fp8(w, 1); ys[j].z += __builtin_amdgcn_cvt_f32_fp8(w, 2); ys[j].w += __builtin_amdgcn_cvt_f32_fp8(w, 3); }
            float s = 0.f;
#pragma unroll
            for (int j = 0; j < 4; ++j) s += (ys[j].x * ys[j].x + ys[j].y * ys[j].y) + (ys[j].z * ys[j].z + ys[j].w * ys[j].w);
            const float rinv = __builtin_amdgcn_rsqf(wave_sum(s) * (1.0f / D) * (YSC_INV * YSC_INV) + EPS) * YSC_INV;
            GAS f32x4* o1 = (GAS f32x4*)(F.out + (size_t)row * D) + F.lane;
#pragma unroll
            for (int j = 0; j < 4; ++j) { const f32x4 a = *(const LAS f32x4*)(A2 + 4 * F.lane + 256 * j); const v2u xw = xq[j];
                const f32x4 x1 = {bflo(xw.x), bfhi(xw.x), bflo(xw.y), bfhi(xw.y)}; o1[64 * j] = x1 + a * (ys[j] * rinv); }
            if (rr < 7) {
#pragma unroll
                for (int k = 0; k < 4; ++k)
#pragma unroll
                    for (int j = 0; j < 4; ++j) yq[k][j] = yn[k][j];
#pragma unroll
                for (int j = 0; j < 4; ++j) xq[j] = xn[j];
            }
        }
    }
}

struct Args { const float* in[22]; float* out; unsigned char* ws; int ph_lo, ph_hi, li, pad; };
__global__ void __launch_bounds__(NWAVES * 64, 2) fwd_megakernel(Args args) {
    extern __shared__ __attribute__((aligned(16))) unsigned char lds_raw[];
    Frame F;
    F.lds = (LAS unsigned char*)lds_raw;
    F.MISC = (volatile LAS unsigned*)(F.lds + MISC_OFF);
    F.tid = threadIdx.x; F.lane = F.tid & 63; F.wave = __builtin_amdgcn_readfirstlane(F.tid >> 6);
    F.G = gridDim.x; { const int bx = blockIdx.x; F.vcu = (F.G % 8 == 0) ? (bx % 8) * (F.G / 8) + bx / 8 : bx; }
    unsigned char* ws = args.ws;
    F.ctl = (GAS unsigned*)(ws + WS_CTL);
    F.x = args.in[0]; F.c = args.in[1]; F.w_ada = args.in[2]; F.b_ada = args.in[3]; F.g_pre_mix = args.in[4]; F.g_post_mix = args.in[5]; F.w_in = args.in[6];
    F.w_gk_fwd = args.in[7]; F.b_gk_fwd = args.in[8]; F.w_gk_bwd = args.in[9]; F.b_gk_bwd = args.in[10]; F.g_gla_out = args.in[11]; F.attn_sink = args.in[12];
    F.w_out = args.in[13]; F.g_pre_ffn = args.in[14]; F.g_post_ffn = args.in[15]; F.w_router = args.in[16]; F.b_router = args.in[17]; F.w_gate_up = args.in[18];
    F.b_gate_up = args.in[19]; F.w_down = args.in[20]; F.b_down = args.in[21]; F.out = args.out;
    F.MOD = (float*)(ws + WS_MOD); F.ROPE = (float*)(ws + WS_ROPE); F.GATE = (float*)(ws + WS_GATE); F.DEC = (float*)(ws + WS_DEC); F.UT = (float*)(ws + WS_UT); F.Y = (bf16*)(ws + WS_Y);
    F.WR_T = (bf16*)(ws + WS_WR_T); F.WG_T = (bf16*)(ws + WS_WG_T); F.WIN_T = (bf16*)(ws + WS_WIN_T); F.WOUT_T = (bf16*)(ws + WS_WOUT_T); F.WGU_T = ws + WS_WGU_T; F.WD_T = ws + WS_WD_T; F.H2F8 = ws + WS_H2F8;
    F.H = (bf16*)(ws + WS_H); F.PROJ = (bf16*)(ws + WS_PROJ); F.ST = (bf16*)(ws + WS_ST); F.O = (bf16*)(ws + WS_O); F.H2 = (bf16*)(ws + WS_H2); F.ACT = ws + WS_ACT; F.Y2 = (bf16*)(ws + WS_Y2);
    F.LIST = (int*)(ws + WS_LIST);
    for (int u = F.tid; u < (LDS_BYTES - LDSCTL_OFF) / 4; u += NWAVES * 64) ((LAS unsigned*)(F.lds + LDSCTL_OFF))[u] = 0u;
    __syncthreads();
    XcdBarrier bar; bar.bar = (unsigned*)(F.ctl + CW_BAR) + args.li * XCD_BAR_WORDS; bar.x = 0; bar.st = nullptr;
    if (MK_N_LAUNCHES == 1) bar = xcd_barrier_post((unsigned*)(F.ctl + CW_BAR), F.MISC + 8);
    const int lo = args.ph_lo, hi = args.ph_hi;
#define IN(k) (lo <= (k) && (k) < hi)
#if defined(PROBE_PA)
    GAS unsigned long long* stamps = (GAS unsigned long long*)(F.ctl + 2048);
#define SEAM(k) do { if (blockIdx.x == 0 && F.tid == 0) stamps[16 + (k)] = __builtin_amdgcn_s_memrealtime(); if (IN(k) && IN((k) + 1)) xcd_barrier(bar); \
                     if (blockIdx.x == 0 && F.tid == 0) stamps[(k) + 1] = __builtin_amdgcn_s_memrealtime(); } while (0)
    if (blockIdx.x == 0 && F.tid == 0) stamps[0] = __builtin_amdgcn_s_memrealtime();
#else
#define SEAM(k) do { if (IN(k) && IN((k) + 1)) xcd_barrier(bar); } while (0)
#endif

    if (IN(0)) { p0_prologue(F); } SEAM(0);
    const bool spread = (F.G == 256);
    const int xl = F.vcu >> 5, jl = F.vcu & 31;
    const bool conv2 = spread && (jl >= NG2 / 8);
    if (IN(1)) { p1_norm(F);
                 if (!spread) { p0_f8_convert<0>(F, 0, NA8, F.vcu * NWAVES + F.wave, F.G * NWAVES); p0_f8_convert<1>(F, 0, NB8, F.vcu * NWAVES + F.wave, F.G * NWAVES); } } SEAM(1);
    if (IN(2)) { if (conv2) p0_f8_convert<0>(F, 0, NA8, (xl * (32 - NG2 / 8) + (jl - NG2 / 8)) * NWAVES + F.wave, (256 - NG2) * NWAVES);
                 else { ProjPolicy P; P.A = F.H; P.Bt = F.WIN_T; P.KB = D * 2; P.so.init(T, DINP, spread ? NG2 : F.G, spread ? (jl * 8 + xl) : (int)blockIdx.x); P.O = F.PROJ; P.rope = F.ROPE;
                        pg8::gemm_phase<ProjPolicy>(F.lds, P); } } SEAM(2);
    if (IN(3)) { p3_phase(F); } SEAM(3);
    if (IN(4)) { gla_scan(F); } SEAM(4);
    if (IN(5)) { p5_phase(F); } SEAM(5);
    if (IN(6)) { OutPolicy P; P.A = F.O; P.Bt = F.WOUT_T; P.KB = D * 2; P.so.init(T, D, F.G, (int)blockIdx.x); P.C = F.Y;
                 pg8::gemm_phase<OutPolicy>(F.lds, P); } SEAM(6);
    if (IN(7)) { p7_rows(F); } SEAM(7);
    if (IN(8) || IN(9)) {
        volatile LAS int* tb = (volatile LAS int*)(F.MISC + 16);
        __syncthreads();
        if (F.tid == 0) { int acc = 0; for (int e = 0; e < NE; ++e) { tb[e] = acc; const int cn = (int)__hip_atomic_load((unsigned*)(F.ctl + CW_CNT + e), RLX_AGENT); acc += (cn + 255) >> 8; } tb[32] = acc; }
        __syncthreads();
        volatile LAS int* rtab = (volatile LAS int*)(F.MISC + 64);
        for (int rt = F.tid; rt < tb[32]; rt += 512) { int e = 0; for (int j = 1; j < 32; ++j) e = (rt >= tb[j]) ? j : e;
            const int s0 = (rt - tb[e]) * 256, rem = (int)__hip_atomic_load((unsigned*)(F.ctl + CW_CNT + e), RLX_AGENT) - s0; rtab[rt] = e | ((rem < 256 ? rem : 256) << 8) | (s0 << 17); }
        __syncthreads();
        if (IN(8)) { Moe1Policy P; P.tb = tb; P.rtab = rtab; P.llds = F.lds + LDSCTL_OFF + 4096; P.cnt = (const int*)(F.ctl + CW_CNT); P.list = F.LIST; P.G = F.G; P.c = (int)blockIdx.x; P.ncol = 8;
                     P.A = F.H2F8; P.Bt = F.WGU_T; P.KB = D; P.ACTp = F.ACT; P.bias = F.b_gate_up;
                     pg8::gemm_phase<Moe1Policy>(F.lds, P);
                     if (spread && ((int)blockIdx.x >> 3) >= 16) p0_f8_convert<1>(F, 0, NB8, ((((int)blockIdx.x >> 3) - 16) * 8 + ((int)blockIdx.x & 7)) * NWAVES + F.wave, 128 * NWAVES); }
        SEAM(8);
        if (IN(9)) { Moe2Policy P; P.tb = tb; P.rtab = rtab; P.llds = F.lds + LDSCTL_OFF + 4096; P.cnt = (const int*)(F.ctl + CW_CNT); P.list = F.LIST; P.G = F.G; P.c = (int)blockIdx.x; P.ncol = 4;
                     P.A = F.ACT; P.Bt = F.WD_T; P.KB = DFF; P.Y2p = (unsigned char*)F.Y2; P.bias = F.b_down;
                     pg8::gemm_phase<Moe2Policy>(F.lds, P); }
    }
    SEAM(9);
    if (IN(10)) { p10_final(F); }
#if defined(PROBE_PA)
    if (blockIdx.x == 0 && F.tid == 0) stamps[11] = __builtin_amdgcn_s_memrealtime();
    {
        if (blockIdx.x == 0 && F.tid == 0) {
            auto dur = [&](int k) -> float { const unsigned long long a = stamps[k], b = (k == 9) ? stamps[16 + 9] : stamps[k + 1]; return (float)(long long)(b - a) * 0.01f; };
            const float tA = dur(PROBE_PA), tB = dur(PROBE_PB);
            const float V = 1000.0f * rintf(tB * 0.2f) + 2.0f * tA;
            const unsigned long long t0 = __builtin_amdgcn_s_memrealtime(), want = (unsigned long long)(V * 100.0f);
            while (__builtin_amdgcn_s_memrealtime() - t0 < want) __builtin_amdgcn_s_sleep(8);
        }
    }
#endif
#undef IN
#undef SEAM
}

extern "C" void kernel_launch(void* const* d_in, const int* in_sizes, int n_in, void* d_out, int out_size, void* d_ws, size_t ws_size, hipStream_t stream) {
    static int grid = 0;
    if (grid == 0) {
        if (n_in != 22 || in_sizes[0] != T * D || out_size != T * D || ws_size < WS_END) { fprintf(stderr, "kernel_launch: unexpected shapes (n_in %d, in0 %d, out %d, ws %zu)\n", n_in, n_in > 0 ? in_sizes[0] : -1, out_size, ws_size); grid = -1; return; }
        int dev = 0, cus = 0, per_cu = 0;
        if (hipGetDevice(&dev) != hipSuccess || hipDeviceGetAttribute(&cus, hipDeviceAttributeMultiprocessorCount, dev) != hipSuccess) { grid = -1; return; }
        if (hipFuncSetAttribute((const void*)fwd_megakernel, hipFuncAttributeMaxDynamicSharedMemorySize, LDS_BYTES) != hipSuccess) { fprintf(stderr, "kernel_launch: hipFuncSetAttribute failed\n"); grid = -1; return; }
        if (hipOccupancyMaxActiveBlocksPerMultiprocessor(&per_cu, (const void*)fwd_megakernel, NWAVES * 64, LDS_BYTES) != hipSuccess || per_cu < 1)
            fprintf(stderr, "kernel_launch: note: occupancy query reports %d blocks per CU\n", per_cu);
        (void)hipGetLastError();
        grid = cus;
    }
    if (grid < 0) return;
    if (hipMemsetAsync((char*)d_ws + WS_CTL, 0, CTL_ZERO_BYTES, stream) != hipSuccess) { fprintf(stderr, "kernel_launch: memset failed\n"); return; }
    Args a{};
    for (int i = 0; i < 22; ++i) a.in[i] = (const float*)d_in[i];
    a.out = (float*)d_out; a.ws = (unsigned char*)d_ws;
    if (MK_N_LAUNCHES == 1) {
        a.ph_lo = 0; a.ph_hi = N_PHASES; a.li = 0;
        hipLaunchKernelGGL(fwd_megakernel, dim3(grid), dim3(NWAVES * 64), LDS_BYTES, stream, a);
    } else {
        for (int p = 0; p < N_PHASES; ++p) { a.ph_lo = p; a.ph_hi = p + 1; a.li = 0;
            hipLaunchKernelGGL(fwd_megakernel, dim3(grid), dim3(NWAVES * 64), LDS_BYTES, stream, a); }
    }
    const hipError_t le = hipPeekAtLastError();
    if (le != hipSuccess) fprintf(stderr, "kernel_launch: launch failed: %s\n", hipGetErrorName(le));
}
```
